# Optimizing an MI355X kernel written in HIP

```python
import math
import jax, jax.numpy as jnp
from jax import lax
import numpy as np

D_MODEL = 1024
BATCH = 16
SEQ = 2048
DEPTH = 1

D_RNN = D_MODEL // 2
N_RNN_BLOCKS = 8
RNN_BLOCK = D_RNN // N_RNN_BLOCKS
CONV_WIDTH = 4
LRU_C = 8.0
DIFF_HEAD_DIM = 64
N_DIFF_HEADS = (D_MODEL // 2) // (2 * DIFF_HEAD_DIM)
D_ATTN = N_DIFF_HEADS * 2 * DIFF_HEAD_DIM
D_MIX = D_RNN + D_ATTN
D_IN = 2 * D_RNN + 3 * D_ATTN
Q_BLOCK = 128
N_EXPERTS = 32
TOP_K = 4
D_FF = D_MODEL
SWIGLU_LIMIT = 7.0
SWIGLU_ALPHA = 1.702
MOE_BLOCK = 128
EPS = 1e-5

kernel_name = "hybrid_rglru_diffattn_moe"


def rms_norm(x, g):
    xf = x.astype(jnp.float32)
    y = xf * lax.rsqrt(jnp.mean(xf * xf, axis=-1, keepdims=True) + EPS)
    return (y * g.astype(jnp.float32)).astype(x.dtype)


def causal_depthwise_conv(x, w, b):
    c = x.shape[-1]
    y = lax.conv_general_dilated(
        x, w[:, None, :].astype(x.dtype), window_strides=(1,),
        padding=[(CONV_WIDTH - 1, 0)], dimension_numbers=("NWC", "WIO", "NWC"),
        feature_group_count=c)
    return y + b


def _lru_combine(left, right):
    a_l, h_l = left
    a_r, h_r = right
    return a_l * a_r, a_r * h_l + h_r


def rg_lru(x, w_a, b_a, w_x, b_x, lam):
    bsz, seq, _ = x.shape
    xb = x.reshape(bsz, seq, N_RNN_BLOCKS, RNN_BLOCK)
    r = jax.nn.sigmoid(jnp.einsum("bsni,nij->bsnj", xb, w_a).reshape(bsz, seq, D_RNN) + b_a)
    i = jax.nn.sigmoid(jnp.einsum("bsni,nij->bsnj", xb, w_x).reshape(bsz, seq, D_RNN) + b_x)
    log_a = -LRU_C * r.astype(jnp.float32) * jax.nn.softplus(-lam.astype(jnp.float32))
    a = jnp.exp(log_a)
    u = jnp.sqrt(-jnp.expm1(2.0 * log_a)) * (i * x).astype(jnp.float32)
    _, h = lax.associative_scan(_lru_combine, (a, u), axis=1)
    return h.astype(x.dtype)


def diff_attention(q, k, v, lam):
    bsz, seq = q.shape[:2]
    nb = seq // Q_BLOCK
    q = jnp.transpose(q, (0, 2, 3, 1, 4))
    k = jnp.transpose(k, (0, 2, 3, 1, 4))
    v = jnp.transpose(v, (0, 2, 1, 3))
    qb = jnp.moveaxis(q.reshape(bsz, N_DIFF_HEADS, 2, nb, Q_BLOCK, DIFF_HEAD_DIM), 3, 0)
    kpos = jnp.arange(seq)

    def one_block(args):
        q_blk, blk = args
        s = jnp.einsum("bhcqd,bhckd->bhcqk", q_blk, k).astype(jnp.float32)
        qpos = blk * Q_BLOCK + jnp.arange(Q_BLOCK)
        s = jnp.where(kpos[None, :] <= qpos[:, None], s, -jnp.inf)
        p = jax.nn.softmax(s, axis=-1)
        w = p[:, :, 0] - lam * p[:, :, 1]
        return jnp.einsum("bhqk,bhke->bhqe", w.astype(v.dtype), v)

    o = lax.map(one_block, (qb, jnp.arange(nb)))
    return jnp.transpose(o, (1, 0, 3, 2, 4)).reshape(bsz, seq, N_DIFF_HEADS, 2 * DIFF_HEAD_DIM)


def moe_ffn(h, router_w, router_b, w1, b1, w2, b2):
    bsz, seq, d = h.shape
    n_tok = bsz * seq
    xt = h.reshape(n_tok, d)
    logits = jnp.dot(xt.astype(jnp.float32), router_w.astype(jnp.float32)) + router_b.astype(jnp.float32)
    top_val, top_idx = lax.top_k(logits, TOP_K)
    gates = jax.nn.softmax(top_val, axis=-1).reshape(-1)
    flat_e = top_idx.reshape(-1)
    n_asg = n_tok * TOP_K
    order = jnp.argsort(flat_e)
    sorted_e = flat_e[order]
    tok = order // TOP_K
    counts = jnp.bincount(flat_e, length=N_EXPERTS)
    padded = (counts + MOE_BLOCK - 1) // MOE_BLOCK * MOE_BLOCK
    pad_end = jnp.cumsum(padded)
    pad_start = pad_end - padded
    grp_start = jnp.cumsum(counts) - counts
    dest = pad_start[sorted_e] + jnp.arange(n_asg) - grp_start[sorted_e]
    n_blocks = (n_asg + MOE_BLOCK - 1) // MOE_BLOCK + N_EXPERTS
    src = jnp.full((n_blocks * MOE_BLOCK,), n_asg, dtype=jnp.int32).at[dest].set(
        jnp.arange(n_asg, dtype=jnp.int32))
    x_sorted = jnp.concatenate([xt[tok], jnp.zeros((1, d), xt.dtype)], axis=0)
    x_blocks = x_sorted[src].reshape(n_blocks, MOE_BLOCK, d)
    blk_e = jnp.minimum(jnp.searchsorted(pad_end, jnp.arange(n_blocks) * MOE_BLOCK, side="right"),
                        N_EXPERTS - 1)

    def expert_block(args):
        xb, e = args
        hcat = xb @ w1[e] + b1[e]
        gate = jnp.minimum(hcat[:, :D_FF], SWIGLU_LIMIT)
        up = jnp.clip(hcat[:, D_FF:], -SWIGLU_LIMIT, SWIGLU_LIMIT)
        act = gate * jax.nn.sigmoid(SWIGLU_ALPHA * gate) * (up + 1.0)
        return act @ w2[e] + b2[e]

    y_blocks = lax.map(expert_block, (x_blocks, blk_e)).reshape(-1, d)
    y_sorted = y_blocks[dest] * gates[order][:, None].astype(y_blocks.dtype)
    y = jax.ops.segment_sum(y_sorted, tok, num_segments=n_tok)
    return y.reshape(bsz, seq, d)


def setup_inputs(seed: int = 0) -> dict:
    key = jax.random.key(seed)
    ks = jax.random.split(key, 25)

    def nrm(k, shape, scale):
        return jax.random.normal(k, shape, jnp.float32) * scale

    a_c = jax.random.uniform(ks[9], (DEPTH, D_RNN), jnp.float32, minval=0.9, maxval=0.999)
    s = a_c ** (1.0 / LRU_C)
    return {
        "x": nrm(ks[0], (BATCH, SEQ, D_MODEL), 1.0),
        "norm1_g": 1.0 + nrm(ks[1], (DEPTH, D_MODEL), 0.02),
        "w_in": nrm(ks[2], (DEPTH, D_MODEL, D_IN), D_MODEL ** -0.5),
        "conv_w": nrm(ks[3], (DEPTH, CONV_WIDTH, D_RNN), CONV_WIDTH ** -0.5),
        "conv_b": nrm(ks[4], (DEPTH, D_RNN), 0.02),
        "lru_wa": nrm(ks[5], (DEPTH, N_RNN_BLOCKS, RNN_BLOCK, RNN_BLOCK), RNN_BLOCK ** -0.5),
        "lru_ba": nrm(ks[6], (DEPTH, D_RNN), 0.02),
        "lru_wx": nrm(ks[7], (DEPTH, N_RNN_BLOCKS, RNN_BLOCK, RNN_BLOCK), RNN_BLOCK ** -0.5),
        "lru_bx": nrm(ks[8], (DEPTH, D_RNN), 0.02),
        "lru_lambda": jnp.log(s) - jnp.log1p(-s),
        "q_norm_g": 1.0 + nrm(ks[10], (DEPTH, DIFF_HEAD_DIM), 0.02),
        "k_norm_g": 1.0 + nrm(ks[11], (DEPTH, DIFF_HEAD_DIM), 0.02),
        "lambda_q1": nrm(ks[12], (DEPTH, DIFF_HEAD_DIM), 0.1),
        "lambda_k1": nrm(ks[13], (DEPTH, DIFF_HEAD_DIM), 0.1),
        "lambda_q2": nrm(ks[14], (DEPTH, DIFF_HEAD_DIM), 0.1),
        "lambda_k2": nrm(ks[15], (DEPTH, DIFF_HEAD_DIM), 0.1),
        "subln_g": 1.0 + nrm(ks[16], (DEPTH, 2 * DIFF_HEAD_DIM), 0.02),
        "w_out": nrm(ks[17], (DEPTH, D_MIX, D_MODEL), D_MIX ** -0.5),
        "norm2_g": 1.0 + nrm(ks[18], (DEPTH, D_MODEL), 0.02),
        "router_w": nrm(ks[19], (DEPTH, D_MODEL, N_EXPERTS), D_MODEL ** -0.5),
        "router_b": nrm(ks[20], (DEPTH, N_EXPERTS), 0.01),
        "w1": nrm(ks[21], (DEPTH, N_EXPERTS, D_MODEL, 2 * D_FF), D_MODEL ** -0.5),
        "b1": nrm(ks[22], (DEPTH, N_EXPERTS, 2 * D_FF), 0.02),
        "w2": nrm(ks[23], (DEPTH, N_EXPERTS, D_FF, D_MODEL), D_FF ** -0.5),
        "b2": nrm(ks[24], (DEPTH, N_EXPERTS, D_MODEL), 0.02),
    }


def reference(x, norm1_g, w_in, conv_w, conv_b, lru_wa, lru_ba, lru_wx, lru_bx, lru_lambda,
              q_norm_g, k_norm_g, lambda_q1, lambda_k1, lambda_q2, lambda_k2, subln_g, w_out,
              norm2_g, router_w, router_b, w1, b1, w2, b2):
    bsz, seq, _ = x.shape
    splits = [D_RNN, 2 * D_RNN, 2 * D_RNN + D_ATTN, 2 * D_RNN + 2 * D_ATTN]
    for l in range(DEPTH):
        h = rms_norm(x, norm1_g[l])
        z = h @ w_in[l]
        xr, gr, q, k, v = jnp.split(z, splits, axis=-1)
        xr = causal_depthwise_conv(xr, conv_w[l], conv_b[l])
        y_rnn = rg_lru(xr, lru_wa[l], lru_ba[l], lru_wx[l], lru_bx[l], lru_lambda[l]) \
            * jax.nn.gelu(gr, approximate=True)
        q = rms_norm(q.reshape(bsz, seq, N_DIFF_HEADS, 2, DIFF_HEAD_DIM), q_norm_g[l]) \
            * (DIFF_HEAD_DIM ** -0.5)
        k = rms_norm(k.reshape(bsz, seq, N_DIFF_HEADS, 2, DIFF_HEAD_DIM), k_norm_g[l])
        v = v.reshape(bsz, seq, N_DIFF_HEADS, 2 * DIFF_HEAD_DIM)
        lam_init = 0.8 - 0.6 * math.exp(-0.3 * l)
        lam = (jnp.exp(jnp.sum(lambda_q1[l].astype(jnp.float32) * lambda_k1[l].astype(jnp.float32)))
               - jnp.exp(jnp.sum(lambda_q2[l].astype(jnp.float32) * lambda_k2[l].astype(jnp.float32)))
               + lam_init)
        o = diff_attention(q, k, v, lam)
        y_attn = (rms_norm(o, subln_g[l]) * (1.0 - lam_init)).reshape(bsz, seq, D_ATTN)
        x = x + jnp.concatenate([y_rnn, y_attn], axis=-1) @ w_out[l]
        x = x + moe_ffn(rms_norm(x, norm2_g[l]), router_w[l], router_b[l], w1[l], b1[l], w2[l], b2[l])
    return x
```

```cpp
#include <hip/hip_runtime.h>
#include <cstdio>
#include <cstdint>

#define LAS __attribute__((address_space(3)))
#define GAS __attribute__((address_space(1)))
typedef unsigned short bf16_t;
typedef short bf16x8 __attribute__((ext_vector_type(8)));
typedef short s16x4 __attribute__((ext_vector_type(4)));
typedef float f32x4 __attribute__((ext_vector_type(4)));
typedef float f32x2 __attribute__((ext_vector_type(2)));
typedef float f32x16 __attribute__((ext_vector_type(16)));
typedef unsigned u32x4 __attribute__((ext_vector_type(4)));
typedef unsigned u32x2 __attribute__((ext_vector_type(2)));

#ifndef MK_N_LAUNCHES
#define MK_N_LAUNCHES 1
#endif
constexpr int NPHASE = 9;

constexpr int NB = 16, SEQ = 2048, DM = 1024, MTOK = NB * SEQ;
constexpr int DIN = 2560, DRNN = 512, NEXP = 32, TOPK = 4, DFF = 1024, NASG = MTOK * TOPK;
constexpr float EPS = 1e-5f;
constexpr float LOG2E = 1.4426950408889634f;
constexpr int NWAVES = 8, NTHR = 512;
constexpr float YSCALE = 8.0f;
constexpr float WSCALE = 32.0f, ASCALE = 4.0f;

constexpr size_t MiB = (size_t)1 << 20;
constexpr size_t WS_CTL = 0, CTL_BYTES = 64 * 1024;
constexpr size_t WS_WIN = 2 * MiB;
constexpr size_t WS_WOUT = 8 * MiB;
constexpr size_t WS_WRH = 10 * MiB, WS_WRL = WS_WRH + 65536;
constexpr size_t WS_WAT = WS_WRH + 2 * 65536, WS_WXT = WS_WAT + 65536;
constexpr size_t WS_RSTD1 = 11 * MiB, WS_RSTD2 = WS_RSTD1 + 131072 * 2;
constexpr size_t WS_GATES = 12 * MiB;
constexpr size_t WS_POSI = 13 * MiB;
constexpr size_t WS_LIST = 16 * MiB;
constexpr size_t WS_W1 = 32 * MiB;
constexpr size_t WS_W2 = 160 * MiB;
constexpr size_t WS_XB = 224 * MiB;
constexpr size_t WS_XR = 288 * MiB, WS_GG = 320 * MiB, WS_Q = 352 * MiB, WS_K = 384 * MiB, WS_V = 416 * MiB;
constexpr size_t WS_Y = 448 * MiB;
constexpr size_t WS_X1B = 512 * MiB;
constexpr size_t WS_X1H = 712 * MiB;
constexpr size_t WS_ACT = 576 * MiB;
constexpr size_t WS_YB = 224 * MiB;
constexpr size_t WS_END = 848 * MiB;
constexpr int MAXTILES = NASG / 256 + NEXP;
constexpr int CW_TMO = 0, CW_QUEUE = 512, CW_CNT = 1024  , CW_BAR = 8192;

constexpr int RING_BYTES = 131072;
constexpr int LDS_AUX = RING_BYTES;
constexpr int LDS_MISC = RING_BYTES + 32768 - 256;
constexpr int LDS_BYTES = 163840;

__device__ __forceinline__ unsigned f2bf(float f) { unsigned u = __builtin_bit_cast(unsigned, f); return (u + 0x7fffu + ((u >> 16) & 1u)) >> 16; }
__device__ __forceinline__ float bf2f(unsigned h) { return __builtin_bit_cast(float, h << 16); }
typedef __bf16 bf16x2_t __attribute__((ext_vector_type(2)));
__device__ __forceinline__ unsigned cvt_pk_bf16(float lo, float hi) { f32x2 v = {lo, hi}; bf16x2_t b = __builtin_convertvector(v, bf16x2_t); return __builtin_bit_cast(unsigned, b); }
__device__ __forceinline__ unsigned pk2(float lo, float hi) { return cvt_pk_bf16(lo, hi); }
__device__ __forceinline__ void swap_rows16(unsigned& a, unsigned& b) { asm("s_nop 1\n\tv_permlane16_swap_b32 %0, %1" : "+v"(a), "+v"(b)); }
__device__ __forceinline__ void swap_rows32(unsigned& a, unsigned& b) { asm("s_nop 1\n\tv_permlane32_swap_b32 %0, %1" : "+v"(a), "+v"(b)); }
__device__ __forceinline__ float add_xor16(float v) { unsigned a = __builtin_bit_cast(unsigned, v), b = a; swap_rows16(a, b); return __builtin_bit_cast(float, a) + __builtin_bit_cast(float, b); }
__device__ __forceinline__ float add_xor32(float v) { unsigned a = __builtin_bit_cast(unsigned, v), b = a; swap_rows32(a, b); return __builtin_bit_cast(float, a) + __builtin_bit_cast(float, b); }
__device__ __forceinline__ float wave_sum(float v) {
#pragma unroll
    for (int o = 1; o < 64; o <<= 1) v += __shfl_xor(v, o);
    return v;
}
__device__ __forceinline__ float fast_sigmoid(float x) { return __builtin_amdgcn_rcpf(1.0f + __builtin_amdgcn_exp2f(-x * LOG2E)); }
__device__ __forceinline__ f32x4 gelu_tanh4(f32x4 x) {
    constexpr float A = -2.0f * 0.7978845608028654f * LOG2E, B = A * 0.044715f;
    const f32x4 t = (x * x * B + A) * x;
    const f32x4 d = (f32x4){__builtin_amdgcn_exp2f(t[0]), __builtin_amdgcn_exp2f(t[1]), __builtin_amdgcn_exp2f(t[2]), __builtin_amdgcn_exp2f(t[3])} + 1.0f;
    return x * (f32x4){__builtin_amdgcn_rcpf(d[0]), __builtin_amdgcn_rcpf(d[1]), __builtin_amdgcn_rcpf(d[2]), __builtin_amdgcn_rcpf(d[3])};
}
__device__ __forceinline__ unsigned pack_fp8x4(float a, float b, float c, float d) { unsigned t = 0; t = __builtin_amdgcn_cvt_pk_fp8_f32(a, b, t, false); t = __builtin_amdgcn_cvt_pk_fp8_f32(c, d, t, true); return t; }
#define LDS_WAIT() asm volatile("s_waitcnt lgkmcnt(0)" ::: "memory")
#define VM_WAIT() asm volatile("s_waitcnt vmcnt(0)" ::: "memory")

typedef const float* const volatile __attribute__((address_space(4))) * karg_ptr_t;
struct Frame {
    LAS unsigned char* lds;
    unsigned char* ws;
    int tid, lane, wave, vcu, G;
    karg_ptr_t kin;
    float* out;
    __device__ __forceinline__ const float* in(int i) const { return kin[i]; }
};

namespace pg8 {
constexpr int BM = 256, BK = 64, HALF = 128, HTB = HALF * BK * 2, KD = 1024, NT = KD / BK;
__device__ __forceinline__ int lds_byte(int r, int c) { const int st = (r >> 4) * 2 + (c >> 5), rr = r & 15, cc = c & 31, ob = rr * 64 + cc * 2; return st * 1024 + (ob ^ (((ob >> 9) & 1) << 5)); }
__device__ __forceinline__ void stage_rc(int b, int& R, int& C) { const int st = b / 1024, sb = b % 1024, swz = sb ^ (((sb >> 9) & 1) << 5); R = (st >> 1) * 16 + swz / 64; C = (st & 1) * 32 + (swz % 64) / 2; }
__device__ __forceinline__ int perm32(int rho) { const int n = rho >> 4, i = rho & 15; return 8 * (i >> 2) + 4 * n + (i & 3); }
struct Unit { int pm, pn, e, tt; };

typedef int v4i_t __attribute__((ext_vector_type(4)));
typedef int v8i_t __attribute__((ext_vector_type(8)));
__device__ __forceinline__ v8i_t cat8(bf16x8 a, bf16x8 b) { return __builtin_shufflevector(__builtin_bit_cast(v4i_t, a), __builtin_bit_cast(v4i_t, b), 0, 1, 2, 3, 4, 5, 6, 7); }
template <class Prob, bool ALIGN_EPI>
__device__ __forceinline__ void gemm_phase(LAS unsigned char* lds, const Prob& P) {
    const int tid = threadIdx.x, wid = __builtin_amdgcn_readfirstlane(tid >> 6), lane = tid & 63, wr = wid >> 2, wc = wid & 3, fr = lane & 15, fq = lane >> 4;
    constexpr int K = Prob::FP8 ? KD / 2 : KD, nt = Prob::FP8 ? NT / 2 : NT;
    unsigned voffB[2];
#pragma unroll
    for (int i = 0; i < 2; ++i) { int R_, C_; stage_rc(tid * 16 + i * 8192, R_, C_); const int Rb = (R_ & ~31) + perm32(R_ & 31); voffB[i] = (unsigned)(Rb * K + C_) * 2u; }
    constexpr size_t kstep = (size_t)(BK * 2);
    constexpr size_t hstepB = (size_t)HALF * K * 2;
    const unsigned ldsw = (unsigned)wid * 1024u;
    const int aoff = lds_byte(wr * 64 + fr, fq * 8), boff = lds_byte(wc * 32 + fr, fq * 8);
#define PG8_SA(b, h) (((b) * 2 + (h)) * HTB)
#define PG8_SB(b, h) ((4 + (b) * 2 + (h)) * HTB)
#define PG8_STAGE(bufoff, gbase, voff) do { _Pragma("unroll") for (int _i = 0; _i < 2; ++_i) \
        __builtin_amdgcn_global_load_lds((const unsigned*)((const char*)(gbase) + (voff)[_i]), (LAS unsigned*)(lds + (bufoff) + ldsw + _i * 8192), 16, 0, 0); } while (0)
#define PG8_RD(off) (*(const LAS bf16x8*)(lds + (off)))
#define PG8_LDA(dst, b, h) do { _Pragma("unroll") for (int m = 0; m < 4; ++m) { if constexpr (Prob::FP8) dst##8[m] = cat8(PG8_RD(PG8_SA(b, h) + aoff + m * 2048), PG8_RD(PG8_SA(b, h) + aoff + m * 2048 + 1024)); \
        else { _Pragma("unroll") for (int k = 0; k < 2; ++k) dst[m][k] = PG8_RD(PG8_SA(b, h) + aoff + m * 2048 + k * 1024); } } } while (0)
#define PG8_LDB(dst, b, h) do { _Pragma("unroll") for (int n = 0; n < 2; ++n) { if constexpr (Prob::FP8) dst##8[n] = cat8(PG8_RD(PG8_SB(b, h) + boff + n * 2048), PG8_RD(PG8_SB(b, h) + boff + n * 2048 + 1024)); \
        else { _Pragma("unroll") for (int k = 0; k < 2; ++k) dst[n][k] = PG8_RD(PG8_SB(b, h) + boff + n * 2048 + k * 1024); } } } while (0)
#define PG8_MMA(ai, bj, At, Bt) do { __builtin_amdgcn_s_setprio(1); _Pragma("unroll") for (int m = 0; m < 4; ++m) _Pragma("unroll") for (int n = 0; n < 2; ++n) { \
        if constexpr (Prob::FP8) asm volatile("s_nop 1\n\tv_mfma_f32_16x16x128_f8f6f4 %0, %1, %2, %0" : "+v"(acc[ai][bj][m][n]) : "v"(Bt##8[n]), "v"(At##8[m])); \
        else { _Pragma("unroll") for (int k = 0; k < 2; ++k) acc[ai][bj][m][n] = __builtin_amdgcn_mfma_f32_16x16x32_bf16(Bt[n][k], At[m][k], acc[ai][bj][m][n], 0, 0, 0); } } \
        __builtin_amdgcn_s_setprio(0); } while (0)
#define PG8_WAIT_V(n) asm volatile("s_waitcnt vmcnt(" #n ")" ::: "memory")
#define PG8_WAIT_L(n) asm volatile("s_waitcnt lgkmcnt(" #n ")" ::: "memory")
#define PG8_BAR __builtin_amdgcn_s_barrier()
#define PG8_SCHED __builtin_amdgcn_sched_barrier(0)
    Unit cur, nxt; int ui = 0;
    if (!P.next(0, cur)) return;
    f32x4 acc[2][2][4][2];
#pragma unroll
    for (int a = 0; a < 2; ++a)
#pragma unroll
        for (int b = 0; b < 2; ++b)
#pragma unroll
            for (int m = 0; m < 4; ++m)
#pragma unroll
                for (int n = 0; n < 2; ++n) acc[a][b][m][n] = (f32x4){0.f, 0.f, 0.f, 0.f};
    bf16x8 At[4][2], B0[2][2], B1[2][2]; v8i_t At8[4], B08[2], B18[2]; (void)At; (void)B0; (void)B1; (void)At8; (void)B08; (void)B18;
    unsigned vo[2][2];
    { int R[2], C[2]; stage_rc(tid * 16, R[0], C[0]); stage_rc(tid * 16 + 8192, R[1], C[1]); P.aoff(cur, R, C, vo); }
    const char* cA = P.abase(cur);
    const char* cB = P.bptr(cur);
    PG8_STAGE(PG8_SB(0, 0), cB, voffB); PG8_STAGE(PG8_SB(0, 1), cB + hstepB, voffB); PG8_STAGE(PG8_SA(0, 0), cA, vo[0]); PG8_STAGE(PG8_SA(0, 1), cA, vo[1]);
    if (wr == 1) PG8_BAR;
    PG8_WAIT_V(2); PG8_BAR;
    PG8_STAGE(PG8_SB(1, 0), cB + kstep, voffB); PG8_STAGE(PG8_SA(1, 0), cA + kstep, vo[0]); PG8_STAGE(PG8_SB(1, 1), cB + hstepB + kstep, voffB);
    PG8_WAIT_V(6); PG8_BAR;
    for (;;) {
        const bool has_next = P.next(ui + 1, nxt);
        const char* nB = has_next ? P.bptr(nxt) : cB;
        const char* nA = has_next ? P.abase(nxt) : cA;
#pragma nounroll
        for (int t = 0; t < nt; t += 2) {
            const bool last = (t == nt - 2);
            const char* a1 = cA + (size_t)(t + 1) * kstep;
            const char* a2 = last ? nA : cA + (size_t)(t + 2) * kstep; const char* b2 = last ? nB : cB + (size_t)(t + 2) * kstep;
            const char* a3 = a2 + kstep; const char* b3 = b2 + kstep;
            unsigned w2[2][2];
#pragma unroll
            for (int h = 0; h < 2; ++h)
#pragma unroll
                for (int i = 0; i < 2; ++i) w2[h][i] = vo[h][i];
            if (last && has_next) { int R[2], C[2]; stage_rc(tid * 16, R[0], C[0]); stage_rc(tid * 16 + 8192, R[1], C[1]); P.aoff(nxt, R, C, w2); }
            PG8_LDB(B0, 0, 0); PG8_LDB(B1, 0, 1); PG8_SCHED; PG8_LDA(At, 0, 0); PG8_STAGE(PG8_SA(1, 1), a1, vo[1]);
            PG8_WAIT_V(8); PG8_WAIT_L(0); PG8_BAR; PG8_MMA(0, 0, At, B0); PG8_MMA(0, 1, At, B1); PG8_BAR; PG8_SCHED;
            PG8_LDA(At, 0, 1); PG8_STAGE(PG8_SB(0, 0), b2, voffB); PG8_STAGE(PG8_SB(0, 1), b2 + hstepB, voffB); PG8_STAGE(PG8_SA(0, 0), a2, w2[0]);
            PG8_WAIT_V(8); PG8_WAIT_L(0); PG8_BAR; PG8_MMA(1, 0, At, B0); PG8_MMA(1, 1, At, B1); PG8_BAR; PG8_SCHED;
            PG8_LDB(B0, 1, 0); PG8_LDB(B1, 1, 1); PG8_SCHED; PG8_LDA(At, 1, 0); PG8_STAGE(PG8_SA(0, 1), a2, w2[1]);
            PG8_WAIT_V(8); PG8_WAIT_L(0); PG8_BAR; PG8_MMA(0, 0, At, B0); PG8_MMA(0, 1, At, B1); PG8_BAR; PG8_SCHED;
            PG8_LDA(At, 1, 1); PG8_STAGE(PG8_SB(1, 0), b3, voffB); PG8_STAGE(PG8_SB(1, 1), b3 + hstepB, voffB); PG8_STAGE(PG8_SA(1, 0), a3, w2[0]);
            PG8_WAIT_V(8); PG8_WAIT_L(0); PG8_BAR; PG8_MMA(1, 0, At, B0); PG8_MMA(1, 1, At, B1); PG8_BAR; PG8_SCHED;
        }
        if constexpr (ALIGN_EPI) { if (wr == 0) PG8_BAR; }
        { int fr_ = fr, fq_ = fq; asm volatile("" : "+v"(fr_), "+v"(fq_)); P.epi(acc, cur, wr, wc, fr_, fq_); }
        if (!has_next) break;
#pragma unroll
        for (int a = 0; a < 2; ++a)
#pragma unroll
            for (int b = 0; b < 2; ++b)
#pragma unroll
                for (int m = 0; m < 4; ++m)
#pragma unroll
                    for (int n = 0; n < 2; ++n) acc[a][b][m][n] = (f32x4){0.f, 0.f, 0.f, 0.f};
        cur = nxt; cB = nB; cA = nA; ++ui;
        { int R[2], C[2]; stage_rc(tid * 16, R[0], C[0]); stage_rc(tid * 16 + 8192, R[1], C[1]); P.aoff(cur, R, C, vo); }
        if constexpr (ALIGN_EPI) { if (wr == 1) PG8_BAR; }
    }
    PG8_WAIT_V(0);
    if constexpr (!ALIGN_EPI) { if (wr == 0) PG8_BAR; }
    PG8_BAR;
#undef PG8_SA
#undef PG8_SB
#undef PG8_STAGE
#undef PG8_LDA
#undef PG8_RD
#undef PG8_LDB
#undef PG8_MMA
#undef PG8_SCHED
}
struct StaticOrder {
    int nM, nN, nwg, G, c;
    __device__ void init(int M, int N, int G_, int c_) { nM = M / BM; nN = N / BM; nwg = nM * nN; G = G_; c = c_; }
    __device__ bool next(int i, int& pm, int& pn) const {
        const long L = (long)i * G + c; if (L >= nwg) return false;
        int wgid = (int)L; { const int q = nwg / 8, r = nwg % 8, xcd = wgid % 8, off = wgid / 8; wgid = (xcd < r ? xcd * (q + 1) : r * (q + 1) + (xcd - r) * q) + off; }
        const int nig = 8 * nN, gid = wgid / nig, fm = gid * 8, gsz = (nM - fm) < 8 ? (nM - fm) : 8;
        pm = fm + ((wgid % nig) % gsz); pn = (wgid % nig) / gsz; return true;
    }
};
}

__device__ __forceinline__ void p0_transpose_item(const float* W, int K, int N, bf16_t* WT, int out_row0, const float* g, LAS float* scr, int kb, int nb, int lane) {
    const int k0 = 64 * kb, n0 = 32 * nb;
#pragma unroll
    for (int i = 0; i < 8; ++i) { const int kk = 8 * i + (lane >> 3), c4 = lane & 7;
        *(LAS f32x4*)(scr + kk * 36 + ((4 * c4 + 4 * (kk >> 3)) & 31)) = __builtin_nontemporal_load((const f32x4*)(W + (size_t)(k0 + kk) * N + n0 + 4 * c4)); }
    LDS_WAIT(); asm volatile("" ::: "memory");
    const int c = lane & 7;
    float gv[8];
#pragma unroll
    for (int q = 0; q < 8; ++q) gv[q] = g ? g[k0 + 8 * c + q] : 1.0f;
#pragma unroll
    for (int j = 0; j < 4; ++j) { const int n = (lane >> 3) + 8 * j; const LAS float* s = scr + (8 * c) * 36 + ((n + 4 * c) & 31);
        u32x4 o; o.x = pk2(s[0 * 36] * gv[0], s[1 * 36] * gv[1]); o.y = pk2(s[2 * 36] * gv[2], s[3 * 36] * gv[3]); o.z = pk2(s[4 * 36] * gv[4], s[5 * 36] * gv[5]); o.w = pk2(s[6 * 36] * gv[6], s[7 * 36] * gv[7]);
        *(u32x4*)(WT + (size_t)(out_row0 + n) * K + k0 + 8 * c) = o; }
    LDS_WAIT(); asm volatile("" ::: "memory");
}
__device__ __forceinline__ void p0_prologue(Frame& F) {
    LAS float* scr = (LAS float*)(F.lds + F.wave * 16384);
    const int gw = F.vcu * NWAVES + F.wave, NGW = F.G * NWAVES;
    const float* x = F.in(0); const float* g1 = F.in(1); const float* w_in = F.in(2); const float* w_out = F.in(17); const float* g2 = F.in(18);
    bf16_t* WIN = (bf16_t*)(F.ws + WS_WIN); bf16_t* WOUT = (bf16_t*)(F.ws + WS_WOUT);
    constexpr int I_IN = 16 * 80, I_OUT = 16 * 32;
    constexpr int NITEMS = I_IN + I_OUT;
    for (int it = gw; it < NITEMS; it += NGW) {
        int r = it;
        if (r < I_IN) { const int kb = r / 80, nb = r % 80; p0_transpose_item(w_in, DM, DIN, WIN, 32 * nb, g1, scr, kb, nb, F.lane); continue; } r -= I_IN;
        { const int kb = r / 32, nb = r % 32; p0_transpose_item(w_out, DM, DM, WOUT, 32 * nb, nullptr, scr, kb, nb, F.lane); }
    }
    {
        const float* rw = F.in(19); bf16_t* WRH = (bf16_t*)(F.ws + WS_WRH); bf16_t* WRL = (bf16_t*)(F.ws + WS_WRL);
        const float* wa = F.in(5); const float* wx = F.in(7); bf16_t* WAT = (bf16_t*)(F.ws + WS_WAT); bf16_t* WXT = (bf16_t*)(F.ws + WS_WXT);
        const int gt = F.vcu * NTHR + F.tid, NGT = F.G * NTHR;
        for (int i = gt; i < 32768; i += NGT) {
            { const int n = i >> 10, k = i & 1023; const float v = rw[k * NEXP + n] * g2[k]; const unsigned h = f2bf(v); WRH[i] = (bf16_t)h; WRL[i] = (bf16_t)f2bf(v - bf2f(h)); }
            { const int nblk = i >> 12, j = (i >> 6) & 63, ii = i & 63; WAT[i] = (bf16_t)f2bf(wa[(nblk * 64 + ii) * 64 + j]); WXT[i] = (bf16_t)f2bf(wx[(nblk * 64 + ii) * 64 + j]); }
        }
    }
    {
        bf16_t* XB = (bf16_t*)(F.ws + WS_XB); float* RS1 = (float*)(F.ws + WS_RSTD1);
        for (int m = gw; m < MTOK; m += NGW) {
            const f32x4* xr = (const f32x4*)(x + (size_t)m * DM) + F.lane;
            f32x4 v[4]; float s = 0.f;
#pragma unroll
            for (int j = 0; j < 4; ++j) { v[j] = __builtin_nontemporal_load(&xr[64 * j]); s += (v[j].x * v[j].x + v[j].y * v[j].y) + (v[j].z * v[j].z + v[j].w * v[j].w); }
            s = wave_sum(s);
            if (F.lane == 0) RS1[m] = 1.0f / sqrtf(s * (1.0f / DM) + EPS);
            u32x2* o8 = (u32x2*)(XB + (size_t)m * DM) + F.lane;
#pragma unroll
            for (int j = 0; j < 4; ++j) { u32x2 w; w.x = pk2(v[j].x, v[j].y); w.y = pk2(v[j].z, v[j].w); o8[64 * j] = w; }
        }
    }
}

constexpr int STG_BUF0 = 3 * pg8::HTB, STG_BUF1 = LDS_AUX + 8192;
struct RowStager {
    LAS unsigned char* lds; int wr, wc, fr, fq, tid;
    template <class RowPtr> __device__ __forceinline__ void chunk(int c, u32x4 w0, u32x4 w1, const RowPtr& rowp) const {
        LAS unsigned char* buf = lds + ((c & 1) ? STG_BUF1 : STG_BUF0);
        const int rl = wr * 16 + fr, p0 = wc * 4 + fq;
        *(LAS u32x4*)(buf + rl * 512 + ((p0 ^ (rl & 7)) << 4)) = w0;
        *(LAS u32x4*)(buf + rl * 512 + (((16 + p0) ^ (rl & 7)) << 4)) = w1;
        asm volatile("s_waitcnt lgkmcnt(0)" ::: "memory"); __builtin_amdgcn_s_barrier(); asm volatile("" ::: "memory");
        const int ai = c >> 2, m = c & 3;
#pragma unroll
        for (int j = 0; j < 2; ++j) { const int p = tid + 512 * j, r2 = p >> 5, pi = p & 31;
            const u32x4 v = *(const LAS u32x4*)(buf + r2 * 512 + ((pi ^ (r2 & 7)) << 4));
            *(u32x4*)(rowp(ai * 128 + (r2 >> 4) * 64 + m * 16 + (r2 & 15)) + pi * 16) = v; }
    }
};

struct ProbInProj {
    static constexpr bool FP8 = false;
    pg8::StaticOrder S; const char* A; const char* Bt; const float* rstd1; bf16_t* dst0; const float* qg; const float* kg; LAS float* xs; LAS unsigned char* lds;
    __device__ __forceinline__ bool next(int i, pg8::Unit& u) const { u.e = 0; u.tt = 0; return S.next(i, u.pm, u.pn); }
    __device__ __forceinline__ const char* abase(const pg8::Unit& u) const { return A + (size_t)u.pm * 256 * DM * 2; }
    __device__ __forceinline__ void aoff(const pg8::Unit& u, const int (&R)[2], const int (&C)[2], unsigned (&vo)[2][2]) const {
#pragma unroll
        for (int h = 0; h < 2; ++h)
#pragma unroll
            for (int i = 0; i < 2; ++i) vo[h][i] = (unsigned)((h * 128 + R[i]) * DM + C[i]) * 2u;
    }
    __device__ __forceinline__ const char* bptr(const pg8::Unit& u) const { return Bt + (size_t)u.pn * 256 * DM * 2; }
    __device__ __forceinline__ void epi(f32x4 (&acc)[2][2][4][2], const pg8::Unit& u, int wr, int wc, int fr, int fq) const {
        const int type = u.pn >> 1;
        bf16_t* dst = dst0 + (size_t)type * ((WS_GG - WS_XR) / 2);
        const int row0 = u.pm * 256 + wr * 64 + fr, col0 = (u.pn & 1) * 256 + wc * 32 + 8 * fq;
        float rs[2][4];
#pragma unroll
        for (int ai = 0; ai < 2; ++ai)
#pragma unroll
            for (int m = 0; m < 4; ++m) rs[ai][m] = rstd1[row0 + ai * 128 + m * 16];
#pragma unroll
        for (int ai = 0; ai < 2; ++ai)
#pragma unroll
            for (int bj = 0; bj < 2; ++bj)
#pragma unroll
                for (int m = 0; m < 4; ++m)
#pragma unroll
                    for (int n = 0; n < 2; ++n) acc[ai][bj][m][n] = acc[ai][bj][m][n] * rs[ai][m];
        if (type == 1) {
#pragma unroll
            for (int ai = 0; ai < 2; ++ai)
#pragma unroll
                for (int bj = 0; bj < 2; ++bj)
#pragma unroll
                    for (int m = 0; m < 4; ++m)
#pragma unroll
                        for (int n = 0; n < 2; ++n) acc[ai][bj][m][n] = gelu_tanh4(acc[ai][bj][m][n]);
        }
        if (type == 2 || type == 3) {
            const int lane = fq * 16 + fr; (void)lane;
            float ss[2][4][2];
#pragma unroll
            for (int ai = 0; ai < 2; ++ai)
#pragma unroll
                for (int m = 0; m < 4; ++m)
#pragma unroll
                    for (int bj = 0; bj < 2; ++bj) { const f32x4 a = acc[ai][bj][m][0], b = acc[ai][bj][m][1]; const f32x4 q = a * a + b * b;
                        float s = (q[0] + q[1]) + (q[2] + q[3]);
                        s = add_xor16(s); s = add_xor32(s); ss[ai][m][bj] = s; }
            LAS float* mine = xs + ((wr * 4 + wc) * 8) * 32; LAS float* other = xs + ((wr * 4 + (wc ^ 1)) * 8) * 32;
            if (fq == 0) {
#pragma unroll
                for (int ai = 0; ai < 2; ++ai)
#pragma unroll
                    for (int m = 0; m < 4; ++m) { f32x2 w; w.x = ss[ai][m][0]; w.y = ss[ai][m][1]; *(LAS f32x2*)(mine + ((ai * 4 + m) * 16 + fr) * 2) = w; }
            }
            asm volatile("s_waitcnt lgkmcnt(0)" ::: "memory"); __builtin_amdgcn_s_barrier(); asm volatile("" ::: "memory");
            const float* g = (type == 2) ? qg : kg; const float sc = (type == 2) ? 0.125f * LOG2E : 1.0f;
            f32x4 gv[2];
#pragma unroll
            for (int n = 0; n < 2; ++n) gv[n] = *(const f32x4*)(g + 32 * (wc & 1) + 8 * fq + 4 * n) * sc;
#pragma unroll
            for (int ai = 0; ai < 2; ++ai)
#pragma unroll
                for (int m = 0; m < 4; ++m) { const f32x2 o = *(const LAS f32x2*)(other + ((ai * 4 + m) * 16 + fr) * 2);
#pragma unroll
                    for (int bj = 0; bj < 2; ++bj) { const float tot = ss[ai][m][bj] + (bj == 0 ? o.x : o.y); const float r = __builtin_amdgcn_rsqf(tot * (1.0f / 64.0f) + EPS);
#pragma unroll
                        for (int n = 0; n < 2; ++n) acc[ai][bj][m][n] = acc[ai][bj][m][n] * (gv[n] * r); } }
        }
        { const RowStager ST{lds, wr, wc, fr, fq, (wr * 4 + wc) * 64 + fq * 16 + fr};
          char* tbase = (char*)(dst + (size_t)u.pm * 256 * 512 + (u.pn & 1) * 256);
          auto rowp = [tbase](int r) { return tbase + (size_t)r * 1024; };
#pragma unroll
          for (int ai = 0; ai < 2; ++ai)
#pragma unroll
              for (int m = 0; m < 4; ++m) { u32x4 w[2];
#pragma unroll
                  for (int bj = 0; bj < 2; ++bj) { const f32x4 v0 = acc[ai][bj][m][0], v1 = acc[ai][bj][m][1];
                      w[bj].x = cvt_pk_bf16(v0[0], v0[1]); w[bj].y = cvt_pk_bf16(v0[2], v0[3]); w[bj].z = cvt_pk_bf16(v1[0], v1[1]); w[bj].w = cvt_pk_bf16(v1[2], v1[3]); }
                  ST.chunk(ai * 4 + m, w[0], w[1], rowp); } }
    }
};

__device__ __forceinline__ void conv_unit(Frame& F, int cu) {
    int lane = F.lane; asm volatile("" : "+v"(lane));
    const int wave = F.wave;
    LAS float* scr = (LAS float*)(F.lds + wave * 16384);
    const bool first = cu < 512;
    const int e = first ? (cu >> 4) : ((cu - 512) >> 3);
    const float* W = first ? F.in(21) + (size_t)e * DM * 2 * DFF : F.in(23) + (size_t)e * DFF * DM;
    unsigned char* WT = first ? F.ws + WS_W1 + (size_t)e * 2 * DFF * DM : F.ws + WS_W2 + (size_t)e * DM * DFF;
    const int N = first ? 2 * DFF : DM;
    const int c = lane & 3;
    float gv[16];
    { const float* g2 = F.in(18);
#pragma unroll
      for (int q = 0; q < 16; ++q) gv[q] = first ? g2[64 * (cu & 15) + 16 * c + q] * WSCALE : WSCALE; }
#define CV_GEOM(j, k0_, n0_, or_) do { const int idx_ = 8 * (j) + wave; \
        if (first) { k0_ = 64 * (cu & 15); n0_ = 32 * idx_; const int j0_ = n0_ & 1023; or_ = 256 * (j0_ >> 7) + (j0_ & 127) + ((n0_ >= 1024) ? 128 : 0); } \
        else { k0_ = 64 * (2 * ((cu - 512) & 7) + (idx_ >> 5)); n0_ = 32 * (idx_ & 31); or_ = n0_; } } while (0)
#define CV_LOAD(LD, k0_, n0_) do { _Pragma("unroll") for (int i = 0; i < 8; ++i) { const int kk = 8 * i + (lane >> 3), c4 = lane & 7; \
        LD[i] = __builtin_nontemporal_load((const f32x4*)(W + (size_t)((k0_) + kk) * N + (n0_) + 4 * c4)); } } while (0)
#define CV_ITEM(LD, j) do { \
        _Pragma("unroll") for (int i = 0; i < 8; ++i) { const int kk = 8 * i + (lane >> 3), c4 = lane & 7; \
            *(LAS f32x4*)(scr + kk * 36 + ((4 * c4 + 4 * (kk >> 3)) & 31)) = LD[i]; }         \
        int k0c, n0c, orc; CV_GEOM(j, k0c, n0c, orc); (void)n0c; \
        if ((j) + 2 < 8) { int k0n, n0n, orn; CV_GEOM((j) + 2, k0n, n0n, orn); (void)orn; CV_LOAD(LD, k0n, n0n); } \
        LDS_WAIT(); asm volatile("" ::: "memory"); \
        _Pragma("unroll") for (int j2 = 0; j2 < 2; ++j2) { const int n = (lane >> 2) + 16 * j2; const LAS float* sp = scr + (16 * c) * 36; \
            const int nc0 = (n + 8 * c) & 31, nc1 = (n + 8 * c + 4) & 31;           \
            unsigned w[4]; \
            _Pragma("unroll") for (int q = 0; q < 4; ++q) { unsigned t = 0; const int nc = (q < 2) ? nc0 : nc1; \
                t = __builtin_amdgcn_cvt_pk_fp8_f32(sp[(4 * q) * 36 + nc] * gv[4 * q], sp[(4 * q + 1) * 36 + nc] * gv[4 * q + 1], t, false); \
                t = __builtin_amdgcn_cvt_pk_fp8_f32(sp[(4 * q + 2) * 36 + nc] * gv[4 * q + 2], sp[(4 * q + 3) * 36 + nc] * gv[4 * q + 3], t, true); w[q] = t; } \
            *(u32x4*)(WT + (size_t)(orc + n) * 1024 + k0c + 16 * c) = (u32x4){w[0], w[1], w[2], w[3]}; } \
        LDS_WAIT(); asm volatile("" ::: "memory"); } while (0)
    f32x4 lda[8], ldb[8];
    { int k0, n0, orow; CV_GEOM(0, k0, n0, orow); (void)orow; CV_LOAD(lda, k0, n0); CV_GEOM(1, k0, n0, orow); CV_LOAD(ldb, k0, n0); }
    CV_ITEM(lda, 0); CV_ITEM(ldb, 1); CV_ITEM(lda, 2); CV_ITEM(ldb, 3); CV_ITEM(lda, 4); CV_ITEM(ldb, 5); CV_ITEM(lda, 6); CV_ITEM(ldb, 7);
#undef CV_ITEM
#undef CV_GEOM
#undef CV_LOAD
}

__device__ __forceinline__ void rglru_item(Frame& F, int item) {
    const int bb = item >> 3, nb = item & 7;
    int tid = F.tid; asm volatile("" : "+v"(tid));
    const int lane = tid & 63, wid = F.wave;
    const bf16_t* XR = (const bf16_t*)(F.ws + WS_XR); const bf16_t* GG = (const bf16_t*)(F.ws + WS_GG); bf16_t* Y = (bf16_t*)(F.ws + WS_Y);
    const float* conv_w = F.in(3); const float* conv_b = F.in(4); const float* ba = F.in(6); const float* bx = F.in(8); const float* lam = F.in(9);
    const bf16_t* WAT = (const bf16_t*)(F.ws + WS_WAT); const bf16_t* WXT = (const bf16_t*)(F.ws + WS_WXT);
    LAS bf16_t* XCb = (LAS bf16_t*)(F.lds);
    LAS float* XCf = (LAS float*)(F.lds + 9216);
    LAS float* RGl = (LAS float*)(F.lds + 9216 + 16384);
    LAS float* SEG = (LAS float*)(F.lds + 9216 + 16384 + 32768);
    LAS float* HC = (LAS float*)(F.lds + 9216 + 16384 + 32768 + 4096);
    const int ct = tid >> 3, cg = tid & 7, chb = nb * 64 + 8 * cg;
    float cw[4][8], cb[8];
#pragma unroll
    for (int j = 0; j < 4; ++j)
#pragma unroll
        for (int c = 0; c < 8; ++c) cw[j][c] = conv_w[j * DRNN + chb + c];
#pragma unroll
    for (int c = 0; c < 8; ++c) cb[c] = conv_b[chb + c];
    const int g = wid >> 2, mt = wid & 3, l15 = lane & 15, kq = lane >> 4;
    bf16x8 Bf[4][2];
    { const bf16_t* WT = (g == 0 ? WAT : WXT) + nb * 4096;
#pragma unroll
      for (int ntl = 0; ntl < 4; ++ntl)
#pragma unroll
          for (int ks = 0; ks < 2; ++ks) Bf[ntl][ks] = *(const bf16x8*)(WT + (16 * ntl + l15) * 64 + 32 * ks + 8 * kq); }
    float gbias[4];
#pragma unroll
    for (int ntl = 0; ntl < 4; ++ntl) gbias[ntl] = (g == 0 ? ba : bx)[nb * 64 + 16 * ntl + l15];
    const int sc = tid & 63, sg = tid >> 6;
    const float sp8 = 8.0f * log1pf(expf(-lam[nb * 64 + sc]));
    if (tid < 64) HC[tid] = 0.f;
    const size_t rowbase = (size_t)bb * SEQ;
    u32x4 xv[4];
#pragma unroll
    for (int j = 0; j < 4; ++j) { const int t = ct - 3 + j; xv[j] = (t >= 0) ? *(const u32x4*)(XR + (rowbase + t) * DRNN + chb) : (u32x4){0u, 0u, 0u, 0u}; }
    for (int c = 0; c < SEQ / 64; ++c) {
        const int t0 = 64 * c;
        {
            float xc[8];
#pragma unroll
            for (int q = 0; q < 8; ++q) xc[q] = cb[q];
#pragma unroll
            for (int j = 0; j < 4; ++j) { const unsigned w[4] = {xv[j].x, xv[j].y, xv[j].z, xv[j].w};
#pragma unroll
                for (int q = 0; q < 4; ++q) { xc[2 * q] += cw[j][2 * q] * bf2f(w[q] & 0xffffu); xc[2 * q + 1] += cw[j][2 * q + 1] * bf2f(w[q] >> 16); } }
            if (c + 1 < SEQ / 64) {
#pragma unroll
                for (int j = 0; j < 4; ++j) xv[j] = *(const u32x4*)(XR + (rowbase + t0 + 64 + ct - 3 + j) * DRNN + chb);
            }
            u32x4 pb; pb.x = pk2(xc[0], xc[1]); pb.y = pk2(xc[2], xc[3]); pb.z = pk2(xc[4], xc[5]); pb.w = pk2(xc[6], xc[7]);
            *(LAS u32x4*)(XCb + ct * 72 + 8 * cg) = pb;
            *(LAS f32x4*)(XCf + ct * 64 + 8 * cg) = (f32x4){xc[0], xc[1], xc[2], xc[3]};
            *(LAS f32x4*)(XCf + ct * 64 + 8 * cg + 4) = (f32x4){xc[4], xc[5], xc[6], xc[7]};
        }
        unsigned short gq[8];
#pragma unroll
        for (int s8 = 0; s8 < 8; ++s8) gq[s8] = GG[(rowbase + t0 + 8 * sg + s8) * DRNN + nb * 64 + sc];
        __syncthreads();
        {
            bf16x8 Af[2];
#pragma unroll
            for (int ks = 0; ks < 2; ++ks) Af[ks] = *(const LAS bf16x8*)(XCb + (16 * mt + l15) * 72 + 32 * ks + 8 * kq);
#pragma unroll
            for (int ntl = 0; ntl < 4; ++ntl) {
                f32x4 d = (f32x4){0.f, 0.f, 0.f, 0.f};
#pragma unroll
                for (int ks = 0; ks < 2; ++ks) d = __builtin_amdgcn_mfma_f32_16x16x32_bf16(Af[ks], Bf[ntl][ks], d, 0, 0, 0);
#pragma unroll
                for (int r = 0; r < 4; ++r) RGl[g * 4096 + (16 * mt + 4 * kq + r) * 64 + 16 * ntl + l15] = fast_sigmoid(d[r] + gbias[ntl]);
            }
        }
        __syncthreads();
        float av[8], uv[8]; float Aseg = 1.f, Hseg = 0.f;
#pragma unroll
        for (int s8 = 0; s8 < 8; ++s8) { const int tok = 8 * sg + s8;
            const float r = RGl[tok * 64 + sc], ig = RGl[4096 + tok * 64 + sc], xcv = XCf[tok * 64 + sc];
            const float la = -sp8 * r, y2 = 2.0f * la;
            const float a = __expf(la);
            const float om = (y2 > -0.1f) ? -y2 * (1.0f + y2 * (0.5f + y2 * (0.16666667f + y2 * 0.041666668f))) : (1.0f - __expf(y2));
            const float u = __builtin_amdgcn_sqrtf(om) * (ig * xcv);
            av[s8] = a; uv[s8] = u; Aseg *= a; Hseg = a * Hseg + u; }
        SEG[(sg * 64 + sc) * 2] = Aseg; SEG[(sg * 64 + sc) * 2 + 1] = Hseg;
        __syncthreads();
        float h = HC[(c & 1) * 64 + sc];
        for (int s2 = 0; s2 < sg; ++s2) h = SEG[(s2 * 64 + sc) * 2] * h + SEG[(s2 * 64 + sc) * 2 + 1];
#pragma unroll
        for (int s8 = 0; s8 < 8; ++s8) { h = av[s8] * h + uv[s8]; Y[(rowbase + t0 + 8 * sg + s8) * DM + nb * 64 + sc] = (bf16_t)f2bf(h * bf2f(gq[s8])); }
        if (sg == 7) HC[((c + 1) & 1) * 64 + sc] = h;
    }
    __syncthreads();
}

namespace att {
constexpr float ATT_THR = 8.0f;
constexpr int LK0 = 0, LK1 = 8192, LV = 16384, LBUF = 32768  , LWS = 98304, LOX = 0;
__device__ __forceinline__ int crow(int r, int hi) { return (r & 3) + 8 * (r >> 2) + 4 * hi; }
__device__ __forceinline__ void glds16(const void* gsrc, unsigned lds_dst) { unsigned keep;
    asm volatile("s_mov_b32 %0, m0\n\ts_mov_b32 m0, %2\n\ts_nop 0\n\tglobal_load_lds_dwordx4 %1, off\n\ts_mov_b32 m0, %0" : "=&s"(keep) : "v"(gsrc), "s"(lds_dst) : "memory"); }
typedef __attribute__((address_space(3))) const char* lds_cptr;
typedef short v4i16_t __attribute__((ext_vector_type(4)));
__device__ __forceinline__ s16x4 vtr(lds_cptr p) { return __builtin_bit_cast(s16x4, __builtin_amdgcn_ds_read_tr16_b64_v4i16((__attribute__((address_space(3))) v4i16_t*)p)); }
template <int CTRL> __device__ __forceinline__ float dpp_f(float x) { return __int_as_float(__builtin_amdgcn_update_dpp(0, __float_as_int(x), CTRL, 0xf, 0xf, true)); }
__device__ __forceinline__ float rowmax_pos(const f32x16& p0, const f32x16& p1) {
    int a = 0, b = 0;
#pragma unroll
    for (int r = 0; r < 16; r += 2) { a = max(max(a, __float_as_int(p0[r])), __float_as_int(p0[r + 1])); b = max(max(b, __float_as_int(p1[r])), __float_as_int(p1[r + 1])); }
    a = max(a, b);
    unsigned ua = (unsigned)a, ub = ua; swap_rows32(ua, ub);
    return __int_as_float(max((int)ua, (int)ub));
}
__device__ __forceinline__ void attn_unit(Frame& F, int b, int h, int qb, float lam) {
    int lane = F.lane; asm volatile("" : "+v"(lane));
    const int r32 = lane & 31, hi = lane >> 5, wid = F.wave, mp = wid >> 2, wq = wid & 3;
    const bf16_t* Q = (const bf16_t*)(F.ws + WS_Q); const bf16_t* K = (const bf16_t*)(F.ws + WS_K); const bf16_t* V = (const bf16_t*)(F.ws + WS_V); bf16_t* Y = (bf16_t*)(F.ws + WS_Y);
    const float* subg = F.in(16);
    char* shm = (char*)F.lds;
    const unsigned lds0 = (unsigned)(uintptr_t)shm;
    const size_t rowbase = (size_t)b * SEQ; const int q0 = qb * 128;
    const int NT = 2 * (qb + 1);
    float* wsf = (float*)(shm + LWS) + wid * 64;
    bf16x8 qr[4];
    { const bf16_t* Qw = Q + (rowbase + q0 + wq * 32 + r32) * 512 + h * 128 + mp * 64;
#pragma unroll
      for (int d0 = 0; d0 < 4; ++d0) qr[d0] = *(const bf16x8*)(Qw + d0 * 16 + hi * 8); }
    const bf16_t* ks0 = K + (rowbase + lane) * 512 + h * 128 + wid * 8;
    const bf16_t* ks1 = ks0 + 64;
    const bf16_t* vs0 = V + (rowbase + 16 * (wid & 3) + (lane >> 2)) * 512 + h * 128 + (wid >> 2) * 32 + (lane & 3) * 8;
    const bf16_t* vs1 = vs0 + 64;
    const unsigned kd0 = (unsigned)__builtin_amdgcn_readfirstlane(lds0 + LK0 + wid * 1024), kd1 = (unsigned)__builtin_amdgcn_readfirstlane(lds0 + LK1 + wid * 1024);
    const unsigned vd0 = (unsigned)__builtin_amdgcn_readfirstlane(lds0 + LV + wid * 1024), vd1 = (unsigned)__builtin_amdgcn_readfirstlane(lds0 + LV + (wid + 8) * 1024);
    const lds_cptr shm3 = (lds_cptr)(F.lds);
    const lds_cptr kp0 = shm3 + (mp ? LK1 : LK0) + hi * 1024 + r32 * 16;
    const lds_cptr vp0 = shm3 + LV + ((lane >> 4) & 1) * 32 + (lane & 3) * 8 + (4 * hi + ((lane & 15) >> 2)) * 64;
    f32x16 negm = f32x16{}; asm volatile("" : "+v"(negm));
    float m_run = 0.f, l_run = 0.f;
    f32x16 o[4];
#pragma unroll
    for (int d = 0; d < 4; ++d) o[d] = f32x16{};
    const int qrel = wq * 32 + r32;
    glds16(ks0, kd0); glds16(ks1, kd1); glds16(vs0, vd0); glds16(vs1, vd1);
    asm volatile("" : "+v"(qr[0]), "+v"(qr[1]), "+v"(qr[2]), "+v"(qr[3]));
    f32x16 p0, p1;
    u32x4 pw[4];
    int bcur = 0, bprev = 0, bnext = LBUF;
#define ATT_QK(P0, P1, slot) do { _Pragma("unroll") for (int d0 = 0; d0 < 4; ++d0) { \
        const bf16x8 k0f = *(const __attribute__((address_space(3))) bf16x8*)(kp0 + (slot) + d0 * 2048); \
        const bf16x8 k1f = *(const __attribute__((address_space(3))) bf16x8*)(kp0 + (slot) + d0 * 2048 + 512); \
        if (d0 == 0) { P0 = __builtin_amdgcn_mfma_f32_32x32x16_bf16(k0f, qr[0], negm, 0, 0, 0); P1 = __builtin_amdgcn_mfma_f32_32x32x16_bf16(k1f, qr[0], negm, 0, 0, 0); } \
        else { P0 = __builtin_amdgcn_mfma_f32_32x32x16_bf16(k0f, qr[d0], P0, 0, 0, 0); P1 = __builtin_amdgcn_mfma_f32_32x32x16_bf16(k1f, qr[d0], P1, 0, 0, 0); } } } while (0)
#define ATT_MASK(P0, P1, t) do { if ((t) >= NT - 2) { const int kb_ = 64 * ((t) - (NT - 2)) + 4 * hi; \
        _Pragma("unroll") for (int r = 0; r < 16; ++r) { const int kv = kb_ + (r & 3) + 8 * (r >> 2); if (kv > qrel) P0[r] = -INFINITY; if (kv + 32 > qrel) P1[r] = -INFINITY; } } } while (0)
#define ATT_SUMPACK(P0, P1) do { float sacc = 0.f; _Pragma("unroll") for (int r = 0; r < 16; ++r) sacc += P0[r] + P1[r]; l_run += sacc; \
        pw[0] = (u32x4){cvt_pk_bf16(P0[0], P0[1]), cvt_pk_bf16(P0[2], P0[3]), cvt_pk_bf16(P0[4], P0[5]), cvt_pk_bf16(P0[6], P0[7])}; \
        pw[1] = (u32x4){cvt_pk_bf16(P0[8], P0[9]), cvt_pk_bf16(P0[10], P0[11]), cvt_pk_bf16(P0[12], P0[13]), cvt_pk_bf16(P0[14], P0[15])}; \
        pw[2] = (u32x4){cvt_pk_bf16(P1[0], P1[1]), cvt_pk_bf16(P1[2], P1[3]), cvt_pk_bf16(P1[4], P1[5]), cvt_pk_bf16(P1[6], P1[7])}; \
        pw[3] = (u32x4){cvt_pk_bf16(P1[8], P1[9]), cvt_pk_bf16(P1[10], P1[11]), cvt_pk_bf16(P1[12], P1[13]), cvt_pk_bf16(P1[14], P1[15])}; } while (0)
#define ATT_PV(slot) do { _Pragma("unroll") for (int db = 0; db < 4; ++db) { _Pragma("unroll") for (int ks = 0; ks < 4; ++ks) { \
        const s16x4 lo = vtr(vp0 + (slot) + db * 4096 + ks * 1024), hh = vtr(vp0 + (slot) + db * 4096 + ks * 1024 + 512); \
        const bf16x8 vf = (bf16x8){lo[0], lo[1], lo[2], lo[3], hh[0], hh[1], hh[2], hh[3]}; \
        o[db] = __builtin_amdgcn_mfma_f32_32x32x16_bf16(__builtin_bit_cast(bf16x8, pw[ks]), vf, o[db], 0, 0, 0); } } } while (0)
#define ATT_DECIDE(P0, P1, moved) do { const float rm = rowmax_pos(P0, P1); moved = false; \
        if (__any(rm > ATT_THR)) { const float dl = rm; m_run += dl; \
            _Pragma("unroll") for (int r = 0; r < 16; ++r) { P0[r] -= dl; P1[r] -= dl; negm[r] = -m_run; } \
            asm volatile("" : "+v"(negm)); \
            const float f = __builtin_amdgcn_exp2f(-dl); l_run *= f; if (hi == 0) wsf[r32] = f; moved = true; } } while (0)
#define ATT_RESCALE_O() do { asm volatile("s_waitcnt lgkmcnt(0)" ::: "memory"); _Pragma("unroll") for (int r = 0; r < 16; ++r) { const float fr_ = wsf[crow(r, hi)]; \
        _Pragma("unroll") for (int d = 0; d < 4; ++d) o[d][r] *= fr_; } } while (0)
    asm volatile("s_waitcnt vmcnt(0) lgkmcnt(0)" ::: "memory"); __builtin_amdgcn_s_barrier(); asm volatile("" ::: "memory");
    { const size_t go = (size_t)1 * 64 * 512; glds16(ks0 + go, kd0 + LBUF); glds16(ks1 + go, kd1 + LBUF); glds16(vs0 + go, vd0 + LBUF); glds16(vs1 + go, vd1 + LBUF); }
    ATT_QK(p0, p1, 0); ATT_MASK(p0, p1, 0);
    { bool moved; ATT_DECIDE(p0, p1, moved); (void)moved; }
#pragma unroll
    for (int r = 0; r < 16; ++r) { p0[r] = __builtin_amdgcn_exp2f(p0[r]); p1[r] = __builtin_amdgcn_exp2f(p1[r]); }
    bprev = 0; bcur = LBUF; bnext = 2 * LBUF;
#define SBAR() __builtin_amdgcn_sched_barrier(0)
#define PIN1(x) asm volatile("" : "+v"(x))
#define KRD(j, slot) (*(const __attribute__((address_space(3))) bf16x8*)(kp0 + (slot) + ((j) >> 1) * 2048 + ((j) & 1) * 512))
#define VRDF(i, slot) do { vlo[(i) % 3] = vtr(vp0 + (slot) + ((i) >> 2) * 4096 + ((i) & 3) * 1024); vhi[(i) % 3] = vtr(vp0 + (slot) + ((i) >> 2) * 4096 + ((i) & 3) * 1024 + 512); } while (0)
#define VFRG(i) (bf16x8){vlo[(i) % 3][0], vlo[(i) % 3][1], vlo[(i) % 3][2], vlo[(i) % 3][3], vhi[(i) % 3][0], vhi[(i) % 3][1], vhi[(i) % 3][2], vhi[(i) % 3][3]}
#define GAPA(j, N0, N1, slot, PA, B, PWW, W0, W1) do { \
        if ((j) == 0) N0 = __builtin_amdgcn_mfma_f32_32x32x16_bf16(kf[0], qr[0], negm, 0, 0, 0); \
        else if ((j) == 1) N1 = __builtin_amdgcn_mfma_f32_32x32x16_bf16(kf[1], qr[0], negm, 0, 0, 0); \
        else if (((j) & 1) == 0) N0 = __builtin_amdgcn_mfma_f32_32x32x16_bf16(kf[(j) % 3], qr[(j) >> 1], N0, 0, 0, 0); \
        else N1 = __builtin_amdgcn_mfma_f32_32x32x16_bf16(kf[(j) % 3], qr[(j) >> 1], N1, 0, 0, 0); \
        if ((j) + 2 < 8) kf[((j) + 2) % 3] = KRD((j) + 2, slot); \
        sacc += PA[B]; sacc += PA[B + 1]; sacc += PA[B + 2]; sacc += PA[B + 3]; PIN1(sacc); \
        PWW[W0] = cvt_pk_bf16(PA[B], PA[B + 1]); PWW[W1] = cvt_pk_bf16(PA[B + 2], PA[B + 3]); PIN1(PWW); SBAR(); } while (0)
#define GAPB(i, slot, X, NX, B) do { \
        o[(i) >> 2] = __builtin_amdgcn_mfma_f32_32x32x16_bf16(__builtin_bit_cast(bf16x8, pw[(i) & 3]), VFRG(i), o[(i) >> 2], 0, 0, 0); \
        if ((i) + 2 < 16) VRDF((i) + 2, slot); \
        X[B] = __builtin_amdgcn_exp2f(NX[B]); X[B + 1] = __builtin_amdgcn_exp2f(NX[B + 1]); PIN1(X); SBAR(); } while (0)
#define ATT_STEP(t, MASKED) do { \
        asm volatile("s_waitcnt vmcnt(0) lgkmcnt(0)" ::: "memory"); \
        __builtin_amdgcn_s_barrier(); \
        asm volatile("" ::: "memory"); \
        if ((t) + 1 < NT) { const size_t go = (size_t)((t) + 1) * 64 * 512; const unsigned b1 = (unsigned)bnext; \
            glds16(ks0 + go, kd0 + b1); glds16(ks1 + go, kd1 + b1); glds16(vs0 + go, vd0 + b1); glds16(vs1 + go, vd1 + b1); } \
        SBAR(); \
        f32x16 n0, n1; bf16x8 kf[3]; s16x4 vlo[3], vhi[3]; float sacc = 0.f; u32x4 q0_, q1_, q2_, q3_; \
        kf[0] = KRD(0, bcur); kf[1] = KRD(1, bcur); SBAR(); \
        GAPA(0, n0, n1, bcur, p0, 0, q0_, 0, 1); GAPA(1, n0, n1, bcur, p0, 4, q0_, 2, 3); GAPA(2, n0, n1, bcur, p0, 8, q1_, 0, 1); GAPA(3, n0, n1, bcur, p0, 12, q1_, 2, 3); \
        GAPA(4, n0, n1, bcur, p1, 0, q2_, 0, 1); GAPA(5, n0, n1, bcur, p1, 4, q2_, 2, 3); GAPA(6, n0, n1, bcur, p1, 8, q3_, 0, 1); GAPA(7, n0, n1, bcur, p1, 12, q3_, 2, 3); \
        l_run += sacc; pw[0] = q0_; pw[1] = q1_; pw[2] = q2_; pw[3] = q3_; \
        VRDF(0, bprev); VRDF(1, bprev); SBAR();                         \
        if (MASKED) ATT_MASK(n0, n1, t); \
        bool moved; ATT_DECIDE(n0, n1, moved); \
        SBAR(); \
        GAPB(0, bprev, p0, n0, 0); GAPB(1, bprev, p0, n0, 2); GAPB(2, bprev, p0, n0, 4); GAPB(3, bprev, p0, n0, 6); \
        GAPB(4, bprev, p0, n0, 8); GAPB(5, bprev, p0, n0, 10); GAPB(6, bprev, p0, n0, 12); GAPB(7, bprev, p0, n0, 14); \
        GAPB(8, bprev, p1, n1, 0); GAPB(9, bprev, p1, n1, 2); GAPB(10, bprev, p1, n1, 4); GAPB(11, bprev, p1, n1, 6); \
        GAPB(12, bprev, p1, n1, 8); GAPB(13, bprev, p1, n1, 10); GAPB(14, bprev, p1, n1, 12); GAPB(15, bprev, p1, n1, 14); \
        if (moved) ATT_RESCALE_O(); \
        bprev = bcur; bcur = bnext; bnext = (bnext == 2 * LBUF) ? 0 : bnext + LBUF; } while (0)
    { int t = 1;
      for (; t < NT - 2; ++t) ATT_STEP(t, false);
      for (; t < NT; ++t) ATT_STEP(t, true); }
#undef ATT_STEP
#undef GAPA
#undef GAPB
#undef KRD
#undef VRDF
#undef VFRG
#undef SBAR
#undef PIN1
    ATT_SUMPACK(p0, p1);
    ATT_PV(bprev);
#undef ATT_QK
#undef ATT_MASK
#undef ATT_SUMPACK
#undef ATT_PV
#undef ATT_DECIDE
#undef ATT_RESCALE_O
    l_run = add_xor32(l_run);
    if (hi == 0) wsf[32 + r32] = l_run;
    asm volatile("s_waitcnt lgkmcnt(0)" ::: "memory");
    f32x16 rliv;
#pragma unroll
    for (int g = 0; g < 4; ++g) { const f32x4 lv = *(const f32x4*)(wsf + 32 + 8 * g + 4 * hi);
#pragma unroll
        for (int j = 0; j < 4; ++j) rliv[4 * g + j] = __builtin_amdgcn_rcpf(lv[j]); }
    __syncthreads();
    float* ox = (float*)(shm + LOX) + wq * 4096;
    if (mp == 1) {
#pragma unroll
        for (int db = 0; db < 4; ++db) { const f32x16 t = o[db] * rliv;
#pragma unroll
            for (int g = 0; g < 4; ++g) *(f32x4*)(ox + ((db * 4 + g) * 64 + lane) * 4) = (f32x4){t[4 * g], t[4 * g + 1], t[4 * g + 2], t[4 * g + 3]}; }
    }
    __syncthreads();
    if (mp == 0) {
        f32x16 ssv = f32x16{};
#pragma unroll
        for (int db = 0; db < 4; ++db) { f32x16 x1;
#pragma unroll
            for (int g = 0; g < 4; ++g) { const f32x4 t = *(const f32x4*)(ox + ((db * 4 + g) * 64 + lane) * 4); x1[4 * g] = t[0]; x1[4 * g + 1] = t[1]; x1[4 * g + 2] = t[2]; x1[4 * g + 3] = t[3]; }
            const f32x16 v = o[db] * rliv - x1 * lam; o[db] = v; ssv = v * v + ssv; }
#pragma unroll
        for (int r = 0; r < 16; ++r) { float sv = ssv[r];
            sv += dpp_f<0xB1>(sv); sv += dpp_f<0x4E>(sv); sv += dpp_f<0x141>(sv); sv += dpp_f<0x140>(sv);
            sv = add_xor16(sv);
            ssv[r] = 0.8f * __builtin_amdgcn_rsqf(sv * (1.0f / 128.0f) + EPS); }
        float sg[4];
#pragma unroll
        for (int db = 0; db < 4; ++db) sg[db] = subg[32 * db + r32];
        bf16_t* stg = (bf16_t*)ox;
#pragma unroll
        for (int db = 0; db < 4; ++db) { const f32x16 t = o[db] * (ssv * sg[db]);
#pragma unroll
            for (int r = 0; r < 16; r += 2) { const unsigned w = cvt_pk_bf16(t[r], t[r + 1]);
                stg[crow(r, hi) * 128 + 32 * db + r32] = (bf16_t)(w & 0xffffu); stg[crow(r + 1, hi) * 128 + 32 * db + r32] = (bf16_t)(w >> 16); } }
        asm volatile("s_waitcnt lgkmcnt(0)" ::: "memory");
        bf16_t* yb = Y + (rowbase + q0 + wq * 32) * DM + 512 + h * 128;
#pragma unroll
        for (int i = 0; i < 8; ++i) { const int q = lane + 64 * i, row = q >> 4, pc = q & 15;
            const u32x4 v = *(const u32x4*)(stg + row * 128 + pc * 8);
            *(u32x4*)(yb + (size_t)row * DM + pc * 8) = v; }
    }
}
constexpr int NCONV = 768, NQUEUE = 128 + 1024 + NCONV;
__device__ __forceinline__ void mixer_phase(Frame& F) {
    const float* lq1 = F.in(12); const float* lk1 = F.in(13); const float* lq2 = F.in(14); const float* lk2 = F.in(15);
    float a1 = lq1[F.lane] * lk1[F.lane], a2 = lq2[F.lane] * lk2[F.lane];
    a1 = wave_sum(a1); a2 = wave_sum(a2);
    const float lam = expf(a1) - expf(a2) + 0.2f;
    unsigned* qhead = (unsigned*)(F.ws + WS_CTL) + CW_QUEUE;
    volatile LAS unsigned* slot = (volatile LAS unsigned*)(F.lds + LDS_MISC) + 16;
    for (;;) {
        if (F.tid == 0) slot[0] = __hip_atomic_fetch_add(qhead, 1u, __ATOMIC_RELAXED, __HIP_MEMORY_SCOPE_AGENT);
        __syncthreads();
        const int u = (int)__builtin_amdgcn_readfirstlane(slot[0]);
        if (u >= NQUEUE) break;
        if (u < 128) { rglru_item(F, u); continue; }
        const int v = u - 128;
        if (v < 2 * NCONV && (v & 1)) { conv_unit(F, v >> 1); __syncthreads(); continue; }
        const int idx = (v < 2 * NCONV) ? (v >> 1) : v - NCONV, qb = 15 - (idx >> 6), bh = idx & 63;
        attn_unit(F, bh >> 2, bh & 3, qb, lam); __syncthreads();
    }
    __syncthreads();
}
}

struct ProbOutProj {
    static constexpr bool FP8 = false;
    pg8::StaticOrder S; const char* A; const char* Bt; const bf16_t* xb; bf16_t* x1h; unsigned char* x1q; LAS unsigned char* lds;
    __device__ __forceinline__ bool next(int i, pg8::Unit& u) const { u.e = 0; u.tt = 0; return S.next(i, u.pm, u.pn); }
    __device__ __forceinline__ const char* abase(const pg8::Unit& u) const { return A + (size_t)u.pm * 256 * DM * 2; }
    __device__ __forceinline__ void aoff(const pg8::Unit& u, const int (&R)[2], const int (&C)[2], unsigned (&vo)[2][2]) const {
#pragma unroll
        for (int h = 0; h < 2; ++h)
#pragma unroll
            for (int i = 0; i < 2; ++i) vo[h][i] = (unsigned)((h * 128 + R[i]) * DM + C[i]) * 2u;
    }
    __device__ __forceinline__ const char* bptr(const pg8::Unit& u) const { return Bt + (size_t)u.pn * 256 * DM * 2; }
    __device__ __forceinline__ void epi(f32x4 (&acc)[2][2][4][2], const pg8::Unit& u, int wr, int wc, int fr, int fq) const {
        const int tid = (wr * 4 + wc) * 64 + fq * 16 + fr;
        const size_t tile0 = (size_t)u.pm * 256 * DM + (size_t)u.pn * 256;
        u32x4 xres[8][2];
#pragma unroll
        for (int c = 0; c < 8; ++c)
#pragma unroll
            for (int j = 0; j < 2; ++j) { const int p = tid + 512 * j, r2 = p >> 5, pi = p & 31;
                xres[c][j] = *(const u32x4*)(xb + tile0 + (size_t)((c >> 2) * 128 + (r2 >> 4) * 64 + (c & 3) * 16 + (r2 & 15)) * DM + pi * 8); }
#pragma unroll
        for (int ai = 0; ai < 2; ++ai)
#pragma unroll
            for (int m = 0; m < 4; ++m) { const int c = ai * 4 + m;
                LAS unsigned char* buf = lds + ((c & 1) ? STG_BUF1 : STG_BUF0);
                const int rl = wr * 16 + fr, p0 = wc * 4 + fq;
#pragma unroll
                for (int bj = 0; bj < 2; ++bj) { const f32x4 v0 = acc[ai][bj][m][0], v1 = acc[ai][bj][m][1];
                    u32x4 w; w.x = cvt_pk_bf16(v0[0], v0[1]); w.y = cvt_pk_bf16(v0[2], v0[3]); w.z = cvt_pk_bf16(v1[0], v1[1]); w.w = cvt_pk_bf16(v1[2], v1[3]);
                    *(LAS u32x4*)(buf + rl * 512 + (((bj * 16 + p0) ^ (rl & 7)) << 4)) = w; }
                asm volatile("s_waitcnt lgkmcnt(0)" ::: "memory"); __builtin_amdgcn_s_barrier(); asm volatile("" ::: "memory");
#pragma unroll
                for (int j = 0; j < 2; ++j) { const int p = tid + 512 * j, r2 = p >> 5, pi = p & 31;
                    const u32x4 a = *(const LAS u32x4*)(buf + r2 * 512 + ((pi ^ (r2 & 7)) << 4));
                    const size_t off = tile0 + (size_t)(ai * 128 + (r2 >> 4) * 64 + m * 16 + (r2 & 15)) * DM + pi * 8;
                    const u32x4 xv = xres[c][j];
                    const unsigned aw[4] = {a.x, a.y, a.z, a.w}, xw[4] = {xv.x, xv.y, xv.z, xv.w};
                    float v[8];
#pragma unroll
                    for (int q = 0; q < 4; ++q) { v[2 * q] = bf2f(aw[q] & 0xffffu) + bf2f(xw[q] & 0xffffu); v[2 * q + 1] = bf2f(aw[q] >> 16) + bf2f(xw[q] >> 16); }
                    u32x4 hb; hb.x = cvt_pk_bf16(v[0], v[1]); hb.y = cvt_pk_bf16(v[2], v[3]); hb.z = cvt_pk_bf16(v[4], v[5]); hb.w = cvt_pk_bf16(v[6], v[7]);
                    *(u32x4*)(x1h + off) = hb;
                    u32x2 w8; w8.x = pack_fp8x4(v[0], v[1], v[2], v[3]); w8.y = pack_fp8x4(v[4], v[5], v[6], v[7]);
                    *(u32x2*)(x1q + off) = w8; } }
    }
};

__device__ __forceinline__ void p5_router(Frame& F) {
    const int lane = F.lane, r32 = lane & 31, hi = lane >> 5, wid = F.wave, tl = wid & 3, kh = wid >> 2, tid = F.tid;
    const bf16_t* x1 = (const bf16_t*)(F.ws + WS_X1H); const bf16_t* WRH = (const bf16_t*)(F.ws + WS_WRH); const bf16_t* WRL = (const bf16_t*)(F.ws + WS_WRL);
    const float* rb = F.in(20);
    unsigned* ctl = (unsigned*)(F.ws + WS_CTL);
    int* LIST = (int*)(F.ws + WS_LIST); float* GATES = (float*)(F.ws + WS_GATES); float* RS2 = (float*)(F.ws + WS_RSTD2); int* POSI = (int*)(F.ws + WS_POSI);
    LAS float* T = (LAS float*)(F.lds);
    LAS float* SS = (LAS float*)(F.lds + 2 * 4 * 32 * 33 * 4);
    LAS unsigned* CNTL = (LAS unsigned*)(F.lds + 2 * 4 * 32 * 33 * 4 + 1024);
    float rbv[8];
#pragma unroll
    for (int j = 0; j < 8; ++j) rbv[j] = rb[8 * (tid & 3) + j];
    for (int blk = F.vcu; blk < MTOK / 128; blk += F.G) {
        const int R0 = blk * 128;
        if (tid < 32) CNTL[tid] = 0u;
        f32x16 acc = f32x16{}; float ssq = 0.f;
        const bf16_t* xrow = x1 + (size_t)(R0 + tl * 32 + r32) * DM + kh * 512 + hi * 8;
        const bf16_t* wh = WRH + r32 * DM + kh * 512 + hi * 8; const bf16_t* wl = WRL + r32 * DM + kh * 512 + hi * 8;
#pragma unroll 8
        for (int s = 0; s < 32; ++s) {
            const u32x4 xa = *(const u32x4*)(xrow + 16 * s);
            const unsigned xw[4] = {xa.x, xa.y, xa.z, xa.w};
#pragma unroll
            for (int j = 0; j < 4; ++j) { const float a = bf2f(xw[j] & 0xffffu), b = bf2f(xw[j] >> 16); ssq += a * a + b * b; }
            const bf16x8 bh = *(const bf16x8*)(wh + 16 * s), bl = *(const bf16x8*)(wl + 16 * s);
            acc = __builtin_amdgcn_mfma_f32_32x32x16_bf16(__builtin_bit_cast(bf16x8, xa), bh, acc, 0, 0, 0);
            acc = __builtin_amdgcn_mfma_f32_32x32x16_bf16(__builtin_bit_cast(bf16x8, xa), bl, acc, 0, 0, 0);
        }
        ssq = add_xor32(ssq);
#pragma unroll
        for (int r = 0; r < 16; ++r) T[((kh * 4 + tl) * 32 + att::crow(r, hi)) * 33 + r32] = acc[r];
        if (hi == 0) SS[(kh * 4 + tl) * 32 + r32] = ssq;
        __syncthreads();
        int ek[4]; float gk[4]; unsigned rk[4] = {0u, 0u, 0u, 0u}; float rstd2;
        const int srow = tid >> 2, sq = tid & 3;
        {
            const int tile = srow >> 5, rr = srow & 31;
            rstd2 = __builtin_amdgcn_rsqf((SS[tile * 32 + rr] + SS[(4 + tile) * 32 + rr]) * (1.0f / DM) + EPS);
            const LAS float* ta = T + (tile * 32 + rr) * 33 + 8 * sq; const LAS float* tb = T + ((4 + tile) * 32 + rr) * 33 + 8 * sq;
            float v[8];
#pragma unroll
            for (int j = 0; j < 8; ++j) v[j] = (ta[j] + tb[j]) * rstd2 + rbv[j];
            float vk[4];
#pragma unroll
            for (int k = 0; k < 4; ++k) { float best = -INFINITY; int be = 8 * sq;
#pragma unroll
                for (int j = 0; j < 8; ++j) if (v[j] > best) { best = v[j]; be = 8 * sq + j; }
                { const float ob = att::dpp_f<0xB1>(best); const int oe = __builtin_amdgcn_update_dpp(0, be, 0xB1, 0xf, 0xf, true); if (ob > best || (ob == best && oe < be)) { best = ob; be = oe; } }
                { const float ob = att::dpp_f<0x4E>(best); const int oe = __builtin_amdgcn_update_dpp(0, be, 0x4E, 0xf, 0xf, true); if (ob > best || (ob == best && oe < be)) { best = ob; be = oe; } }
                ek[k] = be; vk[k] = best;
#pragma unroll
                for (int j = 0; j < 8; ++j) if (be == 8 * sq + j) v[j] = -INFINITY; }
            float den = 0.f;
#pragma unroll
            for (int k = 0; k < 4; ++k) { gk[k] = __expf(vk[k] - vk[0]); den += gk[k]; }
            const float rden = 1.0f / den;
#pragma unroll
            for (int k = 0; k < 4; ++k) { gk[k] *= rden; if (sq == 0) rk[k] = __hip_atomic_fetch_add(CNTL + ek[k], 1u, __ATOMIC_RELAXED, __HIP_MEMORY_SCOPE_WORKGROUP); }
        }
        __syncthreads();
        if (tid < 32) { const unsigned n = CNTL[tid]; CNTL[32 + tid] = n ? atomicAdd(ctl + CW_CNT + 64 * tid, n) : 0u; }
        __syncthreads();
        if (sq == 0) {
            const int tok = R0 + srow;
            RS2[tok] = rstd2;
#pragma unroll
            for (int k = 0; k < 4; ++k) { const int li = (int)(CNTL[32 + ek[k]] + rk[k]); LIST[(size_t)ek[k] * MTOK + li] = tok * 4 + k; GATES[tok * 4 + k] = gk[k]; POSI[tok * 4 + k] = (ek[k] << 15) | li; }
        }
        __syncthreads();
    }
}

constexpr int MOE_MAXS = 24;
struct MoeSched { LAS int* TB; LAS int* TE; LAS int* TAB; int tlo, thi, mt, pn, mpb; };
__device__ __forceinline__ void moe_prefix(Frame& F, LAS int* TB) {
    const unsigned* ctl = (const unsigned*)(F.ws + WS_CTL);
    if (F.tid == 0) { int acc = 0; for (int e = 0; e < NEXP; ++e) { TB[e] = acc; const int c = (int)__hip_atomic_load(ctl + CW_CNT + 64 * e, __ATOMIC_RELAXED, __HIP_MEMORY_SCOPE_AGENT); acc += (c + 255) >> 8; } TB[NEXP] = acc; }
    __syncthreads();
}
template <int NPN, bool TABLE>
__device__ __forceinline__ MoeSched moe_setup(Frame& F) {
    MoeSched M;
    M.TB = (LAS int*)(F.lds + LDS_AUX); M.TE = M.TB + 40; M.TAB = M.TB + 64;
    moe_prefix(F, M.TB);
    const unsigned* ctl = (const unsigned*)(F.ws + WS_CTL);
    const int T = __builtin_amdgcn_readfirstlane(M.TB[NEXP]), x = F.vcu >> 5, i = F.vcu & 31;
    M.mpb = 32 / NPN; M.mt = __builtin_amdgcn_readfirstlane(i / NPN); M.pn = __builtin_amdgcn_readfirstlane(i % NPN);
    M.tlo = __builtin_amdgcn_readfirstlane((x * T) >> 3); M.thi = __builtin_amdgcn_readfirstlane(((x + 1) * T) >> 3);
    const int* LIST = (const int*)(F.ws + WS_LIST); const float* RS2 = (const float*)(F.ws + WS_RSTD2);
    if (TABLE) {
        for (int idx = F.tid; idx < MOE_MAXS * 256; idx += NTHR) {
            const int s = idx >> 8, r = idx & 255, t = M.tlo + s * M.mpb + M.mt;
            int v = 0, e = 0;
            if (t < M.thi) {
                for (int q = 0; q < NEXP; ++q) if (M.TB[q + 1] <= t) e = q + 1;
                const int li = (t - M.TB[e]) * 256 + r; const int c = (int)__hip_atomic_load(ctl + CW_CNT + 64 * e, __ATOMIC_RELAXED, __HIP_MEMORY_SCOPE_AGENT);
                if (li < c) { const int tok = LIST[(size_t)e * MTOK + li] >> 2; v = tok | (int)((f2bf(RS2[tok]) & 0x7fffu) << 15); }
            }
            M.TAB[idx] = v; if (r == 0) M.TE[s] = e;
        }
    } else {
        if (F.tid < MOE_MAXS) { const int t = M.tlo + F.tid * M.mpb + M.mt; int e = 0; if (t < M.thi) { for (int q = 0; q < NEXP; ++q) if (M.TB[q + 1] <= t) e = q + 1; } M.TE[F.tid] = e; }
    }
    __syncthreads();
    return M;
}
struct ProbMoe1 {
    static constexpr bool FP8 = true;
    MoeSched M; const char* A; const char* W; const float* b1; unsigned char* act;
    __device__ __forceinline__ bool next(int s, pg8::Unit& u) const { const int t = __builtin_amdgcn_readfirstlane(M.tlo + s * M.mpb + M.mt); if (s >= MOE_MAXS || t >= __builtin_amdgcn_readfirstlane(M.thi)) return false; u.pn = M.pn; u.pm = t; u.tt = s;
        u.e = __builtin_amdgcn_readfirstlane(M.TE[s]); return true; }
    __device__ __forceinline__ const char* abase(const pg8::Unit&) const { return A; }
    __device__ __forceinline__ void aoff(const pg8::Unit& u, const int (&R)[2], const int (&C)[2], unsigned (&vo)[2][2]) const {
#pragma unroll
        for (int h = 0; h < 2; ++h)
#pragma unroll
            for (int i = 0; i < 2; ++i) vo[h][i] = (unsigned)((M.TAB[u.tt * 256 + h * 128 + R[i]] & 0x7fff) * DM + C[i] * 2);
    }
    __device__ __forceinline__ const char* bptr(const pg8::Unit& u) const { return W + ((size_t)u.e * 2 * DFF + (size_t)u.pn * 256) * DM; }
    __device__ __forceinline__ void epi(f32x4 (&acc)[2][2][4][2], const pg8::Unit& u, int wr, int wc, int fr, int fq) const {
        asm volatile("s_nop 15\n\ts_nop 7" ::: "memory");
        const int rl0 = wr * 64 + fr, cj = u.pn * 128 + wc * 32 + 8 * fq;
        const float* bg = b1 + (size_t)u.e * 2 * DFF + cj; const float* bu = bg + DFF;
        constexpr float CS = -1.702f * LOG2E, KA = ASCALE / CS;
        f32x4 bg0 = *(const f32x4*)bg, bg1 = *(const f32x4*)(bg + 4); const f32x4 bu0 = *(const f32x4*)bu, bu1 = *(const f32x4*)(bu + 4);
        bg0 = bg0 * CS; bg1 = bg1 * CS;
#pragma unroll
        for (int ai = 0; ai < 2; ++ai)
#pragma unroll
            for (int m = 0; m < 4; ++m) { const int rl = rl0 + ai * 128 + m * 16; const float rs = bf2f((unsigned)M.TAB[u.tt * 256 + rl] >> 15) * (1.0f / WSCALE), rsc = rs * CS;
                float a[8];
#pragma unroll
                for (int n = 0; n < 2; ++n)
#pragma unroll
                    for (int jp = 0; jp < 2; ++jp) {
                        const f32x2 ag = {acc[ai][0][m][n][2 * jp], acc[ai][0][m][n][2 * jp + 1]}, au = {acc[ai][1][m][n][2 * jp], acc[ai][1][m][n][2 * jp + 1]};
                        const f32x2 bgp = n ? (f32x2){bg1[2 * jp], bg1[2 * jp + 1]} : (f32x2){bg0[2 * jp], bg0[2 * jp + 1]};
                        const f32x2 bup = n ? (f32x2){bu1[2 * jp], bu1[2 * jp + 1]} : (f32x2){bu0[2 * jp], bu0[2 * jp + 1]};
                        const f32x2 z = ag * (f32x2){rsc, rsc} + bgp, hu = au * (f32x2){rs, rs} + bup;
                        const f32x2 zc = {fmaxf(z.x, 7.0f * CS), fmaxf(z.y, 7.0f * CS)};
                        const f32x2 up = {__builtin_amdgcn_fmed3f(hu.x, -7.0f, 7.0f), __builtin_amdgcn_fmed3f(hu.y, -7.0f, 7.0f)};
                        const f32x2 den = (f32x2){__builtin_amdgcn_exp2f(zc.x), __builtin_amdgcn_exp2f(zc.y)} + (f32x2){1.0f, 1.0f};
                        const f32x2 sg = {__builtin_amdgcn_rcpf(den.x), __builtin_amdgcn_rcpf(den.y)};
                        const f32x2 r = (zc * sg) * (up * (f32x2){KA, KA} + (f32x2){KA, KA});
                        a[4 * n + 2 * jp] = r.x; a[4 * n + 2 * jp + 1] = r.y; }
                u32x2 w; w.x = pack_fp8x4(a[0], a[1], a[2], a[3]); w.y = pack_fp8x4(a[4], a[5], a[6], a[7]);
                *(u32x2*)(act + ((size_t)u.pm * 256 + rl) * DFF + cj) = w; }
    }
};
struct ProbMoe2 {
    static constexpr bool FP8 = true;
    MoeSched M; const char* A; const char* W; const float* b2; unsigned char* ys; LAS unsigned char* lds;
    __device__ __forceinline__ bool next(int s, pg8::Unit& u) const { const int t = __builtin_amdgcn_readfirstlane(M.tlo + s * M.mpb + M.mt); if (s >= MOE_MAXS || t >= __builtin_amdgcn_readfirstlane(M.thi)) return false; u.pn = M.pn; u.pm = t; u.tt = s;
        u.e = __builtin_amdgcn_readfirstlane(M.TE[s]); return true; }
    __device__ __forceinline__ const char* abase(const pg8::Unit& u) const { return A + (size_t)u.pm * 256 * DFF; }
    __device__ __forceinline__ void aoff(const pg8::Unit& u, const int (&R)[2], const int (&C)[2], unsigned (&vo)[2][2]) const {
#pragma unroll
        for (int h = 0; h < 2; ++h)
#pragma unroll
            for (int i = 0; i < 2; ++i) vo[h][i] = (unsigned)((h * 128 + R[i]) * DFF + C[i] * 2);
    }
    __device__ __forceinline__ const char* bptr(const pg8::Unit& u) const { return W + ((size_t)u.e * DM + (size_t)u.pn * 256) * DFF; }
    __device__ __forceinline__ void epi(f32x4 (&acc)[2][2][4][2], const pg8::Unit& u, int wr, int wc, int fr, int fq) const {
        asm volatile("s_nop 15\n\ts_nop 7" ::: "memory");
        const int rl0 = wr * 64 + fr, col0 = u.pn * 256 + wc * 32 + 8 * fq;
        const float* bp = b2 + (size_t)u.e * DM + col0;
        f32x4 bv[2][2];
#pragma unroll
        for (int bj = 0; bj < 2; ++bj) { bv[bj][0] = *(const f32x4*)(bp + bj * 128) * YSCALE; bv[bj][1] = *(const f32x4*)(bp + bj * 128 + 4) * YSCALE; }
        constexpr float sc = YSCALE / (WSCALE * ASCALE);
        char* tbase = (char*)ys + ((size_t)u.pm * 256) * DM + u.pn * 256;
        const int tid = (wr * 4 + wc) * 64 + fq * 16 + fr;
#pragma unroll
        for (int ai = 0; ai < 2; ++ai)
#pragma unroll
            for (int mh = 0; mh < 2; ++mh) { const int c = ai * 2 + mh; LAS unsigned char* buf = lds + ((c & 1) ? STG_BUF1 : STG_BUF0);
#pragma unroll
                for (int ml = 0; ml < 2; ++ml) { const int m = mh * 2 + ml, rl = ml * 32 + wr * 16 + fr;
#pragma unroll
                    for (int bj = 0; bj < 2; ++bj) { const f32x4 v0 = acc[ai][bj][m][0] * sc + bv[bj][0], v1 = acc[ai][bj][m][1] * sc + bv[bj][1];
                        u32x2 w; w.x = pack_fp8x4(v0[0], v0[1], v0[2], v0[3]); w.y = pack_fp8x4(v1[0], v1[1], v1[2], v1[3]);
                        const int slot = bj * 16 + wc * 4 + fq;
                        *(LAS u32x2*)(buf + rl * 256 + ((slot ^ ((rl & 7) << 1)) << 3)) = w; } }
                asm volatile("s_waitcnt lgkmcnt(0)" ::: "memory"); __builtin_amdgcn_s_barrier(); asm volatile("" ::: "memory");
#pragma unroll
                for (int j = 0; j < 2; ++j) { const int p = tid + 512 * j, r2 = p >> 4, pi = p & 15;
                    const u32x4 v = *(const LAS u32x4*)(buf + r2 * 256 + (((2 * pi) ^ ((r2 & 7) << 1)) << 3));
                    const int trow = ai * 128 + ((r2 >> 4) & 1) * 64 + (mh * 2 + (r2 >> 5)) * 16 + (r2 & 15);
                    *(u32x4*)(tbase + (size_t)trow * DM + pi * 16) = v; } }
    }
};
static_assert(256 + MOE_MAXS * 256 * 4 <= 32768 - 512, "MoE tables fit the AUX region");

__device__ __forceinline__ void p8_combine(Frame& F) {
    const int gw = F.vcu * NWAVES + F.wave, NGW = F.G * NWAVES;
    LAS int* TB = (LAS int*)(F.lds + LDS_AUX);
    moe_prefix(F, TB);
    const unsigned char* YS = F.ws + WS_YB; const int* POSI = (const int*)(F.ws + WS_POSI); const float* GATES = (const float*)(F.ws + WS_GATES);
    const bf16_t* X1H = (const bf16_t*)(F.ws + WS_X1H);
    for (int m = gw; m < MTOK; m += NGW) {
        f32x4* op = (f32x4*)(F.out + (size_t)m * DM) + F.lane;
        const u32x2* xp = (const u32x2*)(X1H + (size_t)m * DM) + F.lane;
        const int pv = POSI[m * 4 + (F.lane & 3)]; const float gv = GATES[m * 4 + (F.lane & 3)] * (1.0f / YSCALE);
        f32x4 v[4];
#pragma unroll
        for (int j = 0; j < 4; ++j) { const u32x2 w = xp[64 * j]; v[j].x = bf2f(w.x & 0xffffu); v[j].y = bf2f(w.x >> 16); v[j].z = bf2f(w.y & 0xffffu); v[j].w = bf2f(w.y >> 16); }
#pragma unroll
        for (int k = 0; k < 4; ++k) { const int p = __builtin_amdgcn_readlane(pv, k); const float g = __builtin_bit_cast(float, __builtin_amdgcn_readlane(__builtin_bit_cast(int, gv), k));
            const int pos = TB[p >> 15] * 256 + (p & 32767);
            const unsigned* yp = (const unsigned*)(YS + (size_t)pos * DM) + F.lane;
#pragma unroll
            for (int j = 0; j < 4; ++j) { const unsigned w = yp[64 * j]; const f32x2 lo = __builtin_amdgcn_cvt_pk_f32_fp8(w, false), hi2 = __builtin_amdgcn_cvt_pk_f32_fp8(w, true);
                v[j].x += g * lo.x; v[j].y += g * lo.y; v[j].z += g * hi2.x; v[j].w += g * hi2.y; } }
#pragma unroll
        for (int j = 0; j < 4; ++j) op[64 * j] = v[j];
    }
}

typedef GAS unsigned gu32;
#define XB_TMO      128
#define XB_XCNT(j)  (256  + 64 * (j))
#define XB_XSUB(j)  (1280 + 64 * (j))
#define XB_XGEN(j)  (2304 + 64 * (j))
#define XB_TOP      3328
#define XB_TOPGEN   3392
#define XCD_BAR_WORDS 3456
#define XB_SPIN_CAP (1u << 20)
__device__ __forceinline__ unsigned xb_ld(unsigned* p)              { return __hip_atomic_load(p, __ATOMIC_RELAXED, __HIP_MEMORY_SCOPE_AGENT); }
__device__ __forceinline__ unsigned xb_add(unsigned* p, unsigned v) { return __hip_atomic_fetch_add(p, v, __ATOMIC_RELAXED, __HIP_MEMORY_SCOPE_AGENT); }
__device__ __forceinline__ unsigned xb_xcc_id() { return (unsigned)__builtin_amdgcn_s_getreg((3 << 11) | 20) & 0xFu; }
#define XB_SPIN(cond, bar) do { unsigned _sp = 0; while (cond) { __builtin_amdgcn_s_sleep(1); \
    if ((++_sp & 255u) == 0u) { if (xb_ld(&(bar)[XB_TMO])) break; if (_sp > XB_SPIN_CAP) { atomicAdd(&(bar)[XB_TMO], 1u); break; } } } } while (0)
struct XcdBarrier { unsigned* bar; unsigned x; volatile LAS unsigned* st; };
__device__ __forceinline__ XcdBarrier xcd_barrier_post(unsigned* bar, volatile LAS unsigned* st) {
    XcdBarrier b; b.bar = bar; b.x = xb_xcc_id(); b.st = st;
    if (threadIdx.x == 0) (void)xb_add(&bar[XB_XCNT(b.x)], 1u);
    return b;
}
__device__ __forceinline__ void xcd_barrier_complete(unsigned* bar, unsigned x, unsigned& nloc, unsigned& nx) {
    const unsigned G = gridDim.x * gridDim.y * gridDim.z;
    unsigned sum, cnt, mine, sp = 0u;
    for (;;) {
        sum = 0u; cnt = 0u; mine = 0u;
#pragma unroll
        for (unsigned j = 0; j < 16; ++j) { const unsigned c = xb_ld(&bar[XB_XCNT(j)]); sum += c; cnt += (c > 0u) ? 1u : 0u; mine = (j == x) ? c : mine; }
        if (sum == G) break;
        __builtin_amdgcn_s_sleep(1);
        if ((++sp & 255u) == 0u) { if (xb_ld(&bar[XB_TMO])) break; if (sp > XB_SPIN_CAP) { atomicAdd(&bar[XB_TMO], 1u); break; } }
    }
    nloc = mine > 0u ? mine : 1u; nx = cnt > 0u ? cnt : 1u;
}
__device__ __forceinline__ void xcd_barrier(const XcdBarrier& b) {
    asm volatile("s_waitcnt vmcnt(0)" ::: "memory");
    __syncthreads();
    if (threadIdx.x == 0) {
        unsigned* bar = b.bar;
        __builtin_amdgcn_s_waitcnt(0);
        unsigned nloc = b.st[0], nx = b.st[1];
        if (nloc == 0u) { xcd_barrier_complete(bar, b.x, nloc, nx); b.st[0] = nloc; b.st[1] = nx; }
        const unsigned old = xb_add(&bar[XB_XSUB(b.x)], 1u);
        const unsigned gen = old / nloc;
        if (old + 1u == (gen + 1u) * nloc) {
            __builtin_amdgcn_fence(__ATOMIC_RELEASE, "agent");
            asm volatile("s_waitcnt vmcnt(0)" ::: "memory");
            const unsigned og = xb_add(&bar[XB_TOP], 1u);
            const unsigned tg = og / nx;
            if (og + 1u == (tg + 1u) * nx) xb_add(&bar[XB_TOPGEN], 1u);
            else XB_SPIN(xb_ld(&bar[XB_TOPGEN]) == tg, bar);
            __builtin_amdgcn_fence(__ATOMIC_ACQUIRE, "agent");
            xb_add(&bar[XB_XGEN(b.x)], 1u);
            asm volatile("s_waitcnt vmcnt(0)" ::: "memory");
        } else {
            XB_SPIN(xb_ld(&bar[XB_XGEN(b.x)]) == gen, bar);
            __builtin_amdgcn_fence(__ATOMIC_ACQUIRE, "agent");
            asm volatile("s_waitcnt vmcnt(0)" ::: "memory");
        }
    }
    __syncthreads();
}

struct Args { const float* in[25]; float* out; unsigned char* ws; int ph_lo, ph_hi; };
__global__ void __launch_bounds__(NTHR, 2) mk_fwd(Args args) {
    extern __shared__ __attribute__((aligned(16))) unsigned char lds_raw[];
    Frame F;
    F.lds = (LAS unsigned char*)lds_raw; F.ws = args.ws; F.out = args.out;
    F.kin = (karg_ptr_t)__builtin_amdgcn_kernarg_segment_ptr();
    F.tid = threadIdx.x; F.lane = F.tid & 63; F.wave = __builtin_amdgcn_readfirstlane(F.tid >> 6);
    F.G = gridDim.x; { const int bx = blockIdx.x; F.vcu = (F.G % 8 == 0) ? (bx % 8) * (F.G / 8) + bx / 8 : bx; }
    const int lo = args.ph_lo, hi = args.ph_hi;
    { volatile LAS unsigned* MISC = (volatile LAS unsigned*)(F.lds + LDS_MISC); if (F.tid < 64) MISC[F.tid] = 0u; }
    __syncthreads();
    XcdBarrier bar; bar.bar = (unsigned*)(F.ws + WS_CTL) + CW_BAR; bar.x = 0; bar.st = nullptr;
    if (hi - lo > 1) bar = xcd_barrier_post((unsigned*)(F.ws + WS_CTL) + CW_BAR, (volatile LAS unsigned*)(F.lds + LDS_MISC) + 8);
#define IN(k) (lo <= (k) && (k) < hi)
#define SEAM(k) do { if (IN(k) && ((k) == 2 ? IN(4) : IN((k) + 1))) xcd_barrier(bar); } while (0)
    if (IN(0)) { p0_prologue(F); }
    SEAM(0);
    if (IN(1)) {
        ProbInProj P; P.S.init(MTOK, DIN, F.G, (int)blockIdx.x); P.A = (const char*)(F.ws + WS_XB); P.Bt = (const char*)(F.ws + WS_WIN); P.rstd1 = (const float*)(F.ws + WS_RSTD1);
        P.dst0 = (bf16_t*)(F.ws + WS_XR); P.qg = F.in(10); P.kg = F.in(11); P.xs = (LAS float*)(F.lds + LDS_AUX); P.lds = F.lds;
        pg8::gemm_phase<decltype(P), true>(F.lds, P);
    }
    SEAM(1);
    if (IN(2)) { att::mixer_phase(F); }
    SEAM(2);
    if (IN(4)) {
        ProbOutProj P; P.S.init(MTOK, DM, F.G, (int)blockIdx.x); P.A = (const char*)(F.ws + WS_Y); P.Bt = (const char*)(F.ws + WS_WOUT); P.xb = (const bf16_t*)(F.ws + WS_XB); P.x1h = (bf16_t*)(F.ws + WS_X1H); P.x1q = F.ws + WS_X1B; P.lds = F.lds;
        pg8::gemm_phase<decltype(P), true>(F.lds, P);
    }
    SEAM(4);
    if (IN(5)) { p5_router(F); }
    SEAM(5);
    if (IN(6)) {
        ProbMoe1 P; P.M = moe_setup<8, true>(F); P.A = (const char*)(F.ws + WS_X1B); P.W = (const char*)(F.ws + WS_W1); P.b1 = F.in(22); P.act = F.ws + WS_ACT;
        pg8::gemm_phase<decltype(P), true>(F.lds, P);
    }
    SEAM(6);
    if (IN(7)) {
        ProbMoe2 P; P.M = moe_setup<4, false>(F); P.A = (const char*)(F.ws + WS_ACT); P.W = (const char*)(F.ws + WS_W2); P.b2 = F.in(24); P.ys = F.ws + WS_YB; P.lds = F.lds;
        pg8::gemm_phase<decltype(P), true>(F.lds, P);
    }
    SEAM(7);
    if (IN(8)) { p8_combine(F); }
#undef IN
#undef SEAM
}

extern "C" void kernel_launch(void* const* d_in, const int* in_sizes, int n_in, void* d_out, int out_size, void* d_ws, size_t ws_size, hipStream_t stream) {
    static int grid = 0;
    if (grid == 0) {
        if (n_in != 25 || in_sizes[0] != MTOK * DM || out_size != MTOK * DM || ws_size < WS_END) {
            fprintf(stderr, "kernel_launch: unexpected problem (n_in %d, in0 %d, out %d, ws %zu); nothing launched\n", n_in, n_in > 0 ? in_sizes[0] : -1, out_size, ws_size); grid = -1; return; }
        int dev = 0, cus = 0, per_cu = 0;
        if (hipGetDevice(&dev) != hipSuccess || hipDeviceGetAttribute(&cus, hipDeviceAttributeMultiprocessorCount, dev) != hipSuccess) { grid = -1; return; }
        if (hipFuncSetAttribute((const void*)mk_fwd, hipFuncAttributeMaxDynamicSharedMemorySize, LDS_BYTES) != hipSuccess) { fprintf(stderr, "kernel_launch: hipFuncSetAttribute failed\n"); grid = -1; return; }
        if (hipOccupancyMaxActiveBlocksPerMultiprocessor(&per_cu, (const void*)mk_fwd, NTHR, LDS_BYTES) != hipSuccess || per_cu < 1) { fprintf(stderr, "kernel_launch: occupancy query says %d blocks/CU for %d B of LDS: the grid barrier needs every workgroup resident; nothing launched\n", per_cu, LDS_BYTES); (void)hipGetLastError(); grid = -1; return; }
        (void)hipGetLastError();
        grid = cus;
        if (grid != 256) { fprintf(stderr, "kernel_launch: built for a 256-CU device (got %d)\n", cus); grid = -1; return; }
    }
    if (grid < 0) return;
    (void)hipMemsetAsync((char*)d_ws + WS_CTL, 0, CTL_BYTES, stream);
    Args a{};
    for (int i = 0; i < 25; ++i) a.in[i] = (const float*)d_in[i];
    a.out = (float*)d_out; a.ws = (unsigned char*)d_ws;
#if MK_N_LAUNCHES == 1
    a.ph_lo = 0; a.ph_hi = NPHASE;
    hipLaunchKernelGGL(mk_fwd, dim3(grid), dim3(NTHR), LDS_BYTES, stream, a);
#else
    for (int p = 0; p < NPHASE; ++p) { a.ph_lo = p; a.ph_hi = p + 1; hipLaunchKernelGGL(mk_fwd, dim3(grid), dim3(NTHR), LDS_BYTES, stream, a); }
#endif
}
```

```cpp
#include <hip/hip_runtime.h>
#include <cstdio>
#include <cstdint>

#define LAS __attribute__((address_space(3)))
#define GAS __attribute__((address_space(1)))
typedef unsigned short bf16_t;
typedef short bf16x8 __attribute__((ext_vector_type(8)));
typedef short s16x4 __attribute__((ext_vector_type(4)));
typedef float f32x4 __attribute__((ext_vector_type(4)));
typedef float f32x2 __attribute__((ext_vector_type(2)));
typedef float f32x16 __attribute__((ext_vector_type(16)));
typedef unsigned u32x4 __attribute__((ext_vector_type(4)));
typedef unsigned u32x2 __attribute__((ext_vector_type(2)));

#ifndef MK_N_LAUNCHES
#define MK_N_LAUNCHES 1
#endif
constexpr int NPHASE = 9;

constexpr int NB = 16, SEQ = 2048, DM = 1024, MTOK = NB * SEQ;
constexpr int DIN = 2560, DRNN = 512, NEXP = 32, TOPK = 4, DFF = 1024, NASG = MTOK * TOPK;
constexpr float EPS = 1e-5f;
constexpr float LOG2E = 1.4426950408889634f;
constexpr int NWAVES = 8, NTHR = 512;
constexpr float YSCALE = 8.0f;
constexpr float WSCALE = 32.0f, ASCALE = 4.0f;

constexpr size_t MiB = (size_t)1 << 20;
constexpr size_t WS_CTL = 0, CTL_BYTES = 64 * 1024;
constexpr size_t WS_WIN = 2 * MiB;
constexpr size_t WS_WOUT = 8 * MiB;
constexpr size_t WS_WRH = 10 * MiB, WS_WRL = WS_WRH + 65536;
constexpr size_t WS_WAT = WS_WRH + 2 * 65536, WS_WXT = WS_WAT + 65536;
constexpr size_t WS_RSTD1 = 11 * MiB, WS_RSTD2 = WS_RSTD1 + 131072 * 2;
constexpr size_t WS_GATES = 12 * MiB;
constexpr size_t WS_POSI = 13 * MiB;
constexpr size_t WS_LIST = 16 * MiB;
constexpr size_t WS_W1 = 32 * MiB;
constexpr size_t WS_W2 = 160 * MiB;
constexpr size_t WS_XB = 224 * MiB;
constexpr size_t WS_XR = 288 * MiB, WS_GG = 320 * MiB, WS_Q = 352 * MiB, WS_K = 384 * MiB, WS_V = 416 * MiB;
constexpr size_t WS_Y = 448 * MiB;
constexpr size_t WS_X1B = 512 * MiB;
constexpr size_t WS_X1H = 712 * MiB;
constexpr size_t WS_ACT = 576 * MiB;
constexpr size_t WS_YB = 224 * MiB;
constexpr size_t WS_END = 848 * MiB;
constexpr int MAXTILES = NASG / 256 + NEXP;
constexpr int CW_TMO = 0, CW_QUEUE = 512, CW_CNT = 1024  , CW_BAR = 8192;

constexpr int RING_BYTES = 131072;
constexpr int LDS_AUX = RING_BYTES;
constexpr int LDS_MISC = RING_BYTES + 32768 - 256;
constexpr int LDS_BYTES = 163840;

__device__ __forceinline__ unsigned f2bf(float f) { unsigned u = __builtin_bit_cast(unsigned, f); return (u + 0x7fffu + ((u >> 16) & 1u)) >> 16; }
__device__ __forceinline__ float bf2f(unsigned h) { return __builtin_bit_cast(float, h << 16); }
typedef __bf16 bf16x2_t __attribute__((ext_vector_type(2)));
__device__ __forceinline__ unsigned cvt_pk_bf16(float lo, float hi) { f32x2 v = {lo, hi}; bf16x2_t b = __builtin_convertvector(v, bf16x2_t); return __builtin_bit_cast(unsigned, b); }
__device__ __forceinline__ unsigned pk2(float lo, float hi) { return cvt_pk_bf16(lo, hi); }
__device__ __forceinline__ void swap_rows16(unsigned& a, unsigned& b) { asm("s_nop 1\n\tv_permlane16_swap_b32 %0, %1" : "+v"(a), "+v"(b)); }
__device__ __forceinline__ void swap_rows32(unsigned& a, unsigned& b) { asm("s_nop 1\n\tv_permlane32_swap_b32 %0, %1" : "+v"(a), "+v"(b)); }
__device__ __forceinline__ float add_xor16(float v) { unsigned a = __builtin_bit_cast(unsigned, v), b = a; swap_rows16(a, b); return __builtin_bit_cast(float, a) + __builtin_bit_cast(float, b); }
__device__ __forceinline__ float add_xor32(float v) { unsigned a = __builtin_bit_cast(unsigned, v), b = a; swap_rows32(a, b); return __builtin_bit_cast(float, a) + __builtin_bit_cast(float, b); }
__device__ __forceinline__ float wave_sum(float v) {
#pragma unroll
    for (int o = 1; o < 64; o <<= 1) v += __shfl_xor(v, o);
    return v;
}
__device__ __forceinline__ float fast_sigmoid(float x) { return __builtin_amdgcn_rcpf(1.0f + __builtin_amdgcn_exp2f(-x * LOG2E)); }
__device__ __forceinline__ f32x4 gelu_tanh4(f32x4 x) {
    constexpr float A = -2.0f * 0.7978845608028654f * LOG2E, B = A * 0.044715f;
    const f32x4 t = (x * x * B + A) * x;
    const f32x4 d = (f32x4){__builtin_amdgcn_exp2f(t[0]), __builtin_amdgcn_exp2f(t[1]), __builtin_amdgcn_exp2f(t[2]), __builtin_amdgcn_exp2f(t[3])} + 1.0f;
    return x * (f32x4){__builtin_amdgcn_rcpf(d[0]), __builtin_amdgcn_rcpf(d[1]), __builtin_amdgcn_rcpf(d[2]), __builtin_amdgcn_rcpf(d[3])};
}
__device__ __forceinline__ unsigned pack_fp8x4(float a, float b, float c, float d) { unsigned t = 0; t = __builtin_amdgcn_cvt_pk_fp8_f32(a, b, t, false); t = __builtin_amdgcn_cvt_pk_fp8_f32(c, d, t, true); return t; }
#define LDS_WAIT() asm volatile("s_waitcnt lgkmcnt(0)" ::: "memory")
#define VM_WAIT() asm volatile("s_waitcnt vmcnt(0)" ::: "memory")

typedef const float* const volatile __attribute__((address_space(4))) * karg_ptr_t;
struct Frame {
    LAS unsigned char* lds;
    unsigned char* ws;
    int tid, lane, wave, vcu, G;
    karg_ptr_t kin;
    float* out;
    __device__ __forceinline__ const float* in(int i) const { return kin[i]; }
};

namespace pg8 {
constexpr int BM = 256, BK = 64, HALF = 128, HTB = HALF * BK * 2, KD = 1024, NT = KD / BK;
__device__ __forceinline__ int lds_byte(int r, int c) { const int st = (r >> 4) * 2 + (c >> 5), rr = r & 15, cc = c & 31, ob = rr * 64 + cc * 2; return st * 1024 + (ob ^ (((ob >> 9) & 1) << 5)); }
__device__ __forceinline__ void stage_rc(int b, int& R, int& C) { const int st = b / 1024, sb = b % 1024, swz = sb ^ (((sb >> 9) & 1) << 5); R = (st >> 1) * 16 + swz / 64; C = (st & 1) * 32 + (swz % 64) / 2; }
__device__ __forceinline__ int perm32(int rho) { const int n = rho >> 4, i = rho & 15; return 8 * (i >> 2) + 4 * n + (i & 3); }
struct Unit { int pm, pn, e, tt; };

typedef int v4i_t __attribute__((ext_vector_type(4)));
typedef int v8i_t __attribute__((ext_vector_type(8)));
__device__ __forceinline__ v8i_t cat8(bf16x8 a, bf16x8 b) { return __builtin_shufflevector(__builtin_bit_cast(v4i_t, a), __builtin_bit_cast(v4i_t, b), 0, 1, 2, 3, 4, 5, 6, 7); }
template <class Prob, bool ALIGN_EPI>
__device__ __forceinline__ void gemm_phase(LAS unsigned char* lds, const Prob& P) {
    const int tid = threadIdx.x, wid = __builtin_amdgcn_readfirstlane(tid >> 6), lane = tid & 63, wr = wid >> 2, wc = wid & 3, fr = lane & 15, fq = lane >> 4;
    constexpr int K = Prob::FP8 ? KD / 2 : KD, nt = Prob::FP8 ? NT / 2 : NT;
    unsigned voffB[2];
#pragma unroll
    for (int i = 0; i < 2; ++i) { int R_, C_; stage_rc(tid * 16 + i * 8192, R_, C_); const int Rb = (R_ & ~31) + perm32(R_ & 31); voffB[i] = (unsigned)(Rb * K + C_) * 2u; }
    constexpr size_t kstep = (size_t)(BK * 2);
    constexpr size_t hstepB = (size_t)HALF * K * 2;
    const unsigned ldsw = (unsigned)wid * 1024u;
    const int aoff = lds_byte(wr * 64 + fr, fq * 8), boff = lds_byte(wc * 32 + fr, fq * 8);
#define PG8_SA(b, h) (((b) * 2 + (h)) * HTB)
#define PG8_SB(b, h) ((4 + (b) * 2 + (h)) * HTB)
#define PG8_STAGE(bufoff, gbase, voff) do { _Pragma("unroll") for (int _i = 0; _i < 2; ++_i) \
        __builtin_amdgcn_global_load_lds((const unsigned*)((const char*)(gbase) + (voff)[_i]), (LAS unsigned*)(lds + (bufoff) + ldsw + _i * 8192), 16, 0, 0); } while (0)
#define PG8_RD(off) (*(const LAS bf16x8*)(lds + (off)))
#define PG8_LDA(dst, b, h) do { _Pragma("unroll") for (int m = 0; m < 4; ++m) { if constexpr (Prob::FP8) dst##8[m] = cat8(PG8_RD(PG8_SA(b, h) + aoff + m * 2048), PG8_RD(PG8_SA(b, h) + aoff + m * 2048 + 1024)); \
        else { _Pragma("unroll") for (int k = 0; k < 2; ++k) dst[m][k] = PG8_RD(PG8_SA(b, h) + aoff + m * 2048 + k * 1024); } } } while (0)
#define PG8_LDB(dst, b, h) do { _Pragma("unroll") for (int n = 0; n < 2; ++n) { if constexpr (Prob::FP8) dst##8[n] = cat8(PG8_RD(PG8_SB(b, h) + boff + n * 2048), PG8_RD(PG8_SB(b, h) + boff + n * 2048 + 1024)); \
        else { _Pragma("unroll") for (int k = 0; k < 2; ++k) dst[n][k] = PG8_RD(PG8_SB(b, h) + boff + n * 2048 + k * 1024); } } } while (0)
#define PG8_MMA(ai, bj, At, Bt) do { __builtin_amdgcn_s_setprio(1); _Pragma("unroll") for (int m = 0; m < 4; ++m) _Pragma("unroll") for (int n = 0; n < 2; ++n) { \
        if constexpr (Prob::FP8) asm volatile("s_nop 1\n\tv_mfma_f32_16x16x128_f8f6f4 %0, %1, %2, %0" : "+v"(acc[ai][bj][m][n]) : "v"(Bt##8[n]), "v"(At##8[m])); \
        else { _Pragma("unroll") for (int k = 0; k < 2; ++k) acc[ai][bj][m][n] = __builtin_amdgcn_mfma_f32_16x16x32_bf16(Bt[n][k], At[m][k], acc[ai][bj][m][n], 0, 0, 0); } } \
        __builtin_amdgcn_s_setprio(0); } while (0)
#define PG8_WAIT_V(n) asm volatile("s_waitcnt vmcnt(" #n ")" ::: "memory")
#define PG8_WAIT_L(n) asm volatile("s_waitcnt lgkmcnt(" #n ")" ::: "memory")
#define PG8_BAR __builtin_amdgcn_s_barrier()
#define PG8_SCHED __builtin_amdgcn_sched_barrier(0)
    Unit cur, nxt; int ui = 0;
    if (!P.next(0, cur)) return;
    f32x4 acc[2][2][4][2];
#pragma unroll
    for (int a = 0; a < 2; ++a)
#pragma unroll
        for (int b = 0; b < 2; ++b)
#pragma unroll
            for (int m = 0; m < 4; ++m)
#pragma unroll
                for (int n = 0; n < 2; ++n) acc[a][b][m][n] = (f32x4){0.f, 0.f, 0.f, 0.f};
    bf16x8 At[4][2], B0[2][2], B1[2][2]; v8i_t At8[4], B08[2], B18[2]; (void)At; (void)B0; (void)B1; (void)At8; (void)B08; (void)B18;
    unsigned vo[2][2];
    { int R[2], C[2]; stage_rc(tid * 16, R[0], C[0]); stage_rc(tid * 16 + 8192, R[1], C[1]); P.aoff(cur, R, C, vo); }
    const char* cA = P.abase(cur);
    const char* cB = P.bptr(cur);
    PG8_STAGE(PG8_SB(0, 0), cB, voffB); PG8_STAGE(PG8_SB(0, 1), cB + hstepB, voffB); PG8_STAGE(PG8_SA(0, 0), cA, vo[0]); PG8_STAGE(PG8_SA(0, 1), cA, vo[1]);
    if (wr == 1) PG8_BAR;
    PG8_WAIT_V(2); PG8_BAR;
    PG8_STAGE(PG8_SB(1, 0), cB + kstep, voffB); PG8_STAGE(PG8_SA(1, 0), cA + kstep, vo[0]); PG8_STAGE(PG8_SB(1, 1), cB + hstepB + kstep, voffB);
    PG8_WAIT_V(6); PG8_BAR;
    for (;;) {
        const bool has_next = P.next(ui + 1, nxt);
        const char* nB = has_next ? P.bptr(nxt) : cB;
        const char* nA = has_next ? P.abase(nxt) : cA;
#pragma nounroll
        for (int t = 0; t < nt; t += 2) {
            const bool last = (t == nt - 2);
            const char* a1 = cA + (size_t)(t + 1) * kstep;
            const char* a2 = last ? nA : cA + (size_t)(t + 2) * kstep; const char* b2 = last ? nB : cB + (size_t)(t + 2) * kstep;
            const char* a3 = a2 + kstep; const char* b3 = b2 + kstep;
            unsigned w2[2][2];
#pragma unroll
            for (int h = 0; h < 2; ++h)
#pragma unroll
                for (int i = 0; i < 2; ++i) w2[h][i] = vo[h][i];
            if (last && has_next) { int R[2], C[2]; stage_rc(tid * 16, R[0], C[0]); stage_rc(tid * 16 + 8192, R[1], C[1]); P.aoff(nxt, R, C, w2); }
            PG8_LDB(B0, 0, 0); PG8_LDB(B1, 0, 1); PG8_SCHED; PG8_LDA(At, 0, 0); PG8_STAGE(PG8_SA(1, 1), a1, vo[1]);
            PG8_WAIT_V(8); PG8_WAIT_L(0); PG8_BAR; PG8_MMA(0, 0, At, B0); PG8_MMA(0, 1, At, B1); PG8_BAR; PG8_SCHED;
            PG8_LDA(At, 0, 1); PG8_STAGE(PG8_SB(0, 0), b2, voffB); PG8_STAGE(PG8_SB(0, 1), b2 + hstepB, voffB); PG8_STAGE(PG8_SA(0, 0), a2, w2[0]);
            PG8_WAIT_V(8); PG8_WAIT_L(0); PG8_BAR; PG8_MMA(1, 0, At, B0); PG8_MMA(1, 1, At, B1); PG8_BAR; PG8_SCHED;
            PG8_LDB(B0, 1, 0); PG8_LDB(B1, 1, 1); PG8_SCHED; PG8_LDA(At, 1, 0); PG8_STAGE(PG8_SA(0, 1), a2, w2[1]);
            PG8_WAIT_V(8); PG8_WAIT_L(0); PG8_BAR; PG8_MMA(0, 0, At, B0); PG8_MMA(0, 1, At, B1); PG8_BAR; PG8_SCHED;
            PG8_LDA(At, 1, 1); PG8_STAGE(PG8_SB(1, 0), b3, voffB); PG8_STAGE(PG8_SB(1, 1), b3 + hstepB, voffB); PG8_STAGE(PG8_SA(1, 0), a3, w2[0]);
            PG8_WAIT_V(8); PG8_WAIT_L(0); PG8_BAR; PG8_MMA(1, 0, At, B0); PG8_MMA(1, 1, At, B1); PG8_BAR; PG8_SCHED;
        }
        if constexpr (ALIGN_EPI) { if (wr == 0) PG8_BAR; }
        { int fr_ = fr, fq_ = fq; asm volatile("" : "+v"(fr_), "+v"(fq_)); P.epi(acc, cur, wr, wc, fr_, fq_); }
        if (!has_next) break;
#pragma unroll
        for (int a = 0; a < 2; ++a)
#pragma unroll
            for (int b = 0; b < 2; ++b)
#pragma unroll
                for (int m = 0; m < 4; ++m)
#pragma unroll
                    for (int n = 0; n < 2; ++n) acc[a][b][m][n] = (f32x4){0.f, 0.f, 0.f, 0.f};
        cur = nxt; cB = nB; cA = nA; ++ui;
        { int R[2], C[2]; stage_rc(tid * 16, R[0], C[0]); stage_rc(tid * 16 + 8192, R[1], C[1]); P.aoff(cur, R, C, vo); }
        if constexpr (ALIGN_EPI) { if (wr == 1) PG8_BAR; }
    }
    PG8_WAIT_V(0);
    if constexpr (!ALIGN_EPI) { if (wr == 0) PG8_BAR; }
    PG8_BAR;
#undef PG8_SA
#undef PG8_SB
#undef PG8_STAGE
#undef PG8_LDA
#undef PG8_RD
#undef PG8_LDB
#undef PG8_MMA
#undef PG8_SCHED
}
struct StaticOrder {
    int nM, nN, nwg, G, c;
    __device__ void init(int M, int N, int G_, int c_) { nM = M / BM; nN = N / BM; nwg = nM * nN; G = G_; c = c_; }
    __device__ bool next(int i, int& pm, int& pn) const {
        const long L = (long)i * G + c; if (L >= nwg) return false;
        int wgid = (int)L; { const int q = nwg / 8, r = nwg % 8, xcd = wgid % 8, off = wgid / 8; wgid = (xcd < r ? xcd * (q + 1) : r * (q + 1) + (xcd - r) * q) + off; }
        const int nig = 8 * nN, gid = wgid / nig, fm = gid * 8, gsz = (nM - fm) < 8 ? (nM - fm) : 8;
        pm = fm + ((wgid % nig) % gsz); pn = (wgid % nig) / gsz; return true;
    }
};
}

__device__ __forceinline__ void p0_transpose_item(const float* W, int K, int N, bf16_t* WT, int out_row0, const float* g, LAS float* scr, int kb, int nb, int lane) {
    const int k0 = 64 * kb, n0 = 32 * nb;
#pragma unroll
    for (int i = 0; i < 8; ++i) { const int kk = 8 * i + (lane >> 3), c4 = lane & 7;
        *(LAS f32x4*)(scr + kk * 36 + ((4 * c4 + 4 * (kk >> 3)) & 31)) = __builtin_nontemporal_load((const f32x4*)(W + (size_t)(k0 + kk) * N + n0 + 4 * c4)); }
    LDS_WAIT(); asm volatile("" ::: "memory");
    const int c = lane & 7;
    float gv[8];
#pragma unroll
    for (int q = 0; q < 8; ++q) gv[q] = g ? g[k0 + 8 * c + q] : 1.0f;
#pragma unroll
    for (int j = 0; j < 4; ++j) { const int n = (lane >> 3) + 8 * j; const LAS float* s = scr + (8 * c) * 36 + ((n + 4 * c) & 31);
        u32x4 o; o.x = pk2(s[0 * 36] * gv[0], s[1 * 36] * gv[1]); o.y = pk2(s[2 * 36] * gv[2], s[3 * 36] * gv[3]); o.z = pk2(s[4 * 36] * gv[4], s[5 * 36] * gv[5]); o.w = pk2(s[6 * 36] * gv[6], s[7 * 36] * gv[7]);
        *(u32x4*)(WT + (size_t)(out_row0 + n) * K + k0 + 8 * c) = o; }
    LDS_WAIT(); asm volatile("" ::: "memory");
}
__device__ __forceinline__ void p0_prologue(Frame& F) {
    LAS float* scr = (LAS float*)(F.lds + F.wave * 16384);
    const int gw = F.vcu * NWAVES + F.wave, NGW = F.G * NWAVES;
    const float* x = F.in(0); const float* g1 = F.in(1); const float* w_in = F.in(2); const float* w_out = F.in(17); const float* g2 = F.in(18);
    bf16_t* WIN = (bf16_t*)(F.ws + WS_WIN); bf16_t* WOUT = (bf16_t*)(F.ws + WS_WOUT);
    constexpr int I_IN = 16 * 80, I_OUT = 16 * 32;
    constexpr int NITEMS = I_IN + I_OUT;
    for (int it = gw; it < NITEMS; it += NGW) {
        int r = it;
        if (r < I_IN) { const int kb = r / 80, nb = r % 80; p0_transpose_item(w_in, DM, DIN, WIN, 32 * nb, g1, scr, kb, nb, F.lane); continue; } r -= I_IN;
        { const int kb = r / 32, nb = r % 32; p0_transpose_item(w_out, DM, DM, WOUT, 32 * nb, nullptr, scr, kb, nb, F.lane); }
    }
    {
        const float* rw = F.in(19); bf16_t* WRH = (bf16_t*)(F.ws + WS_WRH); bf16_t* WRL = (bf16_t*)(F.ws + WS_WRL);
        const float* wa = F.in(5); const float* wx = F.in(7); bf16_t* WAT = (bf16_t*)(F.ws + WS_WAT); bf16_t* WXT = (bf16_t*)(F.ws + WS_WXT);
        const int gt = F.vcu * NTHR + F.tid, NGT = F.G * NTHR;
        for (int i = gt; i < 32768; i += NGT) {
            { const int n = i >> 10, k = i & 1023; const float v = rw[k * NEXP + n] * g2[k]; const unsigned h = f2bf(v); WRH[i] = (bf16_t)h; WRL[i] = (bf16_t)f2bf(v - bf2f(h)); }
            { const int nblk = i >> 12, j = (i >> 6) & 63, ii = i & 63; WAT[i] = (bf16_t)f2bf(wa[(nblk * 64 + ii) * 64 + j]); WXT[i] = (bf16_t)f2bf(wx[(nblk * 64 + ii) * 64 + j]); }
        }
    }
    {
        bf16_t* XB = (bf16_t*)(F.ws + WS_XB); float* RS1 = (float*)(F.ws + WS_RSTD1);
        for (int m = gw; m < MTOK; m += NGW) {
            const f32x4* xr = (const f32x4*)(x + (size_t)m * DM) + F.lane;
            f32x4 v[4]; float s = 0.f;
#pragma unroll
            for (int j = 0; j < 4; ++j) { v[j] = __builtin_nontemporal_load(&xr[64 * j]); s += (v[j].x * v[j].x + v[j].y * v[j].y) + (v[j].z * v[j].z + v[j].w * v[j].w); }
            s = wave_sum(s);
            if (F.lane == 0) RS1[m] = 1.0f / sqrtf(s * (1.0f / DM) + EPS);
            u32x2* o8 = (u32x2*)(XB + (size_t)m * DM) + F.lane;
#pragma unroll
            for (int j = 0; j < 4; ++j) { u32x2 w; w.x = pk2(v[j].x, v[j].y); w.y = pk2(v[j].z, v[j].w); o8[64 * j] = w; }
        }
    }
}

constexpr int STG_BUF0 = 3 * pg8::HTB, STG_BUF1 = LDS_AUX + 8192;
struct RowStager {
    LAS unsigned char* lds; int wr, wc, fr, fq, tid;
    template <class RowPtr> __device__ __forceinline__ void chunk(int c, u32x4 w0, u32x4 w1, const RowPtr& rowp) const {
        LAS unsigned char* buf = lds + ((c & 1) ? STG_BUF1 : STG_BUF0);
        const int rl = wr * 16 + fr, p0 = wc * 4 + fq;
        *(LAS u32x4*)(buf + rl * 512 + ((p0 ^ (rl & 7)) << 4)) = w0;
        *(LAS u32x4*)(buf + rl * 512 + (((16 + p0) ^ (rl & 7)) << 4)) = w1;
        asm volatile("s_waitcnt lgkmcnt(0)" ::: "memory"); __builtin_amdgcn_s_barrier(); asm volatile("" ::: "memory");
        const int ai = c >> 2, m = c & 3;
#pragma unroll
        for (int j = 0; j < 2; ++j) { const int p = tid + 512 * j, r2 = p >> 5, pi = p & 31;
            const u32x4 v = *(const LAS u32x4*)(buf + r2 * 512 + ((pi ^ (r2 & 7)) << 4));
            *(u32x4*)(rowp(ai * 128 + (r2 >> 4) * 64 + m * 16 + (r2 & 15)) + pi * 16) = v; }
    }
};

struct ProbInProj {
    static constexpr bool FP8 = false;
    pg8::StaticOrder S; const char* A; const char* Bt; const float* rstd1; bf16_t* dst0; const float* qg; const float* kg; LAS float* xs; LAS unsigned char* lds;
    __device__ __forceinline__ bool next(int i, pg8::Unit& u) const { u.e = 0; u.tt = 0; return S.next(i, u.pm, u.pn); }
    __device__ __forceinline__ const char* abase(const pg8::Unit& u) const { return A + (size_t)u.pm * 256 * DM * 2; }
    __device__ __forceinline__ void aoff(const pg8::Unit& u, const int (&R)[2], const int (&C)[2], unsigned (&vo)[2][2]) const {
#pragma unroll
        for (int h = 0; h < 2; ++h)
#pragma unroll
            for (int i = 0; i < 2; ++i) vo[h][i] = (unsigned)((h * 128 + R[i]) * DM + C[i]) * 2u;
    }
    __device__ __forceinline__ const char* bptr(const pg8::Unit& u) const { return Bt + (size_t)u.pn * 256 * DM * 2; }
    __device__ __forceinline__ void epi(f32x4 (&acc)[2][2][4][2], const pg8::Unit& u, int wr, int wc, int fr, int fq) const {
        const int type = u.pn >> 1;
        bf16_t* dst = dst0 + (size_t)type * ((WS_GG - WS_XR) / 2);
        const int row0 = u.pm * 256 + wr * 64 + fr, col0 = (u.pn & 1) * 256 + wc * 32 + 8 * fq;
        float rs[2][4];
#pragma unroll
        for (int ai = 0; ai < 2; ++ai)
#pragma unroll
            for (int m = 0; m < 4; ++m) rs[ai][m] = rstd1[row0 + ai * 128 + m * 16];
#pragma unroll
        for (int ai = 0; ai < 2; ++ai)
#pragma unroll
            for (int bj = 0; bj < 2; ++bj)
#pragma unroll
                for (int m = 0; m < 4; ++m)
#pragma unroll
                    for (int n = 0; n < 2; ++n) acc[ai][bj][m][n] = acc[ai][bj][m][n] * rs[ai][m];
        if (type == 1) {
#pragma unroll
            for (int ai = 0; ai < 2; ++ai)
#pragma unroll
                for (int bj = 0; bj < 2; ++bj)
#pragma unroll
                    for (int m = 0; m < 4; ++m)
#pragma unroll
                        for (int n = 0; n < 2; ++n) acc[ai][bj][m][n] = gelu_tanh4(acc[ai][bj][m][n]);
        }
        if (type == 2 || type == 3) {
            const int lane = fq * 16 + fr; (void)lane;
            float ss[2][4][2];
#pragma unroll
            for (int ai = 0; ai < 2; ++ai)
#pragma unroll
                for (int m = 0; m < 4; ++m)
#pragma unroll
                    for (int bj = 0; bj < 2; ++bj) { const f32x4 a = acc[ai][bj][m][0], b = acc[ai][bj][m][1]; const f32x4 q = a * a + b * b;
                        float s = (q[0] + q[1]) + (q[2] + q[3]);
                        s = add_xor16(s); s = add_xor32(s); ss[ai][m][bj] = s; }
            LAS float* mine = xs + ((wr * 4 + wc) * 8) * 32; LAS float* other = xs + ((wr * 4 + (wc ^ 1)) * 8) * 32;
            if (fq == 0) {
#pragma unroll
                for (int ai = 0; ai < 2; ++ai)
#pragma unroll
                    for (int m = 0; m < 4; ++m) { f32x2 w; w.x = ss[ai][m][0]; w.y = ss[ai][m][1]; *(LAS f32x2*)(mine + ((ai * 4 + m) * 16 + fr) * 2) = w; }
            }
            asm volatile("s_waitcnt lgkmcnt(0)" ::: "memory"); __builtin_amdgcn_s_barrier(); asm volatile("" ::: "memory");
            const float* g = (type == 2) ? qg : kg; const float sc = (type == 2) ? 0.125f * LOG2E : 1.0f;
            f32x4 gv[2];
#pragma unroll
            for (int n = 0; n < 2; ++n) gv[n] = *(const f32x4*)(g + 32 * (wc & 1) + 8 * fq + 4 * n) * sc;
#pragma unroll
            for (int ai = 0; ai < 2; ++ai)
#pragma unroll
                for (int m = 0; m < 4; ++m) { const f32x2 o = *(const LAS f32x2*)(other + ((ai * 4 + m) * 16 + fr) * 2);
#pragma unroll
                    for (int bj = 0; bj < 2; ++bj) { const float tot = ss[ai][m][bj] + (bj == 0 ? o.x : o.y); const float r = __builtin_amdgcn_rsqf(tot * (1.0f / 64.0f) + EPS);
#pragma unroll
                        for (int n = 0; n < 2; ++n) acc[ai][bj][m][n] = acc[ai][bj][m][n] * (gv[n] * r); } }
        }
        { const RowStager ST{lds, wr, wc, fr, fq, (wr * 4 + wc) * 64 + fq * 16 + fr};
          char* tbase = (char*)(dst + (size_t)u.pm * 256 * 512 + (u.pn & 1) * 256);
          auto rowp = [tbase](int r) { return tbase + (size_t)r * 1024; };
#pragma unroll
          for (int ai = 0; ai < 2; ++ai)
#pragma unroll
              for (int m = 0; m < 4; ++m) { u32x4 w[2];
#pragma unroll
                  for (int bj = 0; bj < 2; ++bj) { const f32x4 v0 = acc[ai][bj][m][0], v1 = acc[ai][bj][m][1];
                      w[bj].x = cvt_pk_bf16(v0[0], v0[1]); w[bj].y = cvt_pk_bf16(v0[2], v0[3]); w[bj].z = cvt_pk_bf16(v1[0], v1[1]); w[bj].w = cvt_pk_bf16(v1[2], v1[3]); }
                  ST.chunk(ai * 4 + m, w[0], w[1], rowp); } }
    }
};

__device__ __forceinline__ void conv_unit(Frame& F, int cu) {
    int lane = F.lane; asm volatile("" : "+v"(lane));
    const int wave = F.wave;
    LAS float* scr = (LAS float*)(F.lds + wave * 16384);
    const bool first = cu < 512;
    const int e = first ? (cu >> 4) : ((cu - 512) >> 3);
    const float* W = first ? F.in(21) + (size_t)e * DM * 2 * DFF : F.in(23) + (size_t)e * DFF * DM;
    unsigned char* WT = first ? F.ws + WS_W1 + (size_t)e * 2 * DFF * DM : F.ws + WS_W2 + (size_t)e * DM * DFF;
    const int N = first ? 2 * DFF : DM;
    const int c = lane & 3;
    float gv[16];
    { const float* g2 = F.in(18);
#pragma unroll
      for (int q = 0; q < 16; ++q) gv[q] = first ? g2[64 * (cu & 15) + 16 * c + q] * WSCALE : WSCALE; }
#define CV_GEOM(j, k0_, n0_, or_) do { const int idx_ = 8 * (j) + wave; \
        if (first) { k0_ = 64 * (cu & 15); n0_ = 32 * idx_; const int j0_ = n0_ & 1023; or_ = 256 * (j0_ >> 7) + (j0_ & 127) + ((n0_ >= 1024) ? 128 : 0); } \
        else { k0_ = 64 * (2 * ((cu - 512) & 7) + (idx_ >> 5)); n0_ = 32 * (idx_ & 31); or_ = n0_; } } while (0)
#define CV_LOAD(LD, k0_, n0_) do { _Pragma("unroll") for (int i = 0; i < 8; ++i) { const int kk = 8 * i + (lane >> 3), c4 = lane & 7; \
        LD[i] = __builtin_nontemporal_load((const f32x4*)(W + (size_t)((k0_) + kk) * N + (n0_) + 4 * c4)); } } while (0)
#define CV_ITEM(LD, j) do { \
        _Pragma("unroll") for (int i = 0; i < 8; ++i) { const int kk = 8 * i + (lane >> 3), c4 = lane & 7; \
            *(LAS f32x4*)(scr + kk * 36 + ((4 * c4 + 4 * (kk >> 3)) & 31)) = LD[i]; }         \
        int k0c, n0c, orc; CV_GEOM(j, k0c, n0c, orc); (void)n0c; \
        if ((j) + 2 < 8) { int k0n, n0n, orn; CV_GEOM((j) + 2, k0n, n0n, orn); (void)orn; CV_LOAD(LD, k0n, n0n); } \
        LDS_WAIT(); asm volatile("" ::: "memory"); \
        _Pragma("unroll") for (int j2 = 0; j2 < 2; ++j2) { const int n = (lane >> 2) + 16 * j2; const LAS float* sp = scr + (16 * c) * 36; \
            const int nc0 = (n + 8 * c) & 31, nc1 = (n + 8 * c + 4) & 31;           \
            unsigned w[4]; \
            _Pragma("unroll") for (int q = 0; q < 4; ++q) { unsigned t = 0; const int nc = (q < 2) ? nc0 : nc1; \
                t = __builtin_amdgcn_cvt_pk_fp8_f32(sp[(4 * q) * 36 + nc] * gv[4 * q], sp[(4 * q + 1) * 36 + nc] * gv[4 * q + 1], t, false); \
                t = __builtin_amdgcn_cvt_pk_fp8_f32(sp[(4 * q + 2) * 36 + nc] * gv[4 * q + 2], sp[(4 * q + 3) * 36 + nc] * gv[4 * q + 3], t, true); w[q] = t; } \
            *(u32x4*)(WT + (size_t)(orc + n) * 1024 + k0c + 16 * c) = (u32x4){w[0], w[1], w[2], w[3]}; } \
        LDS_WAIT(); asm volatile("" ::: "memory"); } while (0)
    f32x4 lda[8], ldb[8];
    { int k0, n0, orow; CV_GEOM(0, k0, n0, orow); (void)orow; CV_LOAD(lda, k0, n0); CV_GEOM(1, k0, n0, orow); CV_LOAD(ldb, k0, n0); }
    CV_ITEM(lda, 0); CV_ITEM(ldb, 1); CV_ITEM(lda, 2); CV_ITEM(ldb, 3); CV_ITEM(lda, 4); CV_ITEM(ldb, 5); CV_ITEM(lda, 6); CV_ITEM(ldb, 7);
#undef CV_ITEM
#undef CV_GEOM
#undef CV_LOAD
}

__device__ __forceinline__ void rglru_item(Frame& F, int item) {
    const int bb = item >> 3, nb = item & 7;
    int tid = F.tid; asm volatile("" : "+v"(tid));
    const int lane = tid & 63, wid = F.wave;
    const bf16_t* XR = (const bf16_t*)(F.ws + WS_XR); const bf16_t* GG = (const bf16_t*)(F.ws + WS_GG); bf16_t* Y = (bf16_t*)(F.ws + WS_Y);
    const float* conv_w = F.in(3); const float* conv_b = F.in(4); const float* ba = F.in(6); const float* bx = F.in(8); const float* lam = F.in(9);
    const bf16_t* WAT = (const bf16_t*)(F.ws + WS_WAT); const bf16_t* WXT = (const bf16_t*)(F.ws + WS_WXT);
    LAS bf16_t* XCb = (LAS bf16_t*)(F.lds);
    LAS float* XCf = (LAS float*)(F.lds + 9216);
    LAS float* RGl = (LAS float*)(F.lds + 9216 + 16384);
    LAS float* SEG = (LAS float*)(F.lds + 9216 + 16384 + 32768);
    LAS float* HC = (LAS float*)(F.lds + 9216 + 16384 + 32768 + 4096);
    const int ct = tid >> 3, cg = tid & 7, chb = nb * 64 + 8 * cg;
    float cw[4][8], cb[8];
#pragma unroll
    for (int j = 0; j < 4; ++j)
#pragma unroll
        for (int c = 0; c < 8; ++c) cw[j][c] = conv_w[j * DRNN + chb + c];
#pragma unroll
    for (int c = 0; c < 8; ++c) cb[c] = conv_b[chb + c];
    const int g = wid >> 2, mt = wid & 3, l15 = lane & 15, kq = lane >> 4;
    bf16x8 Bf[4][2];
    { const bf16_t* WT = (g == 0 ? WAT : WXT) + nb * 4096;
#pragma unroll
      for (int ntl = 0; ntl < 4; ++ntl)
#pragma unroll
          for (int ks = 0; ks < 2; ++ks) Bf[ntl][ks] = *(const bf16x8*)(WT + (16 * ntl + l15) * 64 + 32 * ks + 8 * kq); }
    float gbias[4];
#pragma unroll
    for (int ntl = 0; ntl < 4; ++ntl) gbias[ntl] = (g == 0 ? ba : bx)[nb * 64 + 16 * ntl + l15];
    const int sc = tid & 63, sg = tid >> 6;
    const float sp8 = 8.0f * log1pf(expf(-lam[nb * 64 + sc]));
    if (tid < 64) HC[tid] = 0.f;
    const size_t rowbase = (size_t)bb * SEQ;
    u32x4 xv[4];
#pragma unroll
    for (int j = 0; j < 4; ++j) { const int t = ct - 3 + j; xv[j] = (t >= 0) ? *(const u32x4*)(XR + (rowbase + t) * DRNN + chb) : (u32x4){0u, 0u, 0u, 0u}; }
    for (int c = 0; c < SEQ / 64; ++c) {
        const int t0 = 64 * c;
        {
            float xc[8];
#pragma unroll
            for (int q = 0; q < 8; ++q) xc[q] = cb[q];
#pragma unroll
            for (int j = 0; j < 4; ++j) { const unsigned w[4] = {xv[j].x, xv[j].y, xv[j].z, xv[j].w};
#pragma unroll
                for (int q = 0; q < 4; ++q) { xc[2 * q] += cw[j][2 * q] * bf2f(w[q] & 0xffffu); xc[2 * q + 1] += cw[j][2 * q + 1] * bf2f(w[q] >> 16); } }
            if (c + 1 < SEQ / 64) {
#pragma unroll
                for (int j = 0; j < 4; ++j) xv[j] = *(const u32x4*)(XR + (rowbase + t0 + 64 + ct - 3 + j) * DRNN + chb);
            }
            u32x4 pb; pb.x = pk2(xc[0], xc[1]); pb.y = pk2(xc[2], xc[3]); pb.z = pk2(xc[4], xc[5]); pb.w = pk2(xc[6], xc[7]);
            *(LAS u32x4*)(XCb + ct * 72 + 8 * cg) = pb;
            *(LAS f32x4*)(XCf + ct * 64 + 8 * cg) = (f32x4){xc[0], xc[1], xc[2], xc[3]};
            *(LAS f32x4*)(XCf + ct * 64 + 8 * cg + 4) = (f32x4){xc[4], xc[5], xc[6], xc[7]};
        }
        unsigned short gq[8];
#pragma unroll
        for (int s8 = 0; s8 < 8; ++s8) gq[s8] = GG[(rowbase + t0 + 8 * sg + s8) * DRNN + nb * 64 + sc];
        __syncthreads();
        {
            bf16x8 Af[2];
#pragma unroll
            for (int ks = 0; ks < 2; ++ks) Af[ks] = *(const LAS bf16x8*)(XCb + (16 * mt + l15) * 72 + 32 * ks + 8 * kq);
#pragma unroll
            for (int ntl = 0; ntl < 4; ++ntl) {
                f32x4 d = (f32x4){0.f, 0.f, 0.f, 0.f};
#pragma unroll
                for (int ks = 0; ks < 2; ++ks) d = __builtin_amdgcn_mfma_f32_16x16x32_bf16(Af[ks], Bf[ntl][ks], d, 0, 0, 0);
#pragma unroll
                for (int r = 0; r < 4; ++r) RGl[g * 4096 + (16 * mt + 4 * kq + r) * 64 + 16 * ntl + l15] = fast_sigmoid(d[r] + gbias[ntl]);
            }
        }
        __syncthreads();
        float av[8], uv[8]; float Aseg = 1.f, Hseg = 0.f;
#pragma unroll
        for (int s8 = 0; s8 < 8; ++s8) { const int tok = 8 * sg + s8;
            const float r = RGl[tok * 64 + sc], ig = RGl[4096 + tok * 64 + sc], xcv = XCf[tok * 64 + sc];
            const float la = -sp8 * r, y2 = 2.0f * la;
            const float a = __expf(la);
            const float om = (y2 > -0.1f) ? -y2 * (1.0f + y2 * (0.5f + y2 * (0.16666667f + y2 * 0.041666668f))) : (1.0f - __expf(y2));
            const float u = __builtin_amdgcn_sqrtf(om) * (ig * xcv);
            av[s8] = a; uv[s8] = u; Aseg *= a; Hseg = a * Hseg + u; }
        SEG[(sg * 64 + sc) * 2] = Aseg; SEG[(sg * 64 + sc) * 2 + 1] = Hseg;
        __syncthreads();
        float h = HC[(c & 1) * 64 + sc];
        for (int s2 = 0; s2 < sg; ++s2) h = SEG[(s2 * 64 + sc) * 2] * h + SEG[(s2 * 64 + sc) * 2 + 1];
#pragma unroll
        for (int s8 = 0; s8 < 8; ++s8) { h = av[s8] * h + uv[s8]; Y[(rowbase + t0 + 8 * sg + s8) * DM + nb * 64 + sc] = (bf16_t)f2bf(h * bf2f(gq[s8])); }
        if (sg == 7) HC[((c + 1) & 1) * 64 + sc] = h;
    }
    __syncthreads();
}

namespace att {
constexpr float ATT_THR = 8.0f;
constexpr int LK0 = 0, LK1 = 8192, LV = 16384, LBUF = 32768  , LWS = 98304, LOX = 0;
__device__ __forceinline__ int crow(int r, int hi) { return (r & 3) + 8 * (r >> 2) + 4 * hi; }
__device__ __forceinline__ void glds16(const void* gsrc, unsigned lds_dst) { unsigned keep;
    asm volatile("s_mov_b32 %0, m0\n\ts_mov_b32 m0, %2\n\ts_nop 0\n\tglobal_load_lds_dwordx4 %1, off\n\ts_mov_b32 m0, %0" : "=&s"(keep) : "v"(gsrc), "s"(lds_dst) : "memory"); }
typedef __attribute__((address_space(3))) const char* lds_cptr;
typedef short v4i16_t __attribute__((ext_vector_type(4)));
__device__ __forceinline__ s16x4 vtr(lds_cptr p) { return __builtin_bit_cast(s16x4, __builtin_amdgcn_ds_read_tr16_b64_v4i16((__attribute__((address_space(3))) v4i16_t*)p)); }
template <int CTRL> __device__ __forceinline__ float dpp_f(float x) { return __int_as_float(__builtin_amdgcn_update_dpp(0, __float_as_int(x), CTRL, 0xf, 0xf, true)); }
__device__ __forceinline__ float rowmax_pos(const f32x16& p0, const f32x16& p1) {
    int a = 0, b = 0;
#pragma unroll
    for (int r = 0; r < 16; r += 2) { a = max(max(a, __float_as_int(p0[r])), __float_as_int(p0[r + 1])); b = max(max(b, __float_as_int(p1[r])), __float_as_int(p1[r + 1])); }
    a = max(a, b);
    unsigned ua = (unsigned)a, ub = ua; swap_rows32(ua, ub);
    return __int_as_float(max((int)ua, (int)ub));
}
__device__ __forceinline__ void attn_unit(Frame& F, int b, int h, int qb, float lam) {
    int lane = F.lane; asm volatile("" : "+v"(lane));
    const int r32 = lane & 31, hi = lane >> 5, wid = F.wave, mp = wid >> 2, wq = wid & 3;
    const bf16_t* Q = (const bf16_t*)(F.ws + WS_Q); const bf16_t* K = (const bf16_t*)(F.ws + WS_K); const bf16_t* V = (const bf16_t*)(F.ws + WS_V); bf16_t* Y = (bf16_t*)(F.ws + WS_Y);
    const float* subg = F.in(16);
    char* shm = (char*)F.lds;
    const unsigned lds0 = (unsigned)(uintptr_t)shm;
    const size_t rowbase = (size_t)b * SEQ; const int q0 = qb * 128;
    const int NT = 2 * (qb + 1);
    float* wsf = (float*)(shm + LWS) + wid * 64;
    bf16x8 qr[4];
    { const bf16_t* Qw = Q + (rowbase + q0 + wq * 32 + r32) * 512 + h * 128 + mp * 64;
#pragma unroll
      for (int d0 = 0; d0 < 4; ++d0) qr[d0] = *(const bf16x8*)(Qw + d0 * 16 + hi * 8); }
    const bf16_t* ks0 = K + (rowbase + lane) * 512 + h * 128 + wid * 8;
    const bf16_t* ks1 = ks0 + 64;
    const bf16_t* vs0 = V + (rowbase + 16 * (wid & 3) + (lane >> 2)) * 512 + h * 128 + (wid >> 2) * 32 + (lane & 3) * 8;
    const bf16_t* vs1 = vs0 + 64;
    const unsigned kd0 = (unsigned)__builtin_amdgcn_readfirstlane(lds0 + LK0 + wid * 1024), kd1 = (unsigned)__builtin_amdgcn_readfirstlane(lds0 + LK1 + wid * 1024);
    const unsigned vd0 = (unsigned)__builtin_amdgcn_readfirstlane(lds0 + LV + wid * 1024), vd1 = (unsigned)__builtin_amdgcn_readfirstlane(lds0 + LV + (wid + 8) * 1024);
    const lds_cptr shm3 = (lds_cptr)(F.lds);
    const lds_cptr kp0 = shm3 + (mp ? LK1 : LK0) + hi * 1024 + r32 * 16;
    const lds_cptr vp0 = shm3 + LV + ((lane >> 4) & 1) * 32 + (lane & 3) * 8 + (4 * hi + ((lane & 15) >> 2)) * 64;
    f32x16 negm = f32x16{}; asm volatile("" : "+v"(negm));
    float m_run = 0.f, l_run = 0.f;
    f32x16 o[4];
#pragma unroll
    for (int d = 0; d < 4; ++d) o[d] = f32x16{};
    const int qrel = wq * 32 + r32;
    glds16(ks0, kd0); glds16(ks1, kd1); glds16(vs0, vd0); glds16(vs1, vd1);
    asm volatile("" : "+v"(qr[0]), "+v"(qr[1]), "+v"(qr[2]), "+v"(qr[3]));
    f32x16 p0, p1;
    u32x4 pw[4];
    int bcur = 0, bprev = 0, bnext = LBUF;
#define ATT_QK(P0, P1, slot) do { _Pragma("unroll") for (int d0 = 0; d0 < 4; ++d0) { \
        const bf16x8 k0f = *(const __attribute__((address_space(3))) bf16x8*)(kp0 + (slot) + d0 * 2048); \
        const bf16x8 k1f = *(const __attribute__((address_space(3))) bf16x8*)(kp0 + (slot) + d0 * 2048 + 512); \
        if (d0 == 0) { P0 = __builtin_amdgcn_mfma_f32_32x32x16_bf16(k0f, qr[0], negm, 0, 0, 0); P1 = __builtin_amdgcn_mfma_f32_32x32x16_bf16(k1f, qr[0], negm, 0, 0, 0); } \
        else { P0 = __builtin_amdgcn_mfma_f32_32x32x16_bf16(k0f, qr[d0], P0, 0, 0, 0); P1 = __builtin_amdgcn_mfma_f32_32x32x16_bf16(k1f, qr[d0], P1, 0, 0, 0); } } } while (0)
#define ATT_MASK(P0, P1, t) do { if ((t) >= NT - 2) { const int kb_ = 64 * ((t) - (NT - 2)) + 4 * hi; \
        _Pragma("unroll") for (int r = 0; r < 16; ++r) { const int kv = kb_ + (r & 3) + 8 * (r >> 2); if (kv > qrel) P0[r] = -INFINITY; if (kv + 32 > qrel) P1[r] = -INFINITY; } } } while (0)
#define ATT_SUMPACK(P0, P1) do { float sacc = 0.f; _Pragma("unroll") for (int r = 0; r < 16; ++r) sacc += P0[r] + P1[r]; l_run += sacc; \
        pw[0] = (u32x4){cvt_pk_bf16(P0[0], P0[1]), cvt_pk_bf16(P0[2], P0[3]), cvt_pk_bf16(P0[4], P0[5]), cvt_pk_bf16(P0[6], P0[7])}; \
        pw[1] = (u32x4){cvt_pk_bf16(P0[8], P0[9]), cvt_pk_bf16(P0[10], P0[11]), cvt_pk_bf16(P0[12], P0[13]), cvt_pk_bf16(P0[14], P0[15])}; \
        pw[2] = (u32x4){cvt_pk_bf16(P1[0], P1[1]), cvt_pk_bf16(P1[2], P1[3]), cvt_pk_bf16(P1[4], P1[5]), cvt_pk_bf16(P1[6], P1[7])}; \
        pw[3] = (u32x4){cvt_pk_bf16(P1[8], P1[9]), cvt_pk_bf16(P1[10], P1[11]), cvt_pk_bf16(P1[12], P1[13]), cvt_pk_bf16(P1[14], P1[15])}; } while (0)
#define ATT_PV(slot) do { _Pragma("unroll") for (int db = 0; db < 4; ++db) { _Pragma("unroll") for (int ks = 0; ks < 4; ++ks) { \
        const s16x4 lo = vtr(vp0 + (slot) + db * 4096 + ks * 1024), hh = vtr(vp0 + (slot) + db * 4096 + ks * 1024 + 512); \
        const bf16x8 vf = (bf16x8){lo[0], lo[1], lo[2], lo[3], hh[0], hh[1], hh[2], hh[3]}; \
        o[db] = __builtin_amdgcn_mfma_f32_32x32x16_bf16(__builtin_bit_cast(bf16x8, pw[ks]), vf, o[db], 0, 0, 0); } } } while (0)
#define ATT_DECIDE(P0, P1, moved) do { const float rm = rowmax_pos(P0, P1); moved = false; \
        if (__any(rm > ATT_THR)) { const float dl = rm; m_run += dl; \
            _Pragma("unroll") for (int r = 0; r < 16; ++r) { P0[r] -= dl; P1[r] -= dl; negm[r] = -m_run; } \
            asm volatile("" : "+v"(negm)); \
            const float f = __builtin_amdgcn_exp2f(-dl); l_run *= f; if (hi == 0) wsf[r32] = f; moved = true; } } while (0)
#define ATT_RESCALE_O() do { asm volatile("s_waitcnt lgkmcnt(0)" ::: "memory"); _Pragma("unroll") for (int r = 0; r < 16; ++r) { const float fr_ = wsf[crow(r, hi)]; \
        _Pragma("unroll") for (int d = 0; d < 4; ++d) o[d][r] *= fr_; } } while (0)
    asm volatile("s_waitcnt vmcnt(0) lgkmcnt(0)" ::: "memory"); __builtin_amdgcn_s_barrier(); asm volatile("" ::: "memory");
    { const size_t go = (size_t)1 * 64 * 512; glds16(ks0 + go, kd0 + LBUF); glds16(ks1 + go, kd1 + LBUF); glds16(vs0 + go, vd0 + LBUF); glds16(vs1 + go, vd1 + LBUF); }
    ATT_QK(p0, p1, 0); ATT_MASK(p0, p1, 0);
    { bool moved; ATT_DECIDE(p0, p1, moved); (void)moved; }
#pragma unroll
    for (int r = 0; r < 16; ++r) { p0[r] = __builtin_amdgcn_exp2f(p0[r]); p1[r] = __builtin_amdgcn_exp2f(p1[r]); }
    bprev = 0; bcur = LBUF; bnext = 2 * LBUF;
#define SBAR() __builtin_amdgcn_sched_barrier(0)
#define PIN1(x) asm volatile("" : "+v"(x))
#define KRD(j, slot) (*(const __attribute__((address_space(3))) bf16x8*)(kp0 + (slot) + ((j) >> 1) * 2048 + ((j) & 1) * 512))
#define VRDF(i, slot) do { vlo[(i) % 3] = vtr(vp0 + (slot) + ((i) >> 2) * 4096 + ((i) & 3) * 1024); vhi[(i) % 3] = vtr(vp0 + (slot) + ((i) >> 2) * 4096 + ((i) & 3) * 1024 + 512); } while (0)
#define VFRG(i) (bf16x8){vlo[(i) % 3][0], vlo[(i) % 3][1], vlo[(i) % 3][2], vlo[(i) % 3][3], vhi[(i) % 3][0], vhi[(i) % 3][1], vhi[(i) % 3][2], vhi[(i) % 3][3]}
#define GAPA(j, N0, N1, slot, PA, B, PWW, W0, W1) do { \
        if ((j) == 0) N0 = __builtin_amdgcn_mfma_f32_32x32x16_bf16(kf[0], qr[0], negm, 0, 0, 0); \
        else if ((j) == 1) N1 = __builtin_amdgcn_mfma_f32_32x32x16_bf16(kf[1], qr[0], negm, 0, 0, 0); \
        else if (((j) & 1) == 0) N0 = __builtin_amdgcn_mfma_f32_32x32x16_bf16(kf[(j) % 3], qr[(j) >> 1], N0, 0, 0, 0); \
        else N1 = __builtin_amdgcn_mfma_f32_32x32x16_bf16(kf[(j) % 3], qr[(j) >> 1], N1, 0, 0, 0); \
        if ((j) + 2 < 8) kf[((j) + 2) % 3] = KRD((j) + 2, slot); \
        sacc += PA[B]; sacc += PA[B + 1]; sacc += PA[B + 2]; sacc += PA[B + 3]; PIN1(sacc); \
        PWW[W0] = cvt_pk_bf16(PA[B], PA[B + 1]); PWW[W1] = cvt_pk_bf16(PA[B + 2], PA[B + 3]); PIN1(PWW); SBAR(); } while (0)
#define GAPB(i, slot, X, NX, B) do { \
        o[(i) >> 2] = __builtin_amdgcn_mfma_f32_32x32x16_bf16(__builtin_bit_cast(bf16x8, pw[(i) & 3]), VFRG(i), o[(i) >> 2], 0, 0, 0); \
        if ((i) + 2 < 16) VRDF((i) + 2, slot); \
        X[B] = __builtin_amdgcn_exp2f(NX[B]); X[B + 1] = __builtin_amdgcn_exp2f(NX[B + 1]); PIN1(X); SBAR(); } while (0)
#define ATT_STEP(t, MASKED) do { \
        asm volatile("s_waitcnt vmcnt(0) lgkmcnt(0)" ::: "memory"); \
        __builtin_amdgcn_s_barrier(); \
        asm volatile("" ::: "memory"); \
        if ((t) + 1 < NT) { const size_t go = (size_t)((t) + 1) * 64 * 512; const unsigned b1 = (unsigned)bnext; \
            glds16(ks0 + go, kd0 + b1); glds16(ks1 + go, kd1 + b1); glds16(vs0 + go, vd0 + b1); glds16(vs1 + go, vd1 + b1); } \
        SBAR(); \
        f32x16 n0, n1; bf16x8 kf[3]; s16x4 vlo[3], vhi[3]; float sacc = 0.f; u32x4 q0_, q1_, q2_, q3_; \
        kf[0] = KRD(0, bcur); kf[1] = KRD(1, bcur); SBAR(); \
        GAPA(0, n0, n1, bcur, p0, 0, q0_, 0, 1); GAPA(1, n0, n1, bcur, p0, 4, q0_, 2, 3); GAPA(2, n0, n1, bcur, p0, 8, q1_, 0, 1); GAPA(3, n0, n1, bcur, p0, 12, q1_, 2, 3); \
        GAPA(4, n0, n1, bcur, p1, 0, q2_, 0, 1); GAPA(5, n0, n1, bcur, p1, 4, q2_, 2, 3); GAPA(6, n0, n1, bcur, p1, 8, q3_, 0, 1); GAPA(7, n0, n1, bcur, p1, 12, q3_, 2, 3); \
        l_run += sacc; pw[0] = q0_; pw[1] = q1_; pw[2] = q2_; pw[3] = q3_; \
        VRDF(0, bprev); VRDF(1, bprev); SBAR();                         \
        if (MASKED) ATT_MASK(n0, n1, t); \
        bool moved; ATT_DECIDE(n0, n1, moved); \
        SBAR(); \
        GAPB(0, bprev, p0, n0, 0); GAPB(1, bprev, p0, n0, 2); GAPB(2, bprev, p0, n0, 4); GAPB(3, bprev, p0, n0, 6); \
        GAPB(4, bprev, p0, n0, 8); GAPB(5, bprev, p0, n0, 10); GAPB(6, bprev, p0, n0, 12); GAPB(7, bprev, p0, n0, 14); \
        GAPB(8, bprev, p1, n1, 0); GAPB(9, bprev, p1, n1, 2); GAPB(10, bprev, p1, n1, 4); GAPB(11, bprev, p1, n1, 6); \
        GAPB(12, bprev, p1, n1, 8); GAPB(13, bprev, p1, n1, 10); GAPB(14, bprev, p1, n1, 12); GAPB(15, bprev, p1, n1, 14); \
        if (moved) ATT_RESCALE_O(); \
        bprev = bcur; bcur = bnext; bnext = (bnext == 2 * LBUF) ? 0 : bnext + LBUF; } while (0)
    { int t = 1;
      for (; t < NT - 2; ++t) ATT_STEP(t, false);
      for (; t < NT; ++t) ATT_STEP(t, true); }
#undef ATT_STEP
#undef GAPA
#undef GAPB
#undef KRD
#undef VRDF
#undef VFRG
#undef SBAR
#undef PIN1
    ATT_SUMPACK(p0, p1);
    ATT_PV(bprev);
#undef ATT_QK
#undef ATT_MASK
#undef ATT_SUMPACK
#undef ATT_PV
#undef ATT_DECIDE
#undef ATT_RESCALE_O
    l_run = add_xor32(l_run);
    if (hi == 0) wsf[32 + r32] = l_run;
    asm volatile("s_waitcnt lgkmcnt(0)" ::: "memory");
    f32x16 rliv;
#pragma unroll
    for (int g = 0; g < 4; ++g) { const f32x4 lv = *(const f32x4*)(wsf + 32 + 8 * g + 4 * hi);
#pragma unroll
        for (int j = 0; j < 4; ++j) rliv[4 * g + j] = __builtin_amdgcn_rcpf(lv[j]); }
    __syncthreads();
    float* ox = (float*)(shm + LOX) + wq * 4096;
    if (mp == 1) {
#pragma unroll
        for (int db = 0; db < 4; ++db) { const f32x16 t = o[db] * rliv;
#pragma unroll
            for (int g = 0; g < 4; ++g) *(f32x4*)(ox + ((db * 4 + g) * 64 + lane) * 4) = (f32x4){t[4 * g], t[4 * g + 1], t[4 * g + 2], t[4 * g + 3]}; }
    }
    __syncthreads();
    if (mp == 0) {
        f32x16 ssv = f32x16{};
#pragma unroll
        for (int db = 0; db < 4; ++db) { f32x16 x1;
#pragma unroll
            for (int g = 0; g < 4; ++g) { const f32x4 t = *(const f32x4*)(ox + ((db * 4 + g) * 64 + lane) * 4); x1[4 * g] = t[0]; x1[4 * g + 1] = t[1]; x1[4 * g + 2] = t[2]; x1[4 * g + 3] = t[3]; }
            const f32x16 v = o[db] * rliv - x1 * lam; o[db] = v; ssv = v * v + ssv; }
#pragma unroll
        for (int r = 0; r < 16; ++r) { float sv = ssv[r];
            sv += dpp_f<0xB1>(sv); sv += dpp_f<0x4E>(sv); sv += dpp_f<0x141>(sv); sv += dpp_f<0x140>(sv);
            sv = add_xor16(sv);
            ssv[r] = 0.8f * __builtin_amdgcn_rsqf(sv * (1.0f / 128.0f) + EPS); }
        float sg[4];
#pragma unroll
        for (int db = 0; db < 4; ++db) sg[db] = subg[32 * db + r32];
        bf16_t* stg = (bf16_t*)ox;
#pragma unroll
        for (int db = 0; db < 4; ++db) { const f32x16 t = o[db] * (ssv * sg[db]);
#pragma unroll
            for (int r = 0; r < 16; r += 2) { const unsigned w = cvt_pk_bf16(t[r], t[r + 1]);
                stg[crow(r, hi) * 128 + 32 * db + r32] = (bf16_t)(w & 0xffffu); stg[crow(r + 1, hi) * 128 + 32 * db + r32] = (bf16_t)(w >> 16); } }
        asm volatile("s_waitcnt lgkmcnt(0)" ::: "memory");
        bf16_t* yb = Y + (rowbase + q0 + wq * 32) * DM + 512 + h * 128;
#pragma unroll
        for (int i = 0; i < 8; ++i) { const int q = lane + 64 * i, row = q >> 4, pc = q & 15;
            const u32x4 v = *(const u32x4*)(stg + row * 128 + pc * 8);
            *(u32x4*)(yb + (size_t)row * DM + pc * 8) = v; }
    }
}
constexpr int NCONV = 768, NQUEUE = 128 + 1024 + NCONV;
__device__ __forceinline__ void mixer_phase(Frame& F) {
    const float* lq1 = F.in(12); const float* lk1 = F.in(13); const float* lq2 = F.in(14); const float* lk2 = F.in(15);
    float a1 = lq1[F.lane] * lk1[F.lane], a2 = lq2[F.lane] * lk2[F.lane];
    a1 = wave_sum(a1); a2 = wave_sum(a2);
    const float lam = expf(a1) - expf(a2) + 0.2f;
    unsigned* qhead = (unsigned*)(F.ws + WS_CTL) + CW_QUEUE;
    volatile LAS unsigned* slot = (volatile LAS unsigned*)(F.lds + LDS_MISC) + 16;
    for (;;) {
        if (F.tid == 0) slot[0] = __hip_atomic_fetch_add(qhead, 1u, __ATOMIC_RELAXED, __HIP_MEMORY_SCOPE_AGENT);
        __syncthreads();
        const int u = (int)__builtin_amdgcn_readfirstlane(slot[0]);
        if (u >= NQUEUE) break;
        if (u < 128) { rglru_item(F, u); continue; }
        const int v = u - 128;
        if (v < 2 * NCONV && (v & 1)) { conv_unit(F, v >> 1); __syncthreads(); continue; }
        const int idx = (v < 2 * NCONV) ? (v >> 1) : v - NCONV, qb = 15 - (idx >> 6), bh = idx & 63;
        attn_unit(F, bh >> 2, bh & 3, qb, lam); __syncthreads();
    }
    __syncthreads();
}
}

struct ProbOutProj {
    static constexpr bool FP8 = false;
    pg8::StaticOrder S; const char* A; const char* Bt; const bf16_t* xb; bf16_t* x1h; unsigned char* x1q; LAS unsigned char* lds;
    __device__ __forceinline__ bool next(int i, pg8::Unit& u) const { u.e = 0; u.tt = 0; return S.next(i, u.pm, u.pn); }
    __device__ __forceinline__ const char* abase(const pg8::Unit& u) const { return A + (size_t)u.pm * 256 * DM * 2; }
    __device__ __forceinline__ void aoff(const pg8::Unit& u, const int (&R)[2], const int (&C)[2], unsigned (&vo)[2][2]) const {
#pragma unroll
        for (int h = 0; h < 2; ++h)
#pragma unroll
            for (int i = 0; i < 2; ++i) vo[h][i] = (unsigned)((h * 128 + R[i]) * DM + C[i]) * 2u;
    }
    __device__ __forceinline__ const char* bptr(const pg8::Unit& u) const { return Bt + (size_t)u.pn * 256 * DM * 2; }
    __device__ __forceinline__ void epi(f32x4 (&acc)[2][2][4][2], const pg8::Unit& u, int wr, int wc, int fr, int fq) const {
        const int tid = (wr * 4 + wc) * 64 + fq * 16 + fr;
        const size_t tile0 = (size_t)u.pm * 256 * DM + (size_t)u.pn * 256;
        u32x4 xres[8][2];
#pragma unroll
        for (int c = 0; c < 8; ++c)
#pragma unroll
            for (int j = 0; j < 2; ++j) { const int p = tid + 512 * j, r2 = p >> 5, pi = p & 31;
                xres[c][j] = *(const u32x4*)(xb + tile0 + (size_t)((c >> 2) * 128 + (r2 >> 4) * 64 + (c & 3) * 16 + (r2 & 15)) * DM + pi * 8); }
#pragma unroll
        for (int ai = 0; ai < 2; ++ai)
#pragma unroll
            for (int m = 0; m < 4; ++m) { const int c = ai * 4 + m;
                LAS unsigned char* buf = lds + ((c & 1) ? STG_BUF1 : STG_BUF0);
                const int rl = wr * 16 + fr, p0 = wc * 4 + fq;
#pragma unroll
                for (int bj = 0; bj < 2; ++bj) { const f32x4 v0 = acc[ai][bj][m][0], v1 = acc[ai][bj][m][1];
                    u32x4 w; w.x = cvt_pk_bf16(v0[0], v0[1]); w.y = cvt_pk_bf16(v0[2], v0[3]); w.z = cvt_pk_bf16(v1[0], v1[1]); w.w = cvt_pk_bf16(v1[2], v1[3]);
                    *(LAS u32x4*)(buf + rl * 512 + (((bj * 16 + p0) ^ (rl & 7)) << 4)) = w; }
                asm volatile("s_waitcnt lgkmcnt(0)" ::: "memory"); __builtin_amdgcn_s_barrier(); asm volatile("" ::: "memory");
#pragma unroll
                for (int j = 0; j < 2; ++j) { const int p = tid + 512 * j, r2 = p >> 5, pi = p & 31;
                    const u32x4 a = *(const LAS u32x4*)(buf + r2 * 512 + ((pi ^ (r2 & 7)) << 4));
                    const size_t off = tile0 + (size_t)(ai * 128 + (r2 >> 4) * 64 + m * 16 + (r2 & 15)) * DM + pi * 8;
                    const u32x4 xv = xres[c][j];
                    const unsigned aw[4] = {a.x, a.y, a.z, a.w}, xw[4] = {xv.x, xv.y, xv.z, xv.w};
                    float v[8];
#pragma unroll
                    for (int q = 0; q < 4; ++q) { v[2 * q] = bf2f(aw[q] & 0xffffu) + bf2f(xw[q] & 0xffffu); v[2 * q + 1] = bf2f(aw[q] >> 16) + bf2f(xw[q] >> 16); }
                    u32x4 hb; hb.x = cvt_pk_bf16(v[0], v[1]); hb.y = cvt_pk_bf16(v[2], v[3]); hb.z = cvt_pk_bf16(v[4], v[5]); hb.w = cvt_pk_bf16(v[6], v[7]);
                    *(u32x4*)(x1h + off) = hb;
                    u32x2 w8; w8.x = pack_fp8x4(v[0], v[1], v[2], v[3]); w8.y = pack_fp8x4(v[4], v[5], v[6], v[7]);
                    *(u32x2*)(x1q + off) = w8; } }
    }
};

__device__ __forceinline__ void p5_router(Frame& F) {
    const int lane = F.lane, r32 = lane & 31, hi = lane >> 5, wid = F.wave, tl = wid & 3, kh = wid >> 2, tid = F.tid;
    const bf16_t* x1 = (const bf16_t*)(F.ws + WS_X1H); const bf16_t* WRH = (const bf16_t*)(F.ws + WS_WRH); const bf16_t* WRL = (const bf16_t*)(F.ws + WS_WRL);
    const float* rb = F.in(20);
    unsigned* ctl = (unsigned*)(F.ws + WS_CTL);
    int* LIST = (int*)(F.ws + WS_LIST); float* GATES = (float*)(F.ws + WS_GATES); float* RS2 = (float*)(F.ws + WS_RSTD2); int* POSI = (int*)(F.ws + WS_POSI);
    LAS float* T = (LAS float*)(F.lds);
    LAS float* SS = (LAS float*)(F.lds + 2 * 4 * 32 * 33 * 4);
    LAS unsigned* CNTL = (LAS unsigned*)(F.lds + 2 * 4 * 32 * 33 * 4 + 1024);
    float rbv[8];
#pragma unroll
    for (int j = 0; j < 8; ++j) rbv[j] = rb[8 * (tid & 3) + j];
    for (int blk = F.vcu; blk < MTOK / 128; blk += F.G) {
        const int R0 = blk * 128;
        if (tid < 32) CNTL[tid] = 0u;
        f32x16 acc = f32x16{}; float ssq = 0.f;
        const bf16_t* xrow = x1 + (size_t)(R0 + tl * 32 + r32) * DM + kh * 512 + hi * 8;
        const bf16_t* wh = WRH + r32 * DM + kh * 512 + hi * 8; const bf16_t* wl = WRL + r32 * DM + kh * 512 + hi * 8;
#pragma unroll 8
        for (int s = 0; s < 32; ++s) {
            const u32x4 xa = *(const u32x4*)(xrow + 16 * s);
            const unsigned xw[4] = {xa.x, xa.y, xa.z, xa.w};
#pragma unroll
            for (int j = 0; j < 4; ++j) { const float a = bf2f(xw[j] & 0xffffu), b = bf2f(xw[j] >> 16); ssq += a * a + b * b; }
            const bf16x8 bh = *(const bf16x8*)(wh + 16 * s), bl = *(const bf16x8*)(wl + 16 * s);
            acc = __builtin_amdgcn_mfma_f32_32x32x16_bf16(__builtin_bit_cast(bf16x8, xa), bh, acc, 0, 0, 0);
            acc = __builtin_amdgcn_mfma_f32_32x32x16_bf16(__builtin_bit_cast(bf16x8, xa), bl, acc, 0, 0, 0);
        }
        ssq = add_xor32(ssq);
#pragma unroll
        for (int r = 0; r < 16; ++r) T[((kh * 4 + tl) * 32 + att::crow(r, hi)) * 33 + r32] = acc[r];
        if (hi == 0) SS[(kh * 4 + tl) * 32 + r32] = ssq;
        __syncthreads();
        int ek[4]; float gk[4]; unsigned rk[4] = {0u, 0u, 0u, 0u}; float rstd2;
        const int srow = tid >> 2, sq = tid & 3;
        {
            const int tile = srow >> 5, rr = srow & 31;
            rstd2 = __builtin_amdgcn_rsqf((SS[tile * 32 + rr] + SS[(4 + tile) * 32 + rr]) * (1.0f / DM) + EPS);
            const LAS float* ta = T + (tile * 32 + rr) * 33 + 8 * sq; const LAS float* tb = T + ((4 + tile) * 32 + rr) * 33 + 8 * sq;
            float v[8];
#pragma unroll
            for (int j = 0; j < 8; ++j) v[j] = (ta[j] + tb[j]) * rstd2 + rbv[j];
            float vk[4];
#pragma unroll
            for (int k = 0; k < 4; ++k) { float best = -INFINITY; int be = 8 * sq;
#pragma unroll
                for (int j = 0; j < 8; ++j) if (v[j] > best) { best = v[j]; be = 8 * sq + j; }
                { const float ob = att::dpp_f<0xB1>(best); const int oe = __builtin_amdgcn_update_dpp(0, be, 0xB1, 0xf, 0xf, true); if (ob > best || (ob == best && oe < be)) { best = ob; be = oe; } }
                { const float ob = att::dpp_f<0x4E>(best); const int oe = __builtin_amdgcn_update_dpp(0, be, 0x4E, 0xf, 0xf, true); if (ob > best || (ob == best && oe < be)) { best = ob; be = oe; } }
                ek[k] = be; vk[k] = best;
#pragma unroll
                for (int j = 0; j < 8; ++j) if (be == 8 * sq + j) v[j] = -INFINITY; }
            float den = 0.f;
#pragma unroll
            for (int k = 0; k < 4; ++k) { gk[k] = __expf(vk[k] - vk[0]); den += gk[k]; }
            const float rden = 1.0f / den;
#pragma unroll
            for (int k = 0; k < 4; ++k) { gk[k] *= rden; if (sq == 0) rk[k] = __hip_atomic_fetch_add(CNTL + ek[k], 1u, __ATOMIC_RELAXED, __HIP_MEMORY_SCOPE_WORKGROUP); }
        }
        __syncthreads();
        if (tid < 32) { const unsigned n = CNTL[tid]; CNTL[32 + tid] = n ? atomicAdd(ctl + CW_CNT + 64 * tid, n) : 0u; }
        __syncthreads();
        if (sq == 0) {
            const int tok = R0 + srow;
            RS2[tok] = rstd2;
#pragma unroll
            for (int k = 0; k < 4; ++k) { const int li = (int)(CNTL[32 + ek[k]] + rk[k]); LIST[(size_t)ek[k] * MTOK + li] = tok * 4 + k; GATES[tok * 4 + k] = gk[k]; POSI[tok * 4 + k] = (ek[k] << 15) | li; }
        }
        __syncthreads();
    }
}

constexpr int MOE_MAXS = 24;
struct MoeSched { LAS int* TB; LAS int* TE; LAS int* TAB; int tlo, thi, mt, pn, mpb; };
constexpr int MOE_CNTS = 25600 / 4;
__device__ __forceinline__ void moe_prefix(Frame& F, LAS int* TB) {
    const unsigned* ctl = (const unsigned*)(F.ws + WS_CTL);
    if (F.tid < 64) {
        const int e = F.tid; const int c = (e < NEXP) ? (int)__hip_atomic_load(ctl + CW_CNT + 64 * (e & 31), __ATOMIC_RELAXED, __HIP_MEMORY_SCOPE_AGENT) : 0;
        const int tiles = (c + 255) >> 8; int incl = tiles;
#pragma unroll
        for (int o = 1; o < 32; o <<= 1) { const int y = __shfl_up(incl, o); if (e >= o) incl += y; }
        if (e < NEXP) { TB[e] = incl - tiles; TB[MOE_CNTS + e] = c; }
        if (e == NEXP - 1) TB[NEXP] = incl;
    }
    __syncthreads();
}
template <int NPN, bool TABLE>
__device__ __forceinline__ MoeSched moe_setup(Frame& F) {
    MoeSched M;
    M.TB = (LAS int*)(F.lds + LDS_AUX); M.TE = M.TB + 40; M.TAB = M.TB + 64;
    moe_prefix(F, M.TB);
    const int T = __builtin_amdgcn_readfirstlane(M.TB[NEXP]), x = F.vcu >> 5, i = F.vcu & 31;
    M.mpb = 32 / NPN; M.mt = __builtin_amdgcn_readfirstlane(i / NPN); M.pn = __builtin_amdgcn_readfirstlane(i % NPN);
    M.tlo = __builtin_amdgcn_readfirstlane((x * T) >> 3); M.thi = __builtin_amdgcn_readfirstlane(((x + 1) * T) >> 3);
    const int* LIST = (const int*)(F.ws + WS_LIST); const float* RS2 = (const float*)(F.ws + WS_RSTD2);
    if (F.tid < MOE_MAXS) { const int t = M.tlo + F.tid * M.mpb + M.mt; int e = 0; if (t < M.thi) { for (int q = 0; q < NEXP; ++q) if (M.TB[q + 1] <= t) e = q + 1; } M.TE[F.tid] = e; }
    __syncthreads();
    if (TABLE) {
        constexpr int NIT = MOE_MAXS * 256 / NTHR;
        int lst[NIT];
#pragma unroll
        for (int it = 0; it < NIT; ++it) { const int idx = F.tid + NTHR * it, s = idx >> 8, r = idx & 255, t = M.tlo + s * M.mpb + M.mt;
            const int e = M.TE[s]; const int li = (t - M.TB[e]) * 256 + r;
            lst[it] = (t < M.thi && li < M.TB[MOE_CNTS + e]) ? LIST[(size_t)e * MTOK + li] : -1; }
        float rsv[NIT];
#pragma unroll
        for (int it = 0; it < NIT; ++it) rsv[it] = (lst[it] >= 0) ? RS2[lst[it] >> 2] : 0.f;
#pragma unroll
        for (int it = 0; it < NIT; ++it) M.TAB[F.tid + NTHR * it] = (lst[it] >= 0) ? ((lst[it] >> 2) | (int)((f2bf(rsv[it]) & 0x7fffu) << 15)) : 0;
    }
    __syncthreads();
    return M;
}
struct ProbMoe1 {
    static constexpr bool FP8 = true;
    MoeSched M; const char* A; const char* W; const float* b1; unsigned char* act;
    __device__ __forceinline__ bool next(int s, pg8::Unit& u) const { const int t = __builtin_amdgcn_readfirstlane(M.tlo + s * M.mpb + M.mt); if (s >= MOE_MAXS || t >= __builtin_amdgcn_readfirstlane(M.thi)) return false; u.pn = M.pn; u.pm = t; u.tt = s;
        u.e = __builtin_amdgcn_readfirstlane(M.TE[s]); return true; }
    __device__ __forceinline__ const char* abase(const pg8::Unit&) const { return A; }
    __device__ __forceinline__ void aoff(const pg8::Unit& u, const int (&R)[2], const int (&C)[2], unsigned (&vo)[2][2]) const {
#pragma unroll
        for (int h = 0; h < 2; ++h)
#pragma unroll
            for (int i = 0; i < 2; ++i) vo[h][i] = (unsigned)((M.TAB[u.tt * 256 + h * 128 + R[i]] & 0x7fff) * DM + C[i] * 2);
    }
    __device__ __forceinline__ const char* bptr(const pg8::Unit& u) const { return W + ((size_t)u.e * 2 * DFF + (size_t)u.pn * 256) * DM; }
    __device__ __forceinline__ void epi(f32x4 (&acc)[2][2][4][2], const pg8::Unit& u, int wr, int wc, int fr, int fq) const {
        asm volatile("s_nop 15\n\ts_nop 7" ::: "memory");
        const int rl0 = wr * 64 + fr, cj = u.pn * 128 + wc * 32 + 8 * fq;
        const float* bg = b1 + (size_t)u.e * 2 * DFF + cj; const float* bu = bg + DFF;
        constexpr float CS = -1.702f * LOG2E, KA = ASCALE / CS;
        f32x4 bg0 = *(const f32x4*)bg, bg1 = *(const f32x4*)(bg + 4); const f32x4 bu0 = *(const f32x4*)bu, bu1 = *(const f32x4*)(bu + 4);
        bg0 = bg0 * CS; bg1 = bg1 * CS;
#pragma unroll
        for (int ai = 0; ai < 2; ++ai)
#pragma unroll
            for (int m = 0; m < 4; ++m) { const int rl = rl0 + ai * 128 + m * 16; const float rs = bf2f((unsigned)M.TAB[u.tt * 256 + rl] >> 15) * (1.0f / WSCALE), rsc = rs * CS;
                float a[8];
#pragma unroll
                for (int n = 0; n < 2; ++n)
#pragma unroll
                    for (int jp = 0; jp < 2; ++jp) {
                        const f32x2 ag = {acc[ai][0][m][n][2 * jp], acc[ai][0][m][n][2 * jp + 1]}, au = {acc[ai][1][m][n][2 * jp], acc[ai][1][m][n][2 * jp + 1]};
                        const f32x2 bgp = n ? (f32x2){bg1[2 * jp], bg1[2 * jp + 1]} : (f32x2){bg0[2 * jp], bg0[2 * jp + 1]};
                        const f32x2 bup = n ? (f32x2){bu1[2 * jp], bu1[2 * jp + 1]} : (f32x2){bu0[2 * jp], bu0[2 * jp + 1]};
                        const f32x2 z = ag * (f32x2){rsc, rsc} + bgp, hu = au * (f32x2){rs, rs} + bup;
                        const f32x2 zc = {fmaxf(z.x, 7.0f * CS), fmaxf(z.y, 7.0f * CS)};
                        const f32x2 up = {__builtin_amdgcn_fmed3f(hu.x, -7.0f, 7.0f), __builtin_amdgcn_fmed3f(hu.y, -7.0f, 7.0f)};
                        const f32x2 den = (f32x2){__builtin_amdgcn_exp2f(zc.x), __builtin_amdgcn_exp2f(zc.y)} + (f32x2){1.0f, 1.0f};
                        const f32x2 sg = {__builtin_amdgcn_rcpf(den.x), __builtin_amdgcn_rcpf(den.y)};
                        const f32x2 r = (zc * sg) * (up * (f32x2){KA, KA} + (f32x2){KA, KA});
                        a[4 * n + 2 * jp] = r.x; a[4 * n + 2 * jp + 1] = r.y; }
                u32x2 w; w.x = pack_fp8x4(a[0], a[1], a[2], a[3]); w.y = pack_fp8x4(a[4], a[5], a[6], a[7]);
                *(u32x2*)(act + ((size_t)u.pm * 256 + rl) * DFF + cj) = w; }
    }
};
struct ProbMoe2 {
    static constexpr bool FP8 = true;
    MoeSched M; const char* A; const char* W; const float* b2; unsigned char* ys; LAS unsigned char* lds;
    __device__ __forceinline__ bool next(int s, pg8::Unit& u) const { const int t = __builtin_amdgcn_readfirstlane(M.tlo + s * M.mpb + M.mt); if (s >= MOE_MAXS || t >= __builtin_amdgcn_readfirstlane(M.thi)) return false; u.pn = M.pn; u.pm = t; u.tt = s;
        u.e = __builtin_amdgcn_readfirstlane(M.TE[s]); return true; }
    __device__ __forceinline__ const char* abase(const pg8::Unit& u) const { return A + (size_t)u.pm * 256 * DFF; }
    __device__ __forceinline__ void aoff(const pg8::Unit& u, const int (&R)[2], const int (&C)[2], unsigned (&vo)[2][2]) const {
#pragma unroll
        for (int h = 0; h < 2; ++h)
#pragma unroll
            for (int i = 0; i < 2; ++i) vo[h][i] = (unsigned)((h * 128 + R[i]) * DFF + C[i] * 2);
    }
    __device__ __forceinline__ const char* bptr(const pg8::Unit& u) const { return W + ((size_t)u.e * DM + (size_t)u.pn * 256) * DFF; }
    __device__ __forceinline__ void epi(f32x4 (&acc)[2][2][4][2], const pg8::Unit& u, int wr, int wc, int fr, int fq) const {
        asm volatile("s_nop 15\n\ts_nop 7" ::: "memory");
        const int rl0 = wr * 64 + fr, col0 = u.pn * 256 + wc * 32 + 8 * fq;
        const float* bp = b2 + (size_t)u.e * DM + col0;
        f32x4 bv[2][2];
#pragma unroll
        for (int bj = 0; bj < 2; ++bj) { bv[bj][0] = *(const f32x4*)(bp + bj * 128) * YSCALE; bv[bj][1] = *(const f32x4*)(bp + bj * 128 + 4) * YSCALE; }
        constexpr float sc = YSCALE / (WSCALE * ASCALE);
        char* tbase = (char*)ys + ((size_t)u.pm * 256) * DM + u.pn * 256;
        const int tid = (wr * 4 + wc) * 64 + fq * 16 + fr;
#pragma unroll
        for (int ai = 0; ai < 2; ++ai)
#pragma unroll
            for (int mh = 0; mh < 2; ++mh) { const int c = ai * 2 + mh; LAS unsigned char* buf = lds + ((c & 1) ? STG_BUF1 : STG_BUF0);
#pragma unroll
                for (int ml = 0; ml < 2; ++ml) { const int m = mh * 2 + ml, rl = ml * 32 + wr * 16 + fr;
#pragma unroll
                    for (int bj = 0; bj < 2; ++bj) { const f32x4 v0 = acc[ai][bj][m][0] * sc + bv[bj][0], v1 = acc[ai][bj][m][1] * sc + bv[bj][1];
                        u32x2 w; w.x = pack_fp8x4(v0[0], v0[1], v0[2], v0[3]); w.y = pack_fp8x4(v1[0], v1[1], v1[2], v1[3]);
                        const int slot = bj * 16 + wc * 4 + fq;
                        *(LAS u32x2*)(buf + rl * 256 + ((slot ^ ((rl & 7) << 1)) << 3)) = w; } }
                asm volatile("s_waitcnt lgkmcnt(0)" ::: "memory"); __builtin_amdgcn_s_barrier(); asm volatile("" ::: "memory");
#pragma unroll
                for (int j = 0; j < 2; ++j) { const int p = tid + 512 * j, r2 = p >> 4, pi = p & 15;
                    const u32x4 v = *(const LAS u32x4*)(buf + r2 * 256 + (((2 * pi) ^ ((r2 & 7) << 1)) << 3));
                    const int trow = ai * 128 + ((r2 >> 4) & 1) * 64 + (mh * 2 + (r2 >> 5)) * 16 + (r2 & 15);
                    *(u32x4*)(tbase + (size_t)trow * DM + pi * 16) = v; } }
    }
};
static_assert(256 + MOE_MAXS * 256 * 4 <= 32768 - 512, "MoE tables fit the AUX region");

__device__ __forceinline__ void p8_combine(Frame& F) {
    const int gw = F.vcu * NWAVES + F.wave, NGW = F.G * NWAVES;
    LAS int* TB = (LAS int*)(F.lds + LDS_AUX);
    moe_prefix(F, TB);
    const unsigned char* YS = F.ws + WS_YB; const int* POSI = (const int*)(F.ws + WS_POSI); const float* GATES = (const float*)(F.ws + WS_GATES);
    const bf16_t* X1H = (const bf16_t*)(F.ws + WS_X1H);
    for (int m = gw; m < MTOK; m += NGW) {
        f32x4* op = (f32x4*)(F.out + (size_t)m * DM) + F.lane;
        const u32x2* xp = (const u32x2*)(X1H + (size_t)m * DM) + F.lane;
        const int pv = POSI[m * 4 + (F.lane & 3)]; const float gv = GATES[m * 4 + (F.lane & 3)] * (1.0f / YSCALE);
        f32x4 v[4];
#pragma unroll
        for (int j = 0; j < 4; ++j) { const u32x2 w = xp[64 * j]; v[j].x = bf2f(w.x & 0xffffu); v[j].y = bf2f(w.x >> 16); v[j].z = bf2f(w.y & 0xffffu); v[j].w = bf2f(w.y >> 16); }
#pragma unroll
        for (int k = 0; k < 4; ++k) { const int p = __builtin_amdgcn_readlane(pv, k); const float g = __builtin_bit_cast(float, __builtin_amdgcn_readlane(__builtin_bit_cast(int, gv), k));
            const int pos = TB[p >> 15] * 256 + (p & 32767);
            const unsigned* yp = (const unsigned*)(YS + (size_t)pos * DM) + F.lane;
#pragma unroll
            for (int j = 0; j < 4; ++j) { const unsigned w = yp[64 * j]; const f32x2 lo = __builtin_amdgcn_cvt_pk_f32_fp8(w, false), hi2 = __builtin_amdgcn_cvt_pk_f32_fp8(w, true);
                v[j].x += g * lo.x; v[j].y += g * lo.y; v[j].z += g * hi2.x; v[j].w += g * hi2.y; } }
#pragma unroll
        for (int j = 0; j < 4; ++j) op[64 * j] = v[j];
    }
}

typedef GAS unsigned gu32;
#define XB_TMO      128
#define XB_XCNT(j)  (256  + 64 * (j))
#define XB_XSUB(j)  (1280 + 64 * (j))
#define XB_XGEN(j)  (2304 + 64 * (j))
#define XB_TOP      3328
#define XB_TOPGEN   3392
#define XCD_BAR_WORDS 3456
#define XB_SPIN_CAP (1u << 20)
__device__ __forceinline__ unsigned xb_ld(unsigned* p)              { return __hip_atomic_load(p, __ATOMIC_RELAXED, __HIP_MEMORY_SCOPE_AGENT); }
__device__ __forceinline__ unsigned xb_add(unsigned* p, unsigned v) { return __hip_atomic_fetch_add(p, v, __ATOMIC_RELAXED, __HIP_MEMORY_SCOPE_AGENT); }
__device__ __forceinline__ unsigned xb_xcc_id() { return (unsigned)__builtin_amdgcn_s_getreg((3 << 11) | 20) & 0xFu; }
#define XB_SPIN(cond, bar) do { unsigned _sp = 0; while (cond) { __builtin_amdgcn_s_sleep(1); \
    if ((++_sp & 255u) == 0u) { if (xb_ld(&(bar)[XB_TMO])) break; if (_sp > XB_SPIN_CAP) { atomicAdd(&(bar)[XB_TMO], 1u); break; } } } } while (0)
struct XcdBarrier { unsigned* bar; unsigned x; volatile LAS unsigned* st; };
__device__ __forceinline__ XcdBarrier xcd_barrier_post(unsigned* bar, volatile LAS unsigned* st) {
    XcdBarrier b; b.bar = bar; b.x = xb_xcc_id(); b.st = st;
    if (threadIdx.x == 0) (void)xb_add(&bar[XB_XCNT(b.x)], 1u);
    return b;
}
__device__ __forceinline__ void xcd_barrier_complete(unsigned* bar, unsigned x, unsigned& nloc, unsigned& nx) {
    const unsigned G = gridDim.x * gridDim.y * gridDim.z;
    unsigned sum, cnt, mine, sp = 0u;
    for (;;) {
        sum = 0u; cnt = 0u; mine = 0u;
#pragma unroll
        for (unsigned j = 0; j < 16; ++j) { const unsigned c = xb_ld(&bar[XB_XCNT(j)]); sum += c; cnt += (c > 0u) ? 1u : 0u; mine = (j == x) ? c : mine; }
        if (sum == G) break;
        __builtin_amdgcn_s_sleep(1);
        if ((++sp & 255u) == 0u) { if (xb_ld(&bar[XB_TMO])) break; if (sp > XB_SPIN_CAP) { atomicAdd(&bar[XB_TMO], 1u); break; } }
    }
    nloc = mine > 0u ? mine : 1u; nx = cnt > 0u ? cnt : 1u;
}
__device__ __forceinline__ void xcd_barrier(const XcdBarrier& b) {
    asm volatile("s_waitcnt vmcnt(0)" ::: "memory");
    __syncthreads();
    if (threadIdx.x == 0) {
        unsigned* bar = b.bar;
        __builtin_amdgcn_s_waitcnt(0);
        unsigned nloc = b.st[0], nx = b.st[1];
        if (nloc == 0u) { xcd_barrier_complete(bar, b.x, nloc, nx); b.st[0] = nloc; b.st[1] = nx; }
        const unsigned old = xb_add(&bar[XB_XSUB(b.x)], 1u);
        const unsigned gen = old / nloc;
        if (old + 1u == (gen + 1u) * nloc) {
            __builtin_amdgcn_fence(__ATOMIC_RELEASE, "agent");
            asm volatile("s_waitcnt vmcnt(0)" ::: "memory");
            const unsigned og = xb_add(&bar[XB_TOP], 1u);
            const unsigned tg = og / nx;
            if (og + 1u == (tg + 1u) * nx) xb_add(&bar[XB_TOPGEN], 1u);
            else XB_SPIN(xb_ld(&bar[XB_TOPGEN]) == tg, bar);
            __builtin_amdgcn_fence(__ATOMIC_ACQUIRE, "agent");
            xb_add(&bar[XB_XGEN(b.x)], 1u);
            asm volatile("s_waitcnt vmcnt(0)" ::: "memory");
        } else {
            XB_SPIN(xb_ld(&bar[XB_XGEN(b.x)]) == gen, bar);
            __builtin_amdgcn_fence(__ATOMIC_ACQUIRE, "agent");
            asm volatile("s_waitcnt vmcnt(0)" ::: "memory");
        }
    }
    __syncthreads();
}

struct Args { const float* in[25]; float* out; unsigned char* ws; int ph_lo, ph_hi; };
__global__ void __launch_bounds__(NTHR, 2) mk_fwd(Args args) {
    extern __shared__ __attribute__((aligned(16))) unsigned char lds_raw[];
    Frame F;
    F.lds = (LAS unsigned char*)lds_raw; F.ws = args.ws; F.out = args.out;
    F.kin = (karg_ptr_t)__builtin_amdgcn_kernarg_segment_ptr();
    F.tid = threadIdx.x; F.lane = F.tid & 63; F.wave = __builtin_amdgcn_readfirstlane(F.tid >> 6);
    F.G = gridDim.x; { const int bx = blockIdx.x; F.vcu = (F.G % 8 == 0) ? (bx % 8) * (F.G / 8) + bx / 8 : bx; }
    const int lo = args.ph_lo, hi = args.ph_hi;
    { volatile LAS unsigned* MISC = (volatile LAS unsigned*)(F.lds + LDS_MISC); if (F.tid < 64) MISC[F.tid] = 0u; }
    __syncthreads();
    XcdBarrier bar; bar.bar = (unsigned*)(F.ws + WS_CTL) + CW_BAR; bar.x = 0; bar.st = nullptr;
    if (hi - lo > 1) bar = xcd_barrier_post((unsigned*)(F.ws + WS_CTL) + CW_BAR, (volatile LAS unsigned*)(F.lds + LDS_MISC) + 8);
#define IN(k) (lo <= (k) && (k) < hi)
#define SEAM(k) do { if (IN(k) && ((k) == 2 ? IN(4) : IN((k) + 1))) xcd_barrier(bar); } while (0)
    if (IN(0)) { p0_prologue(F); }
    SEAM(0);
    if (IN(1)) {
        ProbInProj P; P.S.init(MTOK, DIN, F.G, (int)blockIdx.x); P.A = (const char*)(F.ws + WS_XB); P.Bt = (const char*)(F.ws + WS_WIN); P.rstd1 = (const float*)(F.ws + WS_RSTD1);
        P.dst0 = (bf16_t*)(F.ws + WS_XR); P.qg = F.in(10); P.kg = F.in(11); P.xs = (LAS float*)(F.lds + LDS_AUX); P.lds = F.lds;
        pg8::gemm_phase<decltype(P), true>(F.lds, P);
    }
    SEAM(1);
    if (IN(2)) { att::mixer_phase(F); }
    SEAM(2);
    if (IN(4)) {
        ProbOutProj P; P.S.init(MTOK, DM, F.G, (int)blockIdx.x); P.A = (const char*)(F.ws + WS_Y); P.Bt = (const char*)(F.ws + WS_WOUT); P.xb = (const bf16_t*)(F.ws + WS_XB); P.x1h = (bf16_t*)(F.ws + WS_X1H); P.x1q = F.ws + WS_X1B; P.lds = F.lds;
        pg8::gemm_phase<decltype(P), true>(F.lds, P);
    }
    SEAM(4);
    if (IN(5)) { p5_router(F); }
    SEAM(5);
    if (IN(6)) {
        ProbMoe1 P; P.M = moe_setup<8, true>(F); P.A = (const char*)(F.ws + WS_X1B); P.W = (const char*)(F.ws + WS_W1); P.b1 = F.in(22); P.act = F.ws + WS_ACT;
        pg8::gemm_phase<decltype(P), true>(F.lds, P);
    }
    SEAM(6);
    if (IN(7)) {
        ProbMoe2 P; P.M = moe_setup<4, false>(F); P.A = (const char*)(F.ws + WS_ACT); P.W = (const char*)(F.ws + WS_W2); P.b2 = F.in(24); P.ys = F.ws + WS_YB; P.lds = F.lds;
        pg8::gemm_phase<decltype(P), true>(F.lds, P);
    }
    SEAM(7);
    if (IN(8)) { p8_combine(F); }
#undef IN
#undef SEAM
}

extern "C" void kernel_launch(void* const* d_in, const int* in_sizes, int n_in, void* d_out, int out_size, void* d_ws, size_t ws_size, hipStream_t stream) {
    static int grid = 0;
    if (grid == 0) {
        if (n_in != 25 || in_sizes[0] != MTOK * DM || out_size != MTOK * DM || ws_size < WS_END) {
            fprintf(stderr, "kernel_launch: unexpected problem (n_in %d, in0 %d, out %d, ws %zu); nothing launched\n", n_in, n_in > 0 ? in_sizes[0] : -1, out_size, ws_size); grid = -1; return; }
        int dev = 0, cus = 0, per_cu = 0;
        if (hipGetDevice(&dev) != hipSuccess || hipDeviceGetAttribute(&cus, hipDeviceAttributeMultiprocessorCount, dev) != hipSuccess) { grid = -1; return; }
        if (hipFuncSetAttribute((const void*)mk_fwd, hipFuncAttributeMaxDynamicSharedMemorySize, LDS_BYTES) != hipSuccess) { fprintf(stderr, "kernel_launch: hipFuncSetAttribute failed\n"); grid = -1; return; }
        if (hipOccupancyMaxActiveBlocksPerMultiprocessor(&per_cu, (const void*)mk_fwd, NTHR, LDS_BYTES) != hipSuccess || per_cu < 1) { fprintf(stderr, "kernel_launch: occupancy query says %d blocks/CU for %d B of LDS: the grid barrier needs every workgroup resident; nothing launched\n", per_cu, LDS_BYTES); (void)hipGetLastError(); grid = -1; return; }
        (void)hipGetLastError();
        grid = cus;
        if (grid != 256) { fprintf(stderr, "kernel_launch: built for a 256-CU device (got %d)\n", cus); grid = -1; return; }
    }
    if (grid < 0) return;
    (void)hipMemsetAsync((char*)d_ws + WS_CTL, 0, CTL_BYTES, stream);
    Args a{};
    for (int i = 0; i < 25; ++i) a.in[i] = (const float*)d_in[i];
    a.out = (float*)d_out; a.ws = (unsigned char*)d_ws;
#if MK_N_LAUNCHES == 1
    a.ph_lo = 0; a.ph_hi = NPHASE;
    hipLaunchKernelGGL(mk_fwd, dim3(grid), dim3(NTHR), LDS_BYTES, stream, a);
#else
    for (int p = 0; p < NPHASE; ++p) { a.ph_lo = p; a.ph_hi = p + 1; hipLaunchKernelGGL(mk_fwd, dim3(grid), dim3(NTHR), LDS_BYTES, stream, a); }
#endif
}
```

```cpp
#include <hip/hip_runtime.h>
#include <cstdio>
#include <cstdint>

#define LAS __attribute__((address_space(3)))
#define GAS __attribute__((address_space(1)))
typedef unsigned short bf16_t;
typedef short bf16x8 __attribute__((ext_vector_type(8)));
typedef short s16x4 __attribute__((ext_vector_type(4)));
typedef float f32x4 __attribute__((ext_vector_type(4)));
typedef float f32x2 __attribute__((ext_vector_type(2)));
typedef float f32x16 __attribute__((ext_vector_type(16)));
typedef unsigned u32x4 __attribute__((ext_vector_type(4)));
typedef unsigned u32x2 __attribute__((ext_vector_type(2)));

#ifndef MK_N_LAUNCHES
#define MK_N_LAUNCHES 1
#endif
constexpr int NPHASE = 9;

constexpr int NB = 16, SEQ = 2048, DM = 1024, MTOK = NB * SEQ;
constexpr int DIN = 2560, DRNN = 512, NEXP = 32, TOPK = 4, DFF = 1024, NASG = MTOK * TOPK;
constexpr float EPS = 1e-5f;
constexpr float LOG2E = 1.4426950408889634f;
constexpr int NWAVES = 8, NTHR = 512;
constexpr float YSCALE = 8.0f;
constexpr float WSCALE = 32.0f, ASCALE = 4.0f;

constexpr size_t MiB = (size_t)1 << 20;
constexpr size_t WS_CTL = 0, CTL_BYTES = 64 * 1024;
constexpr size_t WS_WIN = 2 * MiB;
constexpr size_t WS_WOUT = 8 * MiB;
constexpr size_t WS_WRH = 10 * MiB, WS_WRL = WS_WRH + 65536;
constexpr size_t WS_WAT = WS_WRH + 2 * 65536, WS_WXT = WS_WAT + 65536;
constexpr size_t WS_RSTD1 = 11 * MiB, WS_RSTD2 = WS_RSTD1 + 131072 * 2;
constexpr size_t WS_GATES = 12 * MiB;
constexpr size_t WS_POSI = 13 * MiB;
constexpr size_t WS_LIST = 16 * MiB;
constexpr size_t WS_W1 = 32 * MiB;
constexpr size_t WS_W2 = 160 * MiB;
constexpr size_t WS_XB = 224 * MiB;
constexpr size_t WS_XR = 288 * MiB, WS_GG = 320 * MiB, WS_Q = 352 * MiB, WS_K = 384 * MiB, WS_V = 416 * MiB;
constexpr size_t WS_Y = 448 * MiB;
constexpr size_t WS_X1B = 512 * MiB;
constexpr size_t WS_X1H = 712 * MiB;
constexpr size_t WS_ACT = 576 * MiB;
constexpr size_t WS_YB = 224 * MiB;
constexpr size_t WS_END = 848 * MiB;
constexpr int MAXTILES = NASG / 256 + NEXP;
constexpr int CW_TMO = 0, CW_QUEUE = 512, CW_CNT = 1024  , CW_BAR = 8192;

constexpr int RING_BYTES = 131072;
constexpr int LDS_AUX = RING_BYTES;
constexpr int LDS_MISC = RING_BYTES + 32768 - 256;
constexpr int LDS_BYTES = 163840;

__device__ __forceinline__ unsigned f2bf(float f) { unsigned u = __builtin_bit_cast(unsigned, f); return (u + 0x7fffu + ((u >> 16) & 1u)) >> 16; }
__device__ __forceinline__ float bf2f(unsigned h) { return __builtin_bit_cast(float, h << 16); }
typedef __bf16 bf16x2_t __attribute__((ext_vector_type(2)));
__device__ __forceinline__ unsigned cvt_pk_bf16(float lo, float hi) { f32x2 v = {lo, hi}; bf16x2_t b = __builtin_convertvector(v, bf16x2_t); return __builtin_bit_cast(unsigned, b); }
__device__ __forceinline__ unsigned pk2(float lo, float hi) { return cvt_pk_bf16(lo, hi); }
__device__ __forceinline__ void swap_rows16(unsigned& a, unsigned& b) { asm("s_nop 1\n\tv_permlane16_swap_b32 %0, %1" : "+v"(a), "+v"(b)); }
__device__ __forceinline__ void swap_rows32(unsigned& a, unsigned& b) { asm("s_nop 1\n\tv_permlane32_swap_b32 %0, %1" : "+v"(a), "+v"(b)); }
__device__ __forceinline__ float add_xor16(float v) { unsigned a = __builtin_bit_cast(unsigned, v), b = a; swap_rows16(a, b); return __builtin_bit_cast(float, a) + __builtin_bit_cast(float, b); }
__device__ __forceinline__ float add_xor32(float v) { unsigned a = __builtin_bit_cast(unsigned, v), b = a; swap_rows32(a, b); return __builtin_bit_cast(float, a) + __builtin_bit_cast(float, b); }
__device__ __forceinline__ float wave_sum(float v) {
#pragma unroll
    for (int o = 1; o < 64; o <<= 1) v += __shfl_xor(v, o);
    return v;
}
__device__ __forceinline__ float fast_sigmoid(float x) { return __builtin_amdgcn_rcpf(1.0f + __builtin_amdgcn_exp2f(-x * LOG2E)); }
__device__ __forceinline__ f32x4 gelu_tanh4(f32x4 x) {
    constexpr float A = -2.0f * 0.7978845608028654f * LOG2E, B = A * 0.044715f;
    const f32x4 t = (x * x * B + A) * x;
    const f32x4 d = (f32x4){__builtin_amdgcn_exp2f(t[0]), __builtin_amdgcn_exp2f(t[1]), __builtin_amdgcn_exp2f(t[2]), __builtin_amdgcn_exp2f(t[3])} + 1.0f;
    return x * (f32x4){__builtin_amdgcn_rcpf(d[0]), __builtin_amdgcn_rcpf(d[1]), __builtin_amdgcn_rcpf(d[2]), __builtin_amdgcn_rcpf(d[3])};
}
__device__ __forceinline__ unsigned pack_fp8x4(float a, float b, float c, float d) { unsigned t = 0; t = __builtin_amdgcn_cvt_pk_fp8_f32(a, b, t, false); t = __builtin_amdgcn_cvt_pk_fp8_f32(c, d, t, true); return t; }
#define LDS_WAIT() asm volatile("s_waitcnt lgkmcnt(0)" ::: "memory")
__device__ __forceinline__ float ld_untracked(const float* p) { float v; asm volatile("global_load_dword %0, %1, off" : "=v"(v) : "v"(p) : "memory"); return v; }
#define VM_WAIT() asm volatile("s_waitcnt vmcnt(0)" ::: "memory")

typedef const float* const volatile __attribute__((address_space(4))) * karg_ptr_t;
struct Frame {
    LAS unsigned char* lds;
    unsigned char* ws;
    int tid, lane, wave, vcu, G;
    karg_ptr_t kin;
    float* out;
    __device__ __forceinline__ const float* in(int i) const { return kin[i]; }
};

namespace pg8 {
constexpr int BM = 256, BK = 64, HALF = 128, HTB = HALF * BK * 2, KD = 1024, NT = KD / BK;
__device__ __forceinline__ int lds_byte(int r, int c) { const int st = (r >> 4) * 2 + (c >> 5), rr = r & 15, cc = c & 31, ob = rr * 64 + cc * 2; return st * 1024 + (ob ^ (((ob >> 9) & 1) << 5)); }
__device__ __forceinline__ void stage_rc(int b, int& R, int& C) { const int st = b / 1024, sb = b % 1024, swz = sb ^ (((sb >> 9) & 1) << 5); R = (st >> 1) * 16 + swz / 64; C = (st & 1) * 32 + (swz % 64) / 2; }
__device__ __forceinline__ int perm32(int rho) { const int n = rho >> 4, i = rho & 15; return 8 * (i >> 2) + 4 * n + (i & 3); }
struct Unit { int pm, pn, e, tt; };

typedef int v4i_t __attribute__((ext_vector_type(4)));
typedef int v8i_t __attribute__((ext_vector_type(8)));
__device__ __forceinline__ v8i_t cat8(bf16x8 a, bf16x8 b) { return __builtin_shufflevector(__builtin_bit_cast(v4i_t, a), __builtin_bit_cast(v4i_t, b), 0, 1, 2, 3, 4, 5, 6, 7); }
template <class Prob, bool ALIGN_EPI>
__device__ __forceinline__ void gemm_phase(LAS unsigned char* lds, const Prob& P) {
    const int tid = threadIdx.x, wid = __builtin_amdgcn_readfirstlane(tid >> 6), lane = tid & 63, wr = wid >> 2, wc = wid & 3, fr = lane & 15, fq = lane >> 4;
    constexpr int K = Prob::FP8 ? KD / 2 : KD, nt = Prob::FP8 ? NT / 2 : NT;
    unsigned voffB[2];
#pragma unroll
    for (int i = 0; i < 2; ++i) { int R_, C_; stage_rc(tid * 16 + i * 8192, R_, C_); const int Rb = (R_ & ~31) + perm32(R_ & 31); voffB[i] = (unsigned)(Rb * K + C_) * 2u; }
    constexpr size_t kstep = (size_t)(BK * 2);
    constexpr size_t hstepB = (size_t)HALF * K * 2;
    const unsigned ldsw = (unsigned)wid * 1024u;
    const int aoff = lds_byte(wr * 64 + fr, fq * 8), boff = lds_byte(wc * 32 + fr, fq * 8);
#define PG8_SA(b, h) (((b) * 2 + (h)) * HTB)
#define PG8_SB(b, h) ((4 + (b) * 2 + (h)) * HTB)
#define PG8_STAGE(bufoff, gbase, voff) do { _Pragma("unroll") for (int _i = 0; _i < 2; ++_i) \
        __builtin_amdgcn_global_load_lds((const unsigned*)((const char*)(gbase) + (voff)[_i]), (LAS unsigned*)(lds + (bufoff) + ldsw + _i * 8192), 16, 0, 0); } while (0)
#define PG8_RD(off) (*(const LAS bf16x8*)(lds + (off)))
#define PG8_LDA(dst, b, h) do { _Pragma("unroll") for (int m = 0; m < 4; ++m) { if constexpr (Prob::FP8) dst##8[m] = cat8(PG8_RD(PG8_SA(b, h) + aoff + m * 2048), PG8_RD(PG8_SA(b, h) + aoff + m * 2048 + 1024)); \
        else { _Pragma("unroll") for (int k = 0; k < 2; ++k) dst[m][k] = PG8_RD(PG8_SA(b, h) + aoff + m * 2048 + k * 1024); } } } while (0)
#define PG8_LDB(dst, b, h) do { _Pragma("unroll") for (int n = 0; n < 2; ++n) { if constexpr (Prob::FP8) dst##8[n] = cat8(PG8_RD(PG8_SB(b, h) + boff + n * 2048), PG8_RD(PG8_SB(b, h) + boff + n * 2048 + 1024)); \
        else { _Pragma("unroll") for (int k = 0; k < 2; ++k) dst[n][k] = PG8_RD(PG8_SB(b, h) + boff + n * 2048 + k * 1024); } } } while (0)
#define PG8_MMA(ai, bj, At, Bt) do { __builtin_amdgcn_s_setprio(1); _Pragma("unroll") for (int m = 0; m < 4; ++m) _Pragma("unroll") for (int n = 0; n < 2; ++n) { \
        if constexpr (Prob::FP8) asm volatile("s_nop 1\n\tv_mfma_f32_16x16x128_f8f6f4 %0, %1, %2, %0" : "+v"(acc[ai][bj][m][n]) : "v"(Bt##8[n]), "v"(At##8[m])); \
        else { _Pragma("unroll") for (int k = 0; k < 2; ++k) acc[ai][bj][m][n] = __builtin_amdgcn_mfma_f32_16x16x32_bf16(Bt[n][k], At[m][k], acc[ai][bj][m][n], 0, 0, 0); } } \
        __builtin_amdgcn_s_setprio(0); } while (0)
#define PG8_WAIT_V(n) asm volatile("s_waitcnt vmcnt(" #n ")" ::: "memory")
#define PG8_WAIT_L(n) asm volatile("s_waitcnt lgkmcnt(" #n ")" ::: "memory")
#define PG8_BAR __builtin_amdgcn_s_barrier()
#define PG8_SCHED __builtin_amdgcn_sched_barrier(0)
    Unit cur, nxt; int ui = 0;
    if (!P.next(0, cur)) return;
    f32x4 acc[2][2][4][2];
#pragma unroll
    for (int a = 0; a < 2; ++a)
#pragma unroll
        for (int b = 0; b < 2; ++b)
#pragma unroll
            for (int m = 0; m < 4; ++m)
#pragma unroll
                for (int n = 0; n < 2; ++n) acc[a][b][m][n] = (f32x4){0.f, 0.f, 0.f, 0.f};
    bf16x8 At[4][2], B0[2][2], B1[2][2]; v8i_t At8[4], B08[2], B18[2]; (void)At; (void)B0; (void)B1; (void)At8; (void)B08; (void)B18;
    unsigned vo[2][2];
    { int R[2], C[2]; stage_rc(tid * 16, R[0], C[0]); stage_rc(tid * 16 + 8192, R[1], C[1]); P.aoff(cur, R, C, vo); }
    const char* cA = P.abase(cur);
    const char* cB = P.bptr(cur);
    float pfc = P.pre(cur, tid), pfn = 0.f;
    PG8_STAGE(PG8_SB(0, 0), cB, voffB); PG8_STAGE(PG8_SB(0, 1), cB + hstepB, voffB); PG8_STAGE(PG8_SA(0, 0), cA, vo[0]); PG8_STAGE(PG8_SA(0, 1), cA, vo[1]);
    if (wr == 1) PG8_BAR;
    PG8_WAIT_V(2); PG8_BAR;
    PG8_STAGE(PG8_SB(1, 0), cB + kstep, voffB); PG8_STAGE(PG8_SA(1, 0), cA + kstep, vo[0]); PG8_STAGE(PG8_SB(1, 1), cB + hstepB + kstep, voffB);
    PG8_WAIT_V(6); PG8_BAR;
    for (;;) {
        const bool has_next = P.next(ui + 1, nxt);
        const char* nB = has_next ? P.bptr(nxt) : cB;
        const char* nA = has_next ? P.abase(nxt) : cA;
#pragma nounroll
        for (int t = 0; t < nt; t += 2) {
            const bool last = (t == nt - 2);
            const char* a1 = cA + (size_t)(t + 1) * kstep;
            const char* a2 = last ? nA : cA + (size_t)(t + 2) * kstep; const char* b2 = last ? nB : cB + (size_t)(t + 2) * kstep;
            const char* a3 = a2 + kstep; const char* b3 = b2 + kstep;
            unsigned w2[2][2];
#pragma unroll
            for (int h = 0; h < 2; ++h)
#pragma unroll
                for (int i = 0; i < 2; ++i) w2[h][i] = vo[h][i];
            if (last && has_next) { int R[2], C[2]; stage_rc(tid * 16, R[0], C[0]); stage_rc(tid * 16 + 8192, R[1], C[1]); P.aoff(nxt, R, C, w2); pfn = P.pre(nxt, tid); }
            PG8_LDB(B0, 0, 0); PG8_LDB(B1, 0, 1); PG8_SCHED; PG8_LDA(At, 0, 0); PG8_STAGE(PG8_SA(1, 1), a1, vo[1]);
            PG8_WAIT_V(8); PG8_WAIT_L(0); PG8_BAR; PG8_MMA(0, 0, At, B0); PG8_MMA(0, 1, At, B1); PG8_BAR; PG8_SCHED;
            PG8_LDA(At, 0, 1); PG8_STAGE(PG8_SB(0, 0), b2, voffB); PG8_STAGE(PG8_SB(0, 1), b2 + hstepB, voffB); PG8_STAGE(PG8_SA(0, 0), a2, w2[0]);
            PG8_WAIT_V(8); PG8_WAIT_L(0); PG8_BAR; PG8_MMA(1, 0, At, B0); PG8_MMA(1, 1, At, B1); PG8_BAR; PG8_SCHED;
            PG8_LDB(B0, 1, 0); PG8_LDB(B1, 1, 1); PG8_SCHED; PG8_LDA(At, 1, 0); PG8_STAGE(PG8_SA(0, 1), a2, w2[1]);
            PG8_WAIT_V(8); PG8_WAIT_L(0); PG8_BAR; PG8_MMA(0, 0, At, B0); PG8_MMA(0, 1, At, B1); PG8_BAR; PG8_SCHED;
            PG8_LDA(At, 1, 1); PG8_STAGE(PG8_SB(1, 0), b3, voffB); PG8_STAGE(PG8_SB(1, 1), b3 + hstepB, voffB); PG8_STAGE(PG8_SA(1, 0), a3, w2[0]);
            PG8_WAIT_V(8); PG8_WAIT_L(0); PG8_BAR; PG8_MMA(1, 0, At, B0); PG8_MMA(1, 1, At, B1); PG8_BAR; PG8_SCHED;
        }
        if constexpr (ALIGN_EPI) { if (wr == 0) PG8_BAR; }
        { int fr_ = fr, fq_ = fq; asm volatile("" : "+v"(fr_), "+v"(fq_)); P.epi(acc, cur, wr, wc, fr_, fq_, pfc); }
        if (!has_next) break;
#pragma unroll
        for (int a = 0; a < 2; ++a)
#pragma unroll
            for (int b = 0; b < 2; ++b)
#pragma unroll
                for (int m = 0; m < 4; ++m)
#pragma unroll
                    for (int n = 0; n < 2; ++n) acc[a][b][m][n] = (f32x4){0.f, 0.f, 0.f, 0.f};
        cur = nxt; cB = nB; cA = nA; ++ui; pfc = pfn;
        { int R[2], C[2]; stage_rc(tid * 16, R[0], C[0]); stage_rc(tid * 16 + 8192, R[1], C[1]); P.aoff(cur, R, C, vo); }
        if constexpr (ALIGN_EPI) { if (wr == 1) PG8_BAR; }
    }
    PG8_WAIT_V(0);
    if constexpr (!ALIGN_EPI) { if (wr == 0) PG8_BAR; }
    PG8_BAR;
#undef PG8_SA
#undef PG8_SB
#undef PG8_STAGE
#undef PG8_LDA
#undef PG8_RD
#undef PG8_LDB
#undef PG8_MMA
#undef PG8_SCHED
}
struct StaticOrder {
    int nM, nN, nwg, G, c;
    __device__ void init(int M, int N, int G_, int c_) { nM = M / BM; nN = N / BM; nwg = nM * nN; G = G_; c = c_; }
    __device__ bool next(int i, int& pm, int& pn) const {
        const long L = (long)i * G + c; if (L >= nwg) return false;
        int wgid = (int)L; { const int q = nwg / 8, r = nwg % 8, xcd = wgid % 8, off = wgid / 8; wgid = (xcd < r ? xcd * (q + 1) : r * (q + 1) + (xcd - r) * q) + off; }
        const int nig = 8 * nN, gid = wgid / nig, fm = gid * 8, gsz = (nM - fm) < 8 ? (nM - fm) : 8;
        pm = fm + ((wgid % nig) % gsz); pn = (wgid % nig) / gsz; return true;
    }
};
}

__device__ __forceinline__ void p0_transpose_item(const float* W, int K, int N, bf16_t* WT, int out_row0, const float* g, LAS float* scr, int kb, int nb, int lane) {
    const int k0 = 64 * kb, n0 = 32 * nb;
#pragma unroll
    for (int i = 0; i < 8; ++i) { const int kk = 8 * i + (lane >> 3), c4 = lane & 7;
        *(LAS f32x4*)(scr + kk * 36 + ((4 * c4 + 4 * (kk >> 3)) & 31)) = __builtin_nontemporal_load((const f32x4*)(W + (size_t)(k0 + kk) * N + n0 + 4 * c4)); }
    LDS_WAIT(); asm volatile("" ::: "memory");
    const int c = lane & 7;
    float gv[8];
#pragma unroll
    for (int q = 0; q < 8; ++q) gv[q] = g ? g[k0 + 8 * c + q] : 1.0f;
#pragma unroll
    for (int j = 0; j < 4; ++j) { const int n = (lane >> 3) + 8 * j; const LAS float* s = scr + (8 * c) * 36 + ((n + 4 * c) & 31);
        u32x4 o; o.x = pk2(s[0 * 36] * gv[0], s[1 * 36] * gv[1]); o.y = pk2(s[2 * 36] * gv[2], s[3 * 36] * gv[3]); o.z = pk2(s[4 * 36] * gv[4], s[5 * 36] * gv[5]); o.w = pk2(s[6 * 36] * gv[6], s[7 * 36] * gv[7]);
        *(u32x4*)(WT + (size_t)(out_row0 + n) * K + k0 + 8 * c) = o; }
    LDS_WAIT(); asm volatile("" ::: "memory");
}
__device__ __forceinline__ void p0_prologue(Frame& F) {
    LAS float* scr = (LAS float*)(F.lds + F.wave * 16384);
    const int gw = F.vcu * NWAVES + F.wave, NGW = F.G * NWAVES;
    const float* x = F.in(0); const float* g1 = F.in(1); const float* w_in = F.in(2); const float* w_out = F.in(17); const float* g2 = F.in(18);
    bf16_t* WIN = (bf16_t*)(F.ws + WS_WIN); bf16_t* WOUT = (bf16_t*)(F.ws + WS_WOUT);
    constexpr int I_IN = 16 * 80, I_OUT = 16 * 32;
    constexpr int NITEMS = I_IN + I_OUT;
    for (int it = gw; it < NITEMS; it += NGW) {
        int r = it;
        if (r < I_IN) { const int kb = r / 80, nb = r % 80; p0_transpose_item(w_in, DM, DIN, WIN, 32 * nb, g1, scr, kb, nb, F.lane); continue; } r -= I_IN;
        { const int kb = r / 32, nb = r % 32; p0_transpose_item(w_out, DM, DM, WOUT, 32 * nb, nullptr, scr, kb, nb, F.lane); }
    }
    {
        const float* rw = F.in(19); bf16_t* WRH = (bf16_t*)(F.ws + WS_WRH); bf16_t* WRL = (bf16_t*)(F.ws + WS_WRL);
        const float* wa = F.in(5); const float* wx = F.in(7); bf16_t* WAT = (bf16_t*)(F.ws + WS_WAT); bf16_t* WXT = (bf16_t*)(F.ws + WS_WXT);
        const int gt = F.vcu * NTHR + F.tid, NGT = F.G * NTHR;
        for (int i = gt; i < 32768; i += NGT) {
            { const int n = i >> 10, k = i & 1023; const float v = rw[k * NEXP + n] * g2[k]; const unsigned h = f2bf(v); WRH[i] = (bf16_t)h; WRL[i] = (bf16_t)f2bf(v - bf2f(h)); }
            { const int nblk = i >> 12, j = (i >> 6) & 63, ii = i & 63; WAT[i] = (bf16_t)f2bf(wa[(nblk * 64 + ii) * 64 + j]); WXT[i] = (bf16_t)f2bf(wx[(nblk * 64 + ii) * 64 + j]); }
        }
    }
    {
        bf16_t* XB = (bf16_t*)(F.ws + WS_XB); float* RS1 = (float*)(F.ws + WS_RSTD1);
        for (int m = gw; m < MTOK; m += NGW) {
            const f32x4* xr = (const f32x4*)(x + (size_t)m * DM) + F.lane;
            f32x4 v[4]; float s = 0.f;
#pragma unroll
            for (int j = 0; j < 4; ++j) { v[j] = __builtin_nontemporal_load(&xr[64 * j]); s += (v[j].x * v[j].x + v[j].y * v[j].y) + (v[j].z * v[j].z + v[j].w * v[j].w); }
            s = wave_sum(s);
            if (F.lane == 0) RS1[m] = 1.0f / sqrtf(s * (1.0f / DM) + EPS);
            u32x2* o8 = (u32x2*)(XB + (size_t)m * DM) + F.lane;
#pragma unroll
            for (int j = 0; j < 4; ++j) { u32x2 w; w.x = pk2(v[j].x, v[j].y); w.y = pk2(v[j].z, v[j].w); o8[64 * j] = w; }
        }
    }
}

constexpr int STG_BUF0 = 3 * pg8::HTB, STG_BUF1 = LDS_AUX + 8192;
constexpr int LDS_PFX = LDS_AUX + 26624;
struct RowStager {
    LAS unsigned char* lds; int wr, wc, fr, fq, tid;
    template <class RowPtr> __device__ __forceinline__ void chunk(int c, u32x4 w0, u32x4 w1, const RowPtr& rowp) const {
        LAS unsigned char* buf = lds + ((c & 1) ? STG_BUF1 : STG_BUF0);
        const int rl = wr * 16 + fr, p0 = wc * 4 + fq;
        *(LAS u32x4*)(buf + rl * 512 + ((p0 ^ (rl & 7)) << 4)) = w0;
        *(LAS u32x4*)(buf + rl * 512 + (((16 + p0) ^ (rl & 7)) << 4)) = w1;
        asm volatile("s_waitcnt lgkmcnt(0)" ::: "memory"); __builtin_amdgcn_s_barrier(); asm volatile("" ::: "memory");
        const int ai = c >> 2, m = c & 3;
#pragma unroll
        for (int j = 0; j < 2; ++j) { const int p = tid + 512 * j, r2 = p >> 5, pi = p & 31;
            const u32x4 v = *(const LAS u32x4*)(buf + r2 * 512 + ((pi ^ (r2 & 7)) << 4));
            *(u32x4*)(rowp(ai * 128 + (r2 >> 4) * 64 + m * 16 + (r2 & 15)) + pi * 16) = v; }
    }
};

struct ProbInProj {
    static constexpr bool FP8 = false;
    pg8::StaticOrder S; const char* A; const char* Bt; const float* rstd1; bf16_t* dst0; const float* qg; const float* kg; LAS float* xs; LAS unsigned char* lds;
    __device__ __forceinline__ bool next(int i, pg8::Unit& u) const { u.e = 0; u.tt = 0; return S.next(i, u.pm, u.pn); }
    __device__ __forceinline__ const char* abase(const pg8::Unit& u) const { return A + (size_t)u.pm * 256 * DM * 2; }
    __device__ __forceinline__ void aoff(const pg8::Unit& u, const int (&R)[2], const int (&C)[2], unsigned (&vo)[2][2]) const {
#pragma unroll
        for (int h = 0; h < 2; ++h)
#pragma unroll
            for (int i = 0; i < 2; ++i) vo[h][i] = (unsigned)((h * 128 + R[i]) * DM + C[i]) * 2u;
    }
    __device__ __forceinline__ const char* bptr(const pg8::Unit& u) const { return Bt + (size_t)u.pn * 256 * DM * 2; }
    __device__ __forceinline__ float pre(const pg8::Unit& u, int tid) const { return ld_untracked(rstd1 + u.pm * 256 + (tid & 255)); }
    __device__ __forceinline__ void epi(f32x4 (&acc)[2][2][4][2], const pg8::Unit& u, int wr, int wc, int fr, int fq, float pf) const {
        const int type = u.pn >> 1;
        bf16_t* dst = dst0 + (size_t)type * ((WS_GG - WS_XR) / 2);
        const int row0 = u.pm * 256 + wr * 64 + fr, col0 = (u.pn & 1) * 256 + wc * 32 + 8 * fq;
        LAS float* pfx = (LAS float*)(lds + LDS_PFX);
        if (wr == 0) pfx[wc * 64 + fq * 16 + fr] = pf;
        asm volatile("s_waitcnt lgkmcnt(0)" ::: "memory"); __builtin_amdgcn_s_barrier(); asm volatile("" ::: "memory");
        float rs[2][4];
#pragma unroll
        for (int ai = 0; ai < 2; ++ai)
#pragma unroll
            for (int m = 0; m < 4; ++m) rs[ai][m] = pfx[wr * 64 + fr + ai * 128 + m * 16];
#pragma unroll
        for (int ai = 0; ai < 2; ++ai)
#pragma unroll
            for (int bj = 0; bj < 2; ++bj)
#pragma unroll
                for (int m = 0; m < 4; ++m)
#pragma unroll
                    for (int n = 0; n < 2; ++n) acc[ai][bj][m][n] = acc[ai][bj][m][n] * rs[ai][m];
        if (type == 1) {
#pragma unroll
            for (int ai = 0; ai < 2; ++ai)
#pragma unroll
                for (int bj = 0; bj < 2; ++bj)
#pragma unroll
                    for (int m = 0; m < 4; ++m)
#pragma unroll
                        for (int n = 0; n < 2; ++n) acc[ai][bj][m][n] = gelu_tanh4(acc[ai][bj][m][n]);
        }
        if (type == 2 || type == 3) {
            const int lane = fq * 16 + fr; (void)lane;
            float ss[2][4][2];
#pragma unroll
            for (int ai = 0; ai < 2; ++ai)
#pragma unroll
                for (int m = 0; m < 4; ++m)
#pragma unroll
                    for (int bj = 0; bj < 2; ++bj) { const f32x4 a = acc[ai][bj][m][0], b = acc[ai][bj][m][1]; const f32x4 q = a * a + b * b;
                        float s = (q[0] + q[1]) + (q[2] + q[3]);
                        s = add_xor16(s); s = add_xor32(s); ss[ai][m][bj] = s; }
            LAS float* mine = xs + ((wr * 4 + wc) * 8) * 32; LAS float* other = xs + ((wr * 4 + (wc ^ 1)) * 8) * 32;
            if (fq == 0) {
#pragma unroll
                for (int ai = 0; ai < 2; ++ai)
#pragma unroll
                    for (int m = 0; m < 4; ++m) { f32x2 w; w.x = ss[ai][m][0]; w.y = ss[ai][m][1]; *(LAS f32x2*)(mine + ((ai * 4 + m) * 16 + fr) * 2) = w; }
            }
            asm volatile("s_waitcnt lgkmcnt(0)" ::: "memory"); __builtin_amdgcn_s_barrier(); asm volatile("" ::: "memory");
            const float* g = (type == 2) ? qg : kg; const float sc = (type == 2) ? 0.125f * LOG2E : 1.0f;
            f32x4 gv[2];
#pragma unroll
            for (int n = 0; n < 2; ++n) gv[n] = *(const f32x4*)(g + 32 * (wc & 1) + 8 * fq + 4 * n) * sc;
#pragma unroll
            for (int ai = 0; ai < 2; ++ai)
#pragma unroll
                for (int m = 0; m < 4; ++m) { const f32x2 o = *(const LAS f32x2*)(other + ((ai * 4 + m) * 16 + fr) * 2);
#pragma unroll
                    for (int bj = 0; bj < 2; ++bj) { const float tot = ss[ai][m][bj] + (bj == 0 ? o.x : o.y); const float r = __builtin_amdgcn_rsqf(tot * (1.0f / 64.0f) + EPS);
#pragma unroll
                        for (int n = 0; n < 2; ++n) acc[ai][bj][m][n] = acc[ai][bj][m][n] * (gv[n] * r); } }
        }
        { const RowStager ST{lds, wr, wc, fr, fq, (wr * 4 + wc) * 64 + fq * 16 + fr};
          char* tbase = (char*)(dst + (size_t)u.pm * 256 * 512 + (u.pn & 1) * 256);
          auto rowp = [tbase](int r) { return tbase + (size_t)r * 1024; };
#pragma unroll
          for (int ai = 0; ai < 2; ++ai)
#pragma unroll
              for (int m = 0; m < 4; ++m) { u32x4 w[2];
#pragma unroll
                  for (int bj = 0; bj < 2; ++bj) { const f32x4 v0 = acc[ai][bj][m][0], v1 = acc[ai][bj][m][1];
                      w[bj].x = cvt_pk_bf16(v0[0], v0[1]); w[bj].y = cvt_pk_bf16(v0[2], v0[3]); w[bj].z = cvt_pk_bf16(v1[0], v1[1]); w[bj].w = cvt_pk_bf16(v1[2], v1[3]); }
                  ST.chunk(ai * 4 + m, w[0], w[1], rowp); } }
    }
};

__device__ __forceinline__ void conv_unit(Frame& F, int cu) {
    int lane = F.lane; asm volatile("" : "+v"(lane));
    const int wave = F.wave;
    LAS float* scr = (LAS float*)(F.lds + wave * 16384);
    const bool first = cu < 512;
    const int e = first ? (cu >> 4) : ((cu - 512) >> 3);
    const float* W = first ? F.in(21) + (size_t)e * DM * 2 * DFF : F.in(23) + (size_t)e * DFF * DM;
    unsigned char* WT = first ? F.ws + WS_W1 + (size_t)e * 2 * DFF * DM : F.ws + WS_W2 + (size_t)e * DM * DFF;
    const int N = first ? 2 * DFF : DM;
    const int c = lane & 3;
    float gv[16];
    { const float* g2 = F.in(18);
#pragma unroll
      for (int q = 0; q < 16; ++q) gv[q] = first ? g2[64 * (cu & 15) + 16 * c + q] * WSCALE : WSCALE; }
#define CV_GEOM(j, k0_, n0_, or_) do { const int idx_ = 8 * (j) + wave; \
        if (first) { k0_ = 64 * (cu & 15); n0_ = 32 * idx_; const int j0_ = n0_ & 1023; or_ = 256 * (j0_ >> 7) + (j0_ & 127) + ((n0_ >= 1024) ? 128 : 0); } \
        else { k0_ = 64 * (2 * ((cu - 512) & 7) + (idx_ >> 5)); n0_ = 32 * (idx_ & 31); or_ = n0_; } } while (0)
#define CV_LOAD(LD, k0_, n0_) do { _Pragma("unroll") for (int i = 0; i < 8; ++i) { const int kk = 8 * i + (lane >> 3), c4 = lane & 7; \
        LD[i] = __builtin_nontemporal_load((const f32x4*)(W + (size_t)((k0_) + kk) * N + (n0_) + 4 * c4)); } } while (0)
#define CV_ITEM(LD, j) do { \
        _Pragma("unroll") for (int i = 0; i < 8; ++i) { const int kk = 8 * i + (lane >> 3), c4 = lane & 7; \
            *(LAS f32x4*)(scr + kk * 36 + ((4 * c4 + 4 * (kk >> 3)) & 31)) = LD[i]; }         \
        int k0c, n0c, orc; CV_GEOM(j, k0c, n0c, orc); (void)n0c; \
        if ((j) + 2 < 8) { int k0n, n0n, orn; CV_GEOM((j) + 2, k0n, n0n, orn); (void)orn; CV_LOAD(LD, k0n, n0n); } \
        LDS_WAIT(); asm volatile("" ::: "memory"); \
        _Pragma("unroll") for (int j2 = 0; j2 < 2; ++j2) { const int n = (lane >> 2) + 16 * j2; const LAS float* sp = scr + (16 * c) * 36; \
            const int nc0 = (n + 8 * c) & 31, nc1 = (n + 8 * c + 4) & 31;           \
            unsigned w[4]; \
            _Pragma("unroll") for (int q = 0; q < 4; ++q) { unsigned t = 0; const int nc = (q < 2) ? nc0 : nc1; \
                t = __builtin_amdgcn_cvt_pk_fp8_f32(sp[(4 * q) * 36 + nc] * gv[4 * q], sp[(4 * q + 1) * 36 + nc] * gv[4 * q + 1], t, false); \
                t = __builtin_amdgcn_cvt_pk_fp8_f32(sp[(4 * q + 2) * 36 + nc] * gv[4 * q + 2], sp[(4 * q + 3) * 36 + nc] * gv[4 * q + 3], t, true); w[q] = t; } \
            *(u32x4*)(WT + (size_t)(orc + n) * 1024 + k0c + 16 * c) = (u32x4){w[0], w[1], w[2], w[3]}; } \
        LDS_WAIT(); asm volatile("" ::: "memory"); } while (0)
    f32x4 lda[8], ldb[8];
    { int k0, n0, orow; CV_GEOM(0, k0, n0, orow); (void)orow; CV_LOAD(lda, k0, n0); CV_GEOM(1, k0, n0, orow); CV_LOAD(ldb, k0, n0); }
    CV_ITEM(lda, 0); CV_ITEM(ldb, 1); CV_ITEM(lda, 2); CV_ITEM(ldb, 3); CV_ITEM(lda, 4); CV_ITEM(ldb, 5); CV_ITEM(lda, 6); CV_ITEM(ldb, 7);
#undef CV_ITEM
#undef CV_GEOM
#undef CV_LOAD
}

__device__ __forceinline__ void rglru_item(Frame& F, int item) {
    const int bb = item >> 3, nb = item & 7;
    int tid = F.tid; asm volatile("" : "+v"(tid));
    const int lane = tid & 63, wid = F.wave;
    const bf16_t* XR = (const bf16_t*)(F.ws + WS_XR); const bf16_t* GG = (const bf16_t*)(F.ws + WS_GG); bf16_t* Y = (bf16_t*)(F.ws + WS_Y);
    const float* conv_w = F.in(3); const float* conv_b = F.in(4); const float* ba = F.in(6); const float* bx = F.in(8); const float* lam = F.in(9);
    const bf16_t* WAT = (const bf16_t*)(F.ws + WS_WAT); const bf16_t* WXT = (const bf16_t*)(F.ws + WS_WXT);
    LAS bf16_t* XCb = (LAS bf16_t*)(F.lds);
    LAS float* XCf = (LAS float*)(F.lds + 9216);
    LAS float* RGl = (LAS float*)(F.lds + 9216 + 16384);
    LAS float* SEG = (LAS float*)(F.lds + 9216 + 16384 + 32768);
    LAS float* HC = (LAS float*)(F.lds + 9216 + 16384 + 32768 + 4096);
    const int ct = tid >> 3, cg = tid & 7, chb = nb * 64 + 8 * cg;
    float cw[4][8], cb[8];
#pragma unroll
    for (int j = 0; j < 4; ++j)
#pragma unroll
        for (int c = 0; c < 8; ++c) cw[j][c] = conv_w[j * DRNN + chb + c];
#pragma unroll
    for (int c = 0; c < 8; ++c) cb[c] = conv_b[chb + c];
    const int g = wid >> 2, mt = wid & 3, l15 = lane & 15, kq = lane >> 4;
    bf16x8 Bf[4][2];
    { const bf16_t* WT = (g == 0 ? WAT : WXT) + nb * 4096;
#pragma unroll
      for (int ntl = 0; ntl < 4; ++ntl)
#pragma unroll
          for (int ks = 0; ks < 2; ++ks) Bf[ntl][ks] = *(const bf16x8*)(WT + (16 * ntl + l15) * 64 + 32 * ks + 8 * kq); }
    float gbias[4];
#pragma unroll
    for (int ntl = 0; ntl < 4; ++ntl) gbias[ntl] = (g == 0 ? ba : bx)[nb * 64 + 16 * ntl + l15];
    const int sc = tid & 63, sg = tid >> 6;
    const float sp8 = 8.0f * log1pf(expf(-lam[nb * 64 + sc]));
    if (tid < 64) HC[tid] = 0.f;
    const size_t rowbase = (size_t)bb * SEQ;
    u32x4 xv[4];
#pragma unroll
    for (int j = 0; j < 4; ++j) { const int t = ct - 3 + j; xv[j] = (t >= 0) ? *(const u32x4*)(XR + (rowbase + t) * DRNN + chb) : (u32x4){0u, 0u, 0u, 0u}; }
    for (int c = 0; c < SEQ / 64; ++c) {
        const int t0 = 64 * c;
        {
            float xc[8];
#pragma unroll
            for (int q = 0; q < 8; ++q) xc[q] = cb[q];
#pragma unroll
            for (int j = 0; j < 4; ++j) { const unsigned w[4] = {xv[j].x, xv[j].y, xv[j].z, xv[j].w};
#pragma unroll
                for (int q = 0; q < 4; ++q) { xc[2 * q] += cw[j][2 * q] * bf2f(w[q] & 0xffffu); xc[2 * q + 1] += cw[j][2 * q + 1] * bf2f(w[q] >> 16); } }
            if (c + 1 < SEQ / 64) {
#pragma unroll
                for (int j = 0; j < 4; ++j) xv[j] = *(const u32x4*)(XR + (rowbase + t0 + 64 + ct - 3 + j) * DRNN + chb);
            }
            u32x4 pb; pb.x = pk2(xc[0], xc[1]); pb.y = pk2(xc[2], xc[3]); pb.z = pk2(xc[4], xc[5]); pb.w = pk2(xc[6], xc[7]);
            *(LAS u32x4*)(XCb + ct * 72 + 8 * cg) = pb;
            *(LAS f32x4*)(XCf + ct * 64 + 8 * cg) = (f32x4){xc[0], xc[1], xc[2], xc[3]};
            *(LAS f32x4*)(XCf + ct * 64 + 8 * cg + 4) = (f32x4){xc[4], xc[5], xc[6], xc[7]};
        }
        unsigned short gq[8];
#pragma unroll
        for (int s8 = 0; s8 < 8; ++s8) gq[s8] = GG[(rowbase + t0 + 8 * sg + s8) * DRNN + nb * 64 + sc];
        __syncthreads();
        {
            bf16x8 Af[2];
#pragma unroll
            for (int ks = 0; ks < 2; ++ks) Af[ks] = *(const LAS bf16x8*)(XCb + (16 * mt + l15) * 72 + 32 * ks + 8 * kq);
#pragma unroll
            for (int ntl = 0; ntl < 4; ++ntl) {
                f32x4 d = (f32x4){0.f, 0.f, 0.f, 0.f};
#pragma unroll
                for (int ks = 0; ks < 2; ++ks) d = __builtin_amdgcn_mfma_f32_16x16x32_bf16(Af[ks], Bf[ntl][ks], d, 0, 0, 0);
#pragma unroll
                for (int r = 0; r < 4; ++r) RGl[g * 4096 + (16 * mt + 4 * kq + r) * 64 + 16 * ntl + l15] = fast_sigmoid(d[r] + gbias[ntl]);
            }
        }
        __syncthreads();
        float av[8], uv[8]; float Aseg = 1.f, Hseg = 0.f;
#pragma unroll
        for (int s8 = 0; s8 < 8; ++s8) { const int tok = 8 * sg + s8;
            const float r = RGl[tok * 64 + sc], ig = RGl[4096 + tok * 64 + sc], xcv = XCf[tok * 64 + sc];
            const float la = -sp8 * r, y2 = 2.0f * la;
            const float a = __expf(la);
            const float om = (y2 > -0.1f) ? -y2 * (1.0f + y2 * (0.5f + y2 * (0.16666667f + y2 * 0.041666668f))) : (1.0f - __expf(y2));
            const float u = __builtin_amdgcn_sqrtf(om) * (ig * xcv);
            av[s8] = a; uv[s8] = u; Aseg *= a; Hseg = a * Hseg + u; }
        SEG[(sg * 64 + sc) * 2] = Aseg; SEG[(sg * 64 + sc) * 2 + 1] = Hseg;
        __syncthreads();
        float h = HC[(c & 1) * 64 + sc];
        for (int s2 = 0; s2 < sg; ++s2) h = SEG[(s2 * 64 + sc) * 2] * h + SEG[(s2 * 64 + sc) * 2 + 1];
#pragma unroll
        for (int s8 = 0; s8 < 8; ++s8) { h = av[s8] * h + uv[s8]; Y[(rowbase + t0 + 8 * sg + s8) * DM + nb * 64 + sc] = (bf16_t)f2bf(h * bf2f(gq[s8])); }
        if (sg == 7) HC[((c + 1) & 1) * 64 + sc] = h;
    }
    __syncthreads();
}

namespace att {
constexpr float ATT_THR = 8.0f;
constexpr int LK0 = 0, LK1 = 8192, LV = 16384, LBUF = 32768  , LWS = 98304, LOX = 0;
__device__ __forceinline__ int crow(int r, int hi) { return (r & 3) + 8 * (r >> 2) + 4 * hi; }
__device__ __forceinline__ void glds16(const void* gsrc, unsigned lds_dst) { unsigned keep;
    asm volatile("s_mov_b32 %0, m0\n\ts_mov_b32 m0, %2\n\ts_nop 0\n\tglobal_load_lds_dwordx4 %1, off\n\ts_mov_b32 m0, %0" : "=&s"(keep) : "v"(gsrc), "s"(lds_dst) : "memory"); }
typedef __attribute__((address_space(3))) const char* lds_cptr;
typedef short v4i16_t __attribute__((ext_vector_type(4)));
__device__ __forceinline__ s16x4 vtr(lds_cptr p) { return __builtin_bit_cast(s16x4, __builtin_amdgcn_ds_read_tr16_b64_v4i16((__attribute__((address_space(3))) v4i16_t*)p)); }
template <int CTRL> __device__ __forceinline__ float dpp_f(float x) { return __int_as_float(__builtin_amdgcn_update_dpp(0, __float_as_int(x), CTRL, 0xf, 0xf, true)); }
__device__ __forceinline__ float rowmax_pos(const f32x16& p0, const f32x16& p1) {
    int a = 0, b = 0;
#pragma unroll
    for (int r = 0; r < 16; r += 2) { a = max(max(a, __float_as_int(p0[r])), __float_as_int(p0[r + 1])); b = max(max(b, __float_as_int(p1[r])), __float_as_int(p1[r + 1])); }
    a = max(a, b);
    unsigned ua = (unsigned)a, ub = ua; swap_rows32(ua, ub);
    return __int_as_float(max((int)ua, (int)ub));
}
__device__ __forceinline__ void attn_unit(Frame& F, int b, int h, int qb, float lam) {
    int lane = F.lane; asm volatile("" : "+v"(lane));
    const int r32 = lane & 31, hi = lane >> 5, wid = F.wave, mp = wid >> 2, wq = wid & 3;
    const bf16_t* Q = (const bf16_t*)(F.ws + WS_Q); const bf16_t* K = (const bf16_t*)(F.ws + WS_K); const bf16_t* V = (const bf16_t*)(F.ws + WS_V); bf16_t* Y = (bf16_t*)(F.ws + WS_Y);
    const float* subg = F.in(16);
    char* shm = (char*)F.lds;
    const unsigned lds0 = (unsigned)(uintptr_t)shm;
    const size_t rowbase = (size_t)b * SEQ; const int q0 = qb * 128;
    const int NT = 2 * (qb + 1);
    float* wsf = (float*)(shm + LWS) + wid * 64;
    bf16x8 qr[4];
    { const bf16_t* Qw = Q + (rowbase + q0 + wq * 32 + r32) * 512 + h * 128 + mp * 64;
#pragma unroll
      for (int d0 = 0; d0 < 4; ++d0) qr[d0] = *(const bf16x8*)(Qw + d0 * 16 + hi * 8); }
    const bf16_t* ks0 = K + (rowbase + lane) * 512 + h * 128 + wid * 8;
    const bf16_t* ks1 = ks0 + 64;
    const bf16_t* vs0 = V + (rowbase + 16 * (wid & 3) + (lane >> 2)) * 512 + h * 128 + (wid >> 2) * 32 + (lane & 3) * 8;
    const bf16_t* vs1 = vs0 + 64;
    const unsigned kd0 = (unsigned)__builtin_amdgcn_readfirstlane(lds0 + LK0 + wid * 1024), kd1 = (unsigned)__builtin_amdgcn_readfirstlane(lds0 + LK1 + wid * 1024);
    const unsigned vd0 = (unsigned)__builtin_amdgcn_readfirstlane(lds0 + LV + wid * 1024), vd1 = (unsigned)__builtin_amdgcn_readfirstlane(lds0 + LV + (wid + 8) * 1024);
    const lds_cptr shm3 = (lds_cptr)(F.lds);
    const lds_cptr kp0 = shm3 + (mp ? LK1 : LK0) + hi * 1024 + r32 * 16;
    const lds_cptr vp0 = shm3 + LV + ((lane >> 4) & 1) * 32 + (lane & 3) * 8 + (4 * hi + ((lane & 15) >> 2)) * 64;
    f32x16 negm = f32x16{}; asm volatile("" : "+v"(negm));
    float m_run = 0.f, l_run = 0.f;
    f32x16 o[4];
#pragma unroll
    for (int d = 0; d < 4; ++d) o[d] = f32x16{};
    const int qrel = wq * 32 + r32;
    glds16(ks0, kd0); glds16(ks1, kd1); glds16(vs0, vd0); glds16(vs1, vd1);
    asm volatile("" : "+v"(qr[0]), "+v"(qr[1]), "+v"(qr[2]), "+v"(qr[3]));
    f32x16 p0, p1;
    u32x4 pw[4];
    int bcur = 0, bprev = 0, bnext = LBUF;
#define ATT_QK(P0, P1, slot) do { _Pragma("unroll") for (int d0 = 0; d0 < 4; ++d0) { \
        const bf16x8 k0f = *(const __attribute__((address_space(3))) bf16x8*)(kp0 + (slot) + d0 * 2048); \
        const bf16x8 k1f = *(const __attribute__((address_space(3))) bf16x8*)(kp0 + (slot) + d0 * 2048 + 512); \
        if (d0 == 0) { P0 = __builtin_amdgcn_mfma_f32_32x32x16_bf16(k0f, qr[0], negm, 0, 0, 0); P1 = __builtin_amdgcn_mfma_f32_32x32x16_bf16(k1f, qr[0], negm, 0, 0, 0); } \
        else { P0 = __builtin_amdgcn_mfma_f32_32x32x16_bf16(k0f, qr[d0], P0, 0, 0, 0); P1 = __builtin_amdgcn_mfma_f32_32x32x16_bf16(k1f, qr[d0], P1, 0, 0, 0); } } } while (0)
#define ATT_MASK(P0, P1, t) do { if ((t) >= NT - 2) { const int kb_ = 64 * ((t) - (NT - 2)) + 4 * hi; \
        _Pragma("unroll") for (int r = 0; r < 16; ++r) { const int kv = kb_ + (r & 3) + 8 * (r >> 2); if (kv > qrel) P0[r] = -INFINITY; if (kv + 32 > qrel) P1[r] = -INFINITY; } } } while (0)
#define ATT_SUMPACK(P0, P1) do { float sacc = 0.f; _Pragma("unroll") for (int r = 0; r < 16; ++r) sacc += P0[r] + P1[r]; l_run += sacc; \
        pw[0] = (u32x4){cvt_pk_bf16(P0[0], P0[1]), cvt_pk_bf16(P0[2], P0[3]), cvt_pk_bf16(P0[4], P0[5]), cvt_pk_bf16(P0[6], P0[7])}; \
        pw[1] = (u32x4){cvt_pk_bf16(P0[8], P0[9]), cvt_pk_bf16(P0[10], P0[11]), cvt_pk_bf16(P0[12], P0[13]), cvt_pk_bf16(P0[14], P0[15])}; \
        pw[2] = (u32x4){cvt_pk_bf16(P1[0], P1[1]), cvt_pk_bf16(P1[2], P1[3]), cvt_pk_bf16(P1[4], P1[5]), cvt_pk_bf16(P1[6], P1[7])}; \
        pw[3] = (u32x4){cvt_pk_bf16(P1[8], P1[9]), cvt_pk_bf16(P1[10], P1[11]), cvt_pk_bf16(P1[12], P1[13]), cvt_pk_bf16(P1[14], P1[15])}; } while (0)
#define ATT_PV(slot) do { _Pragma("unroll") for (int db = 0; db < 4; ++db) { _Pragma("unroll") for (int ks = 0; ks < 4; ++ks) { \
        const s16x4 lo = vtr(vp0 + (slot) + db * 4096 + ks * 1024), hh = vtr(vp0 + (slot) + db * 4096 + ks * 1024 + 512); \
        const bf16x8 vf = (bf16x8){lo[0], lo[1], lo[2], lo[3], hh[0], hh[1], hh[2], hh[3]}; \
        o[db] = __builtin_amdgcn_mfma_f32_32x32x16_bf16(__builtin_bit_cast(bf16x8, pw[ks]), vf, o[db], 0, 0, 0); } } } while (0)
#define ATT_DECIDE(P0, P1, moved) do { const float rm = rowmax_pos(P0, P1); moved = false; \
        if (__any(rm > ATT_THR)) { const float dl = rm; m_run += dl; \
            _Pragma("unroll") for (int r = 0; r < 16; ++r) { P0[r] -= dl; P1[r] -= dl; negm[r] = -m_run; } \
            asm volatile("" : "+v"(negm)); \
            const float f = __builtin_amdgcn_exp2f(-dl); l_run *= f; if (hi == 0) wsf[r32] = f; moved = true; } } while (0)
#define ATT_RESCALE_O() do { asm volatile("s_waitcnt lgkmcnt(0)" ::: "memory"); _Pragma("unroll") for (int r = 0; r < 16; ++r) { const float fr_ = wsf[crow(r, hi)]; \
        _Pragma("unroll") for (int d = 0; d < 4; ++d) o[d][r] *= fr_; } } while (0)
    asm volatile("s_waitcnt vmcnt(0) lgkmcnt(0)" ::: "memory"); __builtin_amdgcn_s_barrier(); asm volatile("" ::: "memory");
    { const size_t go = (size_t)1 * 64 * 512; glds16(ks0 + go, kd0 + LBUF); glds16(ks1 + go, kd1 + LBUF); glds16(vs0 + go, vd0 + LBUF); glds16(vs1 + go, vd1 + LBUF); }
    ATT_QK(p0, p1, 0); ATT_MASK(p0, p1, 0);
    { bool moved; ATT_DECIDE(p0, p1, moved); (void)moved; }
#pragma unroll
    for (int r = 0; r < 16; ++r) { p0[r] = __builtin_amdgcn_exp2f(p0[r]); p1[r] = __builtin_amdgcn_exp2f(p1[r]); }
    bprev = 0; bcur = LBUF; bnext = 2 * LBUF;
#define SBAR() __builtin_amdgcn_sched_barrier(0)
#define PIN1(x) asm volatile("" : "+v"(x))
#define KRD(j, slot) (*(const __attribute__((address_space(3))) bf16x8*)(kp0 + (slot) + ((j) >> 1) * 2048 + ((j) & 1) * 512))
#define VRDF(i, slot) do { vlo[(i) % 3] = vtr(vp0 + (slot) + ((i) >> 2) * 4096 + ((i) & 3) * 1024); vhi[(i) % 3] = vtr(vp0 + (slot) + ((i) >> 2) * 4096 + ((i) & 3) * 1024 + 512); } while (0)
#define VFRG(i) (bf16x8){vlo[(i) % 3][0], vlo[(i) % 3][1], vlo[(i) % 3][2], vlo[(i) % 3][3], vhi[(i) % 3][0], vhi[(i) % 3][1], vhi[(i) % 3][2], vhi[(i) % 3][3]}
#define GAPA(j, N0, N1, slot, PA, B, PWW, W0, W1) do { \
        if ((j) == 0) N0 = __builtin_amdgcn_mfma_f32_32x32x16_bf16(kf[0], qr[0], negm, 0, 0, 0); \
        else if ((j) == 1) N1 = __builtin_amdgcn_mfma_f32_32x32x16_bf16(kf[1], qr[0], negm, 0, 0, 0); \
        else if (((j) & 1) == 0) N0 = __builtin_amdgcn_mfma_f32_32x32x16_bf16(kf[(j) % 3], qr[(j) >> 1], N0, 0, 0, 0); \
        else N1 = __builtin_amdgcn_mfma_f32_32x32x16_bf16(kf[(j) % 3], qr[(j) >> 1], N1, 0, 0, 0); \
        if ((j) + 2 < 8) kf[((j) + 2) % 3] = KRD((j) + 2, slot); \
        sacc += PA[B]; sacc += PA[B + 1]; sacc += PA[B + 2]; sacc += PA[B + 3]; PIN1(sacc); \
        PWW[W0] = cvt_pk_bf16(PA[B], PA[B + 1]); PWW[W1] = cvt_pk_bf16(PA[B + 2], PA[B + 3]); PIN1(PWW); SBAR(); } while (0)
#define GAPB(i, slot, X, NX, B) do { \
        o[(i) >> 2] = __builtin_amdgcn_mfma_f32_32x32x16_bf16(__builtin_bit_cast(bf16x8, pw[(i) & 3]), VFRG(i), o[(i) >> 2], 0, 0, 0); \
        if ((i) + 2 < 16) VRDF((i) + 2, slot); \
        X[B] = __builtin_amdgcn_exp2f(NX[B]); X[B + 1] = __builtin_amdgcn_exp2f(NX[B + 1]); PIN1(X); SBAR(); } while (0)
#define ATT_STEP(t, MASKED) do { \
        asm volatile("s_waitcnt vmcnt(0) lgkmcnt(0)" ::: "memory"); \
        __builtin_amdgcn_s_barrier(); \
        asm volatile("" ::: "memory"); \
        if ((t) + 1 < NT) { const size_t go = (size_t)((t) + 1) * 64 * 512; const unsigned b1 = (unsigned)bnext; \
            glds16(ks0 + go, kd0 + b1); glds16(ks1 + go, kd1 + b1); glds16(vs0 + go, vd0 + b1); glds16(vs1 + go, vd1 + b1); } \
        SBAR(); \
        f32x16 n0, n1; bf16x8 kf[3]; s16x4 vlo[3], vhi[3]; float sacc = 0.f; u32x4 q0_, q1_, q2_, q3_; \
        kf[0] = KRD(0, bcur); kf[1] = KRD(1, bcur); SBAR(); \
        GAPA(0, n0, n1, bcur, p0, 0, q0_, 0, 1); GAPA(1, n0, n1, bcur, p0, 4, q0_, 2, 3); GAPA(2, n0, n1, bcur, p0, 8, q1_, 0, 1); GAPA(3, n0, n1, bcur, p0, 12, q1_, 2, 3); \
        GAPA(4, n0, n1, bcur, p1, 0, q2_, 0, 1); GAPA(5, n0, n1, bcur, p1, 4, q2_, 2, 3); GAPA(6, n0, n1, bcur, p1, 8, q3_, 0, 1); GAPA(7, n0, n1, bcur, p1, 12, q3_, 2, 3); \
        l_run += sacc; pw[0] = q0_; pw[1] = q1_; pw[2] = q2_; pw[3] = q3_; \
        VRDF(0, bprev); VRDF(1, bprev); SBAR();                         \
        if (MASKED) ATT_MASK(n0, n1, t); \
        bool moved; ATT_DECIDE(n0, n1, moved); \
        SBAR(); \
        GAPB(0, bprev, p0, n0, 0); GAPB(1, bprev, p0, n0, 2); GAPB(2, bprev, p0, n0, 4); GAPB(3, bprev, p0, n0, 6); \
        GAPB(4, bprev, p0, n0, 8); GAPB(5, bprev, p0, n0, 10); GAPB(6, bprev, p0, n0, 12); GAPB(7, bprev, p0, n0, 14); \
        GAPB(8, bprev, p1, n1, 0); GAPB(9, bprev, p1, n1, 2); GAPB(10, bprev, p1, n1, 4); GAPB(11, bprev, p1, n1, 6); \
        GAPB(12, bprev, p1, n1, 8); GAPB(13, bprev, p1, n1, 10); GAPB(14, bprev, p1, n1, 12); GAPB(15, bprev, p1, n1, 14); \
        if (moved) ATT_RESCALE_O(); \
        bprev = bcur; bcur = bnext; bnext = (bnext == 2 * LBUF) ? 0 : bnext + LBUF; } while (0)
    { int t = 1;
      for (; t < NT - 2; ++t) ATT_STEP(t, false);
      for (; t < NT; ++t) ATT_STEP(t, true); }
#undef ATT_STEP
#undef GAPA
#undef GAPB
#undef KRD
#undef VRDF
#undef VFRG
#undef SBAR
#undef PIN1
    ATT_SUMPACK(p0, p1);
    ATT_PV(bprev);
#undef ATT_QK
#undef ATT_MASK
#undef ATT_SUMPACK
#undef ATT_PV
#undef ATT_DECIDE
#undef ATT_RESCALE_O
    l_run = add_xor32(l_run);
    if (hi == 0) wsf[32 + r32] = l_run;
    asm volatile("s_waitcnt lgkmcnt(0)" ::: "memory");
    f32x16 rliv;
#pragma unroll
    for (int g = 0; g < 4; ++g) { const f32x4 lv = *(const f32x4*)(wsf + 32 + 8 * g + 4 * hi);
#pragma unroll
        for (int j = 0; j < 4; ++j) rliv[4 * g + j] = __builtin_amdgcn_rcpf(lv[j]); }
    __syncthreads();
    float* ox = (float*)(shm + LOX) + wq * 4096;
    if (mp == 1) {
#pragma unroll
        for (int db = 0; db < 4; ++db) { const f32x16 t = o[db] * rliv;
#pragma unroll
            for (int g = 0; g < 4; ++g) *(f32x4*)(ox + ((db * 4 + g) * 64 + lane) * 4) = (f32x4){t[4 * g], t[4 * g + 1], t[4 * g + 2], t[4 * g + 3]}; }
    }
    __syncthreads();
    if (mp == 0) {
        f32x16 ssv = f32x16{};
#pragma unroll
        for (int db = 0; db < 4; ++db) { f32x16 x1;
#pragma unroll
            for (int g = 0; g < 4; ++g) { const f32x4 t = *(const f32x4*)(ox + ((db * 4 + g) * 64 + lane) * 4); x1[4 * g] = t[0]; x1[4 * g + 1] = t[1]; x1[4 * g + 2] = t[2]; x1[4 * g + 3] = t[3]; }
            const f32x16 v = o[db] * rliv - x1 * lam; o[db] = v; ssv = v * v + ssv; }
#pragma unroll
        for (int r = 0; r < 16; ++r) { float sv = ssv[r];
            sv += dpp_f<0xB1>(sv); sv += dpp_f<0x4E>(sv); sv += dpp_f<0x141>(sv); sv += dpp_f<0x140>(sv);
            sv = add_xor16(sv);
            ssv[r] = 0.8f * __builtin_amdgcn_rsqf(sv * (1.0f / 128.0f) + EPS); }
        float sg[4];
#pragma unroll
        for (int db = 0; db < 4; ++db) sg[db] = subg[32 * db + r32];
        bf16_t* stg = (bf16_t*)ox;
#pragma unroll
        for (int db = 0; db < 4; ++db) { const f32x16 t = o[db] * (ssv * sg[db]);
#pragma unroll
            for (int r = 0; r < 16; r += 2) { const unsigned w = cvt_pk_bf16(t[r], t[r + 1]);
                stg[crow(r, hi) * 128 + 32 * db + r32] = (bf16_t)(w & 0xffffu); stg[crow(r + 1, hi) * 128 + 32 * db + r32] = (bf16_t)(w >> 16); } }
        asm volatile("s_waitcnt lgkmcnt(0)" ::: "memory");
        bf16_t* yb = Y + (rowbase + q0 + wq * 32) * DM + 512 + h * 128;
#pragma unroll
        for (int i = 0; i < 8; ++i) { const int q = lane + 64 * i, row = q >> 4, pc = q & 15;
            const u32x4 v = *(const u32x4*)(stg + row * 128 + pc * 8);
            *(u32x4*)(yb + (size_t)row * DM + pc * 8) = v; }
    }
}
constexpr int NCONV = 768, NQUEUE = 128 + 1024 + NCONV;
__device__ __forceinline__ void mixer_phase(Frame& F) {
    const float* lq1 = F.in(12); const float* lk1 = F.in(13); const float* lq2 = F.in(14); const float* lk2 = F.in(15);
    float a1 = lq1[F.lane] * lk1[F.lane], a2 = lq2[F.lane] * lk2[F.lane];
    a1 = wave_sum(a1); a2 = wave_sum(a2);
    const float lam = expf(a1) - expf(a2) + 0.2f;
    unsigned* qhead = (unsigned*)(F.ws + WS_CTL) + CW_QUEUE;
    volatile LAS unsigned* slot = (volatile LAS unsigned*)(F.lds + LDS_MISC) + 16;
    for (;;) {
        if (F.tid == 0) slot[0] = __hip_atomic_fetch_add(qhead, 1u, __ATOMIC_RELAXED, __HIP_MEMORY_SCOPE_AGENT);
        __syncthreads();
        const int u = (int)__builtin_amdgcn_readfirstlane(slot[0]);
        if (u >= NQUEUE) break;
        if (u < 128) { rglru_item(F, u); continue; }
        const int v = u - 128;
        if (v < 2 * NCONV && (v & 1)) { conv_unit(F, v >> 1); __syncthreads(); continue; }
        const int idx = (v < 2 * NCONV) ? (v >> 1) : v - NCONV, qb = 15 - (idx >> 6), bh = idx & 63;
        attn_unit(F, bh >> 2, bh & 3, qb, lam); __syncthreads();
    }
    __syncthreads();
}
}

struct ProbOutProj {
    static constexpr bool FP8 = false;
    pg8::StaticOrder S; const char* A; const char* Bt; const bf16_t* xb; bf16_t* x1h; unsigned char* x1q; LAS unsigned char* lds;
    __device__ __forceinline__ bool next(int i, pg8::Unit& u) const { u.e = 0; u.tt = 0; return S.next(i, u.pm, u.pn); }
    __device__ __forceinline__ const char* abase(const pg8::Unit& u) const { return A + (size_t)u.pm * 256 * DM * 2; }
    __device__ __forceinline__ void aoff(const pg8::Unit& u, const int (&R)[2], const int (&C)[2], unsigned (&vo)[2][2]) const {
#pragma unroll
        for (int h = 0; h < 2; ++h)
#pragma unroll
            for (int i = 0; i < 2; ++i) vo[h][i] = (unsigned)((h * 128 + R[i]) * DM + C[i]) * 2u;
    }
    __device__ __forceinline__ const char* bptr(const pg8::Unit& u) const { return Bt + (size_t)u.pn * 256 * DM * 2; }
    __device__ __forceinline__ float pre(const pg8::Unit&, int) const { return 0.f; }
    __device__ __forceinline__ void epi(f32x4 (&acc)[2][2][4][2], const pg8::Unit& u, int wr, int wc, int fr, int fq, float) const {
        const int tid = (wr * 4 + wc) * 64 + fq * 16 + fr;
        const size_t tile0 = (size_t)u.pm * 256 * DM + (size_t)u.pn * 256;
        u32x4 xres[8][2];
#pragma unroll
        for (int c = 0; c < 8; ++c)
#pragma unroll
            for (int j = 0; j < 2; ++j) { const int p = tid + 512 * j, r2 = p >> 5, pi = p & 31;
                xres[c][j] = *(const u32x4*)(xb + tile0 + (size_t)((c >> 2) * 128 + (r2 >> 4) * 64 + (c & 3) * 16 + (r2 & 15)) * DM + pi * 8); }
#pragma unroll
        for (int ai = 0; ai < 2; ++ai)
#pragma unroll
            for (int m = 0; m < 4; ++m) { const int c = ai * 4 + m;
                LAS unsigned char* buf = lds + ((c & 1) ? STG_BUF1 : STG_BUF0);
                const int rl = wr * 16 + fr, p0 = wc * 4 + fq;
#pragma unroll
                for (int bj = 0; bj < 2; ++bj) { const f32x4 v0 = acc[ai][bj][m][0], v1 = acc[ai][bj][m][1];
                    u32x4 w; w.x = cvt_pk_bf16(v0[0], v0[1]); w.y = cvt_pk_bf16(v0[2], v0[3]); w.z = cvt_pk_bf16(v1[0], v1[1]); w.w = cvt_pk_bf16(v1[2], v1[3]);
                    *(LAS u32x4*)(buf + rl * 512 + (((bj * 16 + p0) ^ (rl & 7)) << 4)) = w; }
                asm volatile("s_waitcnt lgkmcnt(0)" ::: "memory"); __builtin_amdgcn_s_barrier(); asm volatile("" ::: "memory");
#pragma unroll
                for (int j = 0; j < 2; ++j) { const int p = tid + 512 * j, r2 = p >> 5, pi = p & 31;
                    const u32x4 a = *(const LAS u32x4*)(buf + r2 * 512 + ((pi ^ (r2 & 7)) << 4));
                    const size_t off = tile0 + (size_t)(ai * 128 + (r2 >> 4) * 64 + m * 16 + (r2 & 15)) * DM + pi * 8;
                    const u32x4 xv = xres[c][j];
                    const unsigned aw[4] = {a.x, a.y, a.z, a.w}, xw[4] = {xv.x, xv.y, xv.z, xv.w};
                    float v[8];
#pragma unroll
                    for (int q = 0; q < 4; ++q) { v[2 * q] = bf2f(aw[q] & 0xffffu) + bf2f(xw[q] & 0xffffu); v[2 * q + 1] = bf2f(aw[q] >> 16) + bf2f(xw[q] >> 16); }
                    u32x4 hb; hb.x = cvt_pk_bf16(v[0], v[1]); hb.y = cvt_pk_bf16(v[2], v[3]); hb.z = cvt_pk_bf16(v[4], v[5]); hb.w = cvt_pk_bf16(v[6], v[7]);
                    *(u32x4*)(x1h + off) = hb;
                    u32x2 w8; w8.x = pack_fp8x4(v[0], v[1], v[2], v[3]); w8.y = pack_fp8x4(v[4], v[5], v[6], v[7]);
                    *(u32x2*)(x1q + off) = w8; } }
    }
};

__device__ __forceinline__ void p5_router(Frame& F) {
    const int lane = F.lane, r32 = lane & 31, hi = lane >> 5, wid = F.wave, tl = wid & 3, kh = wid >> 2, tid = F.tid;
    const bf16_t* x1 = (const bf16_t*)(F.ws + WS_X1H); const bf16_t* WRH = (const bf16_t*)(F.ws + WS_WRH); const bf16_t* WRL = (const bf16_t*)(F.ws + WS_WRL);
    const float* rb = F.in(20);
    unsigned* ctl = (unsigned*)(F.ws + WS_CTL);
    int* LIST = (int*)(F.ws + WS_LIST); float* GATES = (float*)(F.ws + WS_GATES); float* RS2 = (float*)(F.ws + WS_RSTD2); int* POSI = (int*)(F.ws + WS_POSI);
    LAS float* T = (LAS float*)(F.lds);
    LAS float* SS = (LAS float*)(F.lds + 2 * 4 * 32 * 33 * 4);
    LAS unsigned* CNTL = (LAS unsigned*)(F.lds + 2 * 4 * 32 * 33 * 4 + 1024);
    float rbv[8];
#pragma unroll
    for (int j = 0; j < 8; ++j) rbv[j] = rb[8 * (tid & 3) + j];
    for (int blk = F.vcu; blk < MTOK / 128; blk += F.G) {
        const int R0 = blk * 128;
        if (tid < 32) CNTL[tid] = 0u;
        f32x16 acc = f32x16{}; float ssq = 0.f;
        const bf16_t* xrow = x1 + (size_t)(R0 + tl * 32 + r32) * DM + kh * 512 + hi * 8;
        const bf16_t* wh = WRH + r32 * DM + kh * 512 + hi * 8; const bf16_t* wl = WRL + r32 * DM + kh * 512 + hi * 8;
#pragma unroll 8
        for (int s = 0; s < 32; ++s) {
            const u32x4 xa = *(const u32x4*)(xrow + 16 * s);
            const unsigned xw[4] = {xa.x, xa.y, xa.z, xa.w};
#pragma unroll
            for (int j = 0; j < 4; ++j) { const float a = bf2f(xw[j] & 0xffffu), b = bf2f(xw[j] >> 16); ssq += a * a + b * b; }
            const bf16x8 bh = *(const bf16x8*)(wh + 16 * s), bl = *(const bf16x8*)(wl + 16 * s);
            acc = __builtin_amdgcn_mfma_f32_32x32x16_bf16(__builtin_bit_cast(bf16x8, xa), bh, acc, 0, 0, 0);
            acc = __builtin_amdgcn_mfma_f32_32x32x16_bf16(__builtin_bit_cast(bf16x8, xa), bl, acc, 0, 0, 0);
        }
        ssq = add_xor32(ssq);
#pragma unroll
        for (int r = 0; r < 16; ++r) T[((kh * 4 + tl) * 32 + att::crow(r, hi)) * 33 + r32] = acc[r];
        if (hi == 0) SS[(kh * 4 + tl) * 32 + r32] = ssq;
        __syncthreads();
        int ek[4]; float gk[4]; unsigned rk[4] = {0u, 0u, 0u, 0u}; float rstd2;
        const int srow = tid >> 2, sq = tid & 3;
        {
            const int tile = srow >> 5, rr = srow & 31;
            rstd2 = __builtin_amdgcn_rsqf((SS[tile * 32 + rr] + SS[(4 + tile) * 32 + rr]) * (1.0f / DM) + EPS);
            const LAS float* ta = T + (tile * 32 + rr) * 33 + 8 * sq; const LAS float* tb = T + ((4 + tile) * 32 + rr) * 33 + 8 * sq;
            float v[8];
#pragma unroll
            for (int j = 0; j < 8; ++j) v[j] = (ta[j] + tb[j]) * rstd2 + rbv[j];
            float vk[4];
#pragma unroll
            for (int k = 0; k < 4; ++k) { float best = -INFINITY; int be = 8 * sq;
#pragma unroll
                for (int j = 0; j < 8; ++j) if (v[j] > best) { best = v[j]; be = 8 * sq + j; }
                { const float ob = att::dpp_f<0xB1>(best); const int oe = __builtin_amdgcn_update_dpp(0, be, 0xB1, 0xf, 0xf, true); if (ob > best || (ob == best && oe < be)) { best = ob; be = oe; } }
                { const float ob = att::dpp_f<0x4E>(best); const int oe = __builtin_amdgcn_update_dpp(0, be, 0x4E, 0xf, 0xf, true); if (ob > best || (ob == best && oe < be)) { best = ob; be = oe; } }
                ek[k] = be; vk[k] = best;
#pragma unroll
                for (int j = 0; j < 8; ++j) if (be == 8 * sq + j) v[j] = -INFINITY; }
            float den = 0.f;
#pragma unroll
            for (int k = 0; k < 4; ++k) { gk[k] = __expf(vk[k] - vk[0]); den += gk[k]; }
            const float rden = 1.0f / den;
#pragma unroll
            for (int k = 0; k < 4; ++k) { gk[k] *= rden; if (sq == 0) rk[k] = __hip_atomic_fetch_add(CNTL + ek[k], 1u, __ATOMIC_RELAXED, __HIP_MEMORY_SCOPE_WORKGROUP); }
        }
        __syncthreads();
        if (tid < 32) { const unsigned n = CNTL[tid]; CNTL[32 + tid] = n ? atomicAdd(ctl + CW_CNT + 64 * tid, n) : 0u; }
        __syncthreads();
        if (sq == 0) {
            const int tok = R0 + srow;
            RS2[tok] = rstd2;
#pragma unroll
            for (int k = 0; k < 4; ++k) { const int li = (int)(CNTL[32 + ek[k]] + rk[k]); LIST[(size_t)ek[k] * MTOK + li] = tok * 4 + k; GATES[tok * 4 + k] = gk[k]; POSI[tok * 4 + k] = (ek[k] << 15) | li; }
        }
        __syncthreads();
    }
}

constexpr int MOE_MAXS = 24;
struct MoeSched { LAS int* TB; LAS int* TE; LAS int* TAB; int tlo, thi, mt, pn, mpb; };
constexpr int MOE_CNTS = 25600 / 4;
__device__ __forceinline__ void moe_prefix(Frame& F, LAS int* TB) {
    const unsigned* ctl = (const unsigned*)(F.ws + WS_CTL);
    if (F.tid < 64) {
        const int e = F.tid; const int c = (e < NEXP) ? (int)__hip_atomic_load(ctl + CW_CNT + 64 * (e & 31), __ATOMIC_RELAXED, __HIP_MEMORY_SCOPE_AGENT) : 0;
        const int tiles = (c + 255) >> 8; int incl = tiles;
#pragma unroll
        for (int o = 1; o < 32; o <<= 1) { const int y = __shfl_up(incl, o); if (e >= o) incl += y; }
        if (e < NEXP) { TB[e] = incl - tiles; TB[MOE_CNTS + e] = c; }
        if (e == NEXP - 1) TB[NEXP] = incl;
    }
    __syncthreads();
}
template <int NPN, bool TABLE>
__device__ __forceinline__ MoeSched moe_setup(Frame& F) {
    MoeSched M;
    M.TB = (LAS int*)(F.lds + LDS_AUX); M.TE = M.TB + 40; M.TAB = M.TB + 64;
    moe_prefix(F, M.TB);
    const int T = __builtin_amdgcn_readfirstlane(M.TB[NEXP]), x = F.vcu >> 5, i = F.vcu & 31;
    M.mpb = 32 / NPN; M.mt = __builtin_amdgcn_readfirstlane(i / NPN); M.pn = __builtin_amdgcn_readfirstlane(i % NPN);
    M.tlo = __builtin_amdgcn_readfirstlane((x * T) >> 3); M.thi = __builtin_amdgcn_readfirstlane(((x + 1) * T) >> 3);
    const int* LIST = (const int*)(F.ws + WS_LIST); const float* RS2 = (const float*)(F.ws + WS_RSTD2);
    if (F.tid < MOE_MAXS) { const int t = M.tlo + F.tid * M.mpb + M.mt; int e = 0; if (t < M.thi) { for (int q = 0; q < NEXP; ++q) if (M.TB[q + 1] <= t) e = q + 1; } M.TE[F.tid] = e; }
    __syncthreads();
    if (TABLE) {
        constexpr int NIT = MOE_MAXS * 256 / NTHR;
        int lst[NIT];
#pragma unroll
        for (int it = 0; it < NIT; ++it) { const int idx = F.tid + NTHR * it, s = idx >> 8, r = idx & 255, t = M.tlo + s * M.mpb + M.mt;
            const int e = M.TE[s]; const int li = (t - M.TB[e]) * 256 + r;
            lst[it] = (t < M.thi && li < M.TB[MOE_CNTS + e]) ? LIST[(size_t)e * MTOK + li] : -1; }
        float rsv[NIT];
#pragma unroll
        for (int it = 0; it < NIT; ++it) rsv[it] = (lst[it] >= 0) ? RS2[lst[it] >> 2] : 0.f;
#pragma unroll
        for (int it = 0; it < NIT; ++it) M.TAB[F.tid + NTHR * it] = (lst[it] >= 0) ? ((lst[it] >> 2) | (int)((f2bf(rsv[it]) & 0x7fffu) << 15)) : 0;
    }
    __syncthreads();
    return M;
}
struct ProbMoe1 {
    static constexpr bool FP8 = true;
    MoeSched M; const char* A; const char* W; const float* b1; unsigned char* act; LAS unsigned char* lds;
    __device__ __forceinline__ bool next(int s, pg8::Unit& u) const { const int t = __builtin_amdgcn_readfirstlane(M.tlo + s * M.mpb + M.mt); if (s >= MOE_MAXS || t >= __builtin_amdgcn_readfirstlane(M.thi)) return false; u.pn = M.pn; u.pm = t; u.tt = s;
        u.e = __builtin_amdgcn_readfirstlane(M.TE[s]); return true; }
    __device__ __forceinline__ const char* abase(const pg8::Unit&) const { return A; }
    __device__ __forceinline__ void aoff(const pg8::Unit& u, const int (&R)[2], const int (&C)[2], unsigned (&vo)[2][2]) const {
#pragma unroll
        for (int h = 0; h < 2; ++h)
#pragma unroll
            for (int i = 0; i < 2; ++i) vo[h][i] = (unsigned)((M.TAB[u.tt * 256 + h * 128 + R[i]] & 0x7fff) * DM + C[i] * 2);
    }
    __device__ __forceinline__ const char* bptr(const pg8::Unit& u) const { return W + ((size_t)u.e * 2 * DFF + (size_t)u.pn * 256) * DM; }
    __device__ __forceinline__ float pre(const pg8::Unit& u, int tid) const { const int t = tid & 255; return ld_untracked(b1 + (size_t)u.e * 2 * DFF + u.pn * 128 + (t & 127) + ((t >> 7) ? DFF : 0)); }
    __device__ __forceinline__ void epi(f32x4 (&acc)[2][2][4][2], const pg8::Unit& u, int wr, int wc, int fr, int fq, float pf) const {
        asm volatile("s_nop 15\n\ts_nop 7" ::: "memory");
        const int rl0 = wr * 64 + fr, cj = u.pn * 128 + wc * 32 + 8 * fq;
        LAS float* pfx = (LAS float*)(lds + LDS_PFX);
        if (wr == 0) pfx[wc * 64 + fq * 16 + fr] = pf;
        asm volatile("s_waitcnt lgkmcnt(0)" ::: "memory"); __builtin_amdgcn_s_barrier(); asm volatile("" ::: "memory");
        const LAS float* bg = pfx + wc * 32 + 8 * fq; const LAS float* bu = bg + 128;
        constexpr float CS = -1.702f * LOG2E, KA = ASCALE / CS;
        f32x4 bg0 = *(const LAS f32x4*)bg, bg1 = *(const LAS f32x4*)(bg + 4); const f32x4 bu0 = *(const LAS f32x4*)bu, bu1 = *(const LAS f32x4*)(bu + 4);
        bg0 = bg0 * CS; bg1 = bg1 * CS;
#pragma unroll
        for (int ai = 0; ai < 2; ++ai)
#pragma unroll
            for (int m = 0; m < 4; ++m) { const int rl = rl0 + ai * 128 + m * 16; const float rs = bf2f((unsigned)M.TAB[u.tt * 256 + rl] >> 15) * (1.0f / WSCALE), rsc = rs * CS;
                float a[8];
#pragma unroll
                for (int n = 0; n < 2; ++n)
#pragma unroll
                    for (int jp = 0; jp < 2; ++jp) {
                        const f32x2 ag = {acc[ai][0][m][n][2 * jp], acc[ai][0][m][n][2 * jp + 1]}, au = {acc[ai][1][m][n][2 * jp], acc[ai][1][m][n][2 * jp + 1]};
                        const f32x2 bgp = n ? (f32x2){bg1[2 * jp], bg1[2 * jp + 1]} : (f32x2){bg0[2 * jp], bg0[2 * jp + 1]};
                        const f32x2 bup = n ? (f32x2){bu1[2 * jp], bu1[2 * jp + 1]} : (f32x2){bu0[2 * jp], bu0[2 * jp + 1]};
                        const f32x2 z = ag * (f32x2){rsc, rsc} + bgp, hu = au * (f32x2){rs, rs} + bup;
                        const f32x2 zc = {fmaxf(z.x, 7.0f * CS), fmaxf(z.y, 7.0f * CS)};
                        const f32x2 up = {__builtin_amdgcn_fmed3f(hu.x, -7.0f, 7.0f), __builtin_amdgcn_fmed3f(hu.y, -7.0f, 7.0f)};
                        const f32x2 den = (f32x2){__builtin_amdgcn_exp2f(zc.x), __builtin_amdgcn_exp2f(zc.y)} + (f32x2){1.0f, 1.0f};
                        const f32x2 sg = {__builtin_amdgcn_rcpf(den.x), __builtin_amdgcn_rcpf(den.y)};
                        const f32x2 r = (zc * sg) * (up * (f32x2){KA, KA} + (f32x2){KA, KA});
                        a[4 * n + 2 * jp] = r.x; a[4 * n + 2 * jp + 1] = r.y; }
                u32x2 w; w.x = pack_fp8x4(a[0], a[1], a[2], a[3]); w.y = pack_fp8x4(a[4], a[5], a[6], a[7]);
                *(u32x2*)(act + ((size_t)u.pm * 256 + rl) * DFF + cj) = w; }
    }
};
struct ProbMoe2 {
    static constexpr bool FP8 = true;
    MoeSched M; const char* A; const char* W; const float* b2; unsigned char* ys; LAS unsigned char* lds;
    __device__ __forceinline__ bool next(int s, pg8::Unit& u) const { const int t = __builtin_amdgcn_readfirstlane(M.tlo + s * M.mpb + M.mt); if (s >= MOE_MAXS || t >= __builtin_amdgcn_readfirstlane(M.thi)) return false; u.pn = M.pn; u.pm = t; u.tt = s;
        u.e = __builtin_amdgcn_readfirstlane(M.TE[s]); return true; }
    __device__ __forceinline__ const char* abase(const pg8::Unit& u) const { return A + (size_t)u.pm * 256 * DFF; }
    __device__ __forceinline__ void aoff(const pg8::Unit& u, const int (&R)[2], const int (&C)[2], unsigned (&vo)[2][2]) const {
#pragma unroll
        for (int h = 0; h < 2; ++h)
#pragma unroll
            for (int i = 0; i < 2; ++i) vo[h][i] = (unsigned)((h * 128 + R[i]) * DFF + C[i] * 2);
    }
    __device__ __forceinline__ const char* bptr(const pg8::Unit& u) const { return W + ((size_t)u.e * DM + (size_t)u.pn * 256) * DFF; }
    __device__ __forceinline__ float pre(const pg8::Unit& u, int tid) const { return ld_untracked(b2 + (size_t)u.e * DM + u.pn * 256 + (tid & 255)); }
    __device__ __forceinline__ void epi(f32x4 (&acc)[2][2][4][2], const pg8::Unit& u, int wr, int wc, int fr, int fq, float pf) const {
        asm volatile("s_nop 15\n\ts_nop 7" ::: "memory");
        const int rl0 = wr * 64 + fr, col0 = u.pn * 256 + wc * 32 + 8 * fq;
        LAS float* pfx = (LAS float*)(lds + LDS_PFX);
        if (wr == 0) pfx[wc * 64 + fq * 16 + fr] = pf;
        asm volatile("s_waitcnt lgkmcnt(0)" ::: "memory"); __builtin_amdgcn_s_barrier(); asm volatile("" ::: "memory");
        const LAS float* bp = pfx + wc * 32 + 8 * fq;
        f32x4 bv[2][2];
#pragma unroll
        for (int bj = 0; bj < 2; ++bj) { bv[bj][0] = *(const LAS f32x4*)(bp + bj * 128) * YSCALE; bv[bj][1] = *(const LAS f32x4*)(bp + bj * 128 + 4) * YSCALE; }
        constexpr float sc = YSCALE / (WSCALE * ASCALE);
        char* tbase = (char*)ys + ((size_t)u.pm * 256) * DM + u.pn * 256;
        const int tid = (wr * 4 + wc) * 64 + fq * 16 + fr;
#pragma unroll
        for (int ai = 0; ai < 2; ++ai)
#pragma unroll
            for (int mh = 0; mh < 2; ++mh) { const int c = ai * 2 + mh; LAS unsigned char* buf = lds + ((c & 1) ? STG_BUF1 : STG_BUF0);
#pragma unroll
                for (int ml = 0; ml < 2; ++ml) { const int m = mh * 2 + ml, rl = ml * 32 + wr * 16 + fr;
#pragma unroll
                    for (int bj = 0; bj < 2; ++bj) { const f32x4 v0 = acc[ai][bj][m][0] * sc + bv[bj][0], v1 = acc[ai][bj][m][1] * sc + bv[bj][1];
                        u32x2 w; w.x = pack_fp8x4(v0[0], v0[1], v0[2], v0[3]); w.y = pack_fp8x4(v1[0], v1[1], v1[2], v1[3]);
                        const int slot = bj * 16 + wc * 4 + fq;
                        *(LAS u32x2*)(buf + rl * 256 + ((slot ^ ((rl & 7) << 1)) << 3)) = w; } }
                asm volatile("s_waitcnt lgkmcnt(0)" ::: "memory"); __builtin_amdgcn_s_barrier(); asm volatile("" ::: "memory");
#pragma unroll
                for (int j = 0; j < 2; ++j) { const int p = tid + 512 * j, r2 = p >> 4, pi = p & 15;
                    const u32x4 v = *(const LAS u32x4*)(buf + r2 * 256 + (((2 * pi) ^ ((r2 & 7) << 1)) << 3));
                    const int trow = ai * 128 + ((r2 >> 4) & 1) * 64 + (mh * 2 + (r2 >> 5)) * 16 + (r2 & 15);
                    *(u32x4*)(tbase + (size_t)trow * DM + pi * 16) = v; } }
    }
};
static_assert(256 + MOE_MAXS * 256 * 4 <= 32768 - 512, "MoE tables fit the AUX region");

__device__ __forceinline__ void p8_combine(Frame& F) {
    const int gw = F.vcu * NWAVES + F.wave, NGW = F.G * NWAVES;
    LAS int* TB = (LAS int*)(F.lds + LDS_AUX);
    moe_prefix(F, TB);
    const unsigned char* YS = F.ws + WS_YB; const int* POSI = (const int*)(F.ws + WS_POSI); const float* GATES = (const float*)(F.ws + WS_GATES);
    const bf16_t* X1H = (const bf16_t*)(F.ws + WS_X1H);
    for (int m = gw; m < MTOK; m += NGW) {
        f32x4* op = (f32x4*)(F.out + (size_t)m * DM) + F.lane;
        const u32x2* xp = (const u32x2*)(X1H + (size_t)m * DM) + F.lane;
        const int pv = POSI[m * 4 + (F.lane & 3)]; const float gv = GATES[m * 4 + (F.lane & 3)] * (1.0f / YSCALE);
        f32x4 v[4];
#pragma unroll
        for (int j = 0; j < 4; ++j) { const u32x2 w = xp[64 * j]; v[j].x = bf2f(w.x & 0xffffu); v[j].y = bf2f(w.x >> 16); v[j].z = bf2f(w.y & 0xffffu); v[j].w = bf2f(w.y >> 16); }
#pragma unroll
        for (int k = 0; k < 4; ++k) { const int p = __builtin_amdgcn_readlane(pv, k); const float g = __builtin_bit_cast(float, __builtin_amdgcn_readlane(__builtin_bit_cast(int, gv), k));
            const int pos = TB[p >> 15] * 256 + (p & 32767);
            const unsigned* yp = (const unsigned*)(YS + (size_t)pos * DM) + F.lane;
#pragma unroll
            for (int j = 0; j < 4; ++j) { const unsigned w = yp[64 * j]; const f32x2 lo = __builtin_amdgcn_cvt_pk_f32_fp8(w, false), hi2 = __builtin_amdgcn_cvt_pk_f32_fp8(w, true);
                v[j].x += g * lo.x; v[j].y += g * lo.y; v[j].z += g * hi2.x; v[j].w += g * hi2.y; } }
#pragma unroll
        for (int j = 0; j < 4; ++j) op[64 * j] = v[j];
    }
}

typedef GAS unsigned gu32;
#define XB_TMO      128
#define XB_XCNT(j)  (256  + 64 * (j))
#define XB_XSUB(j)  (1280 + 64 * (j))
#define XB_XGEN(j)  (2304 + 64 * (j))
#define XB_TOP      3328
#define XB_TOPGEN   3392
#define XCD_BAR_WORDS 3456
#define XB_SPIN_CAP (1u << 20)
__device__ __forceinline__ unsigned xb_ld(unsigned* p)              { return __hip_atomic_load(p, __ATOMIC_RELAXED, __HIP_MEMORY_SCOPE_AGENT); }
__device__ __forceinline__ unsigned xb_add(unsigned* p, unsigned v) { return __hip_atomic_fetch_add(p, v, __ATOMIC_RELAXED, __HIP_MEMORY_SCOPE_AGENT); }
__device__ __forceinline__ unsigned xb_xcc_id() { return (unsigned)__builtin_amdgcn_s_getreg((3 << 11) | 20) & 0xFu; }
#define XB_SPIN(cond, bar) do { unsigned _sp = 0; while (cond) { __builtin_amdgcn_s_sleep(1); \
    if ((++_sp & 255u) == 0u) { if (xb_ld(&(bar)[XB_TMO])) break; if (_sp > XB_SPIN_CAP) { atomicAdd(&(bar)[XB_TMO], 1u); break; } } } } while (0)
struct XcdBarrier { unsigned* bar; unsigned x; volatile LAS unsigned* st; };
__device__ __forceinline__ XcdBarrier xcd_barrier_post(unsigned* bar, volatile LAS unsigned* st) {
    XcdBarrier b; b.bar = bar; b.x = xb_xcc_id(); b.st = st;
    if (threadIdx.x == 0) (void)xb_add(&bar[XB_XCNT(b.x)], 1u);
    return b;
}
__device__ __forceinline__ void xcd_barrier_complete(unsigned* bar, unsigned x, unsigned& nloc, unsigned& nx) {
    const unsigned G = gridDim.x * gridDim.y * gridDim.z;
    unsigned sum, cnt, mine, sp = 0u;
    for (;;) {
        sum = 0u; cnt = 0u; mine = 0u;
#pragma unroll
        for (unsigned j = 0; j < 16; ++j) { const unsigned c = xb_ld(&bar[XB_XCNT(j)]); sum += c; cnt += (c > 0u) ? 1u : 0u; mine = (j == x) ? c : mine; }
        if (sum == G) break;
        __builtin_amdgcn_s_sleep(1);
        if ((++sp & 255u) == 0u) { if (xb_ld(&bar[XB_TMO])) break; if (sp > XB_SPIN_CAP) { atomicAdd(&bar[XB_TMO], 1u); break; } }
    }
    nloc = mine > 0u ? mine : 1u; nx = cnt > 0u ? cnt : 1u;
}
__device__ __forceinline__ void xcd_barrier(const XcdBarrier& b) {
    asm volatile("s_waitcnt vmcnt(0)" ::: "memory");
    __syncthreads();
    if (threadIdx.x == 0) {
        unsigned* bar = b.bar;
        __builtin_amdgcn_s_waitcnt(0);
        unsigned nloc = b.st[0], nx = b.st[1];
        if (nloc == 0u) { xcd_barrier_complete(bar, b.x, nloc, nx); b.st[0] = nloc; b.st[1] = nx; }
        const unsigned old = xb_add(&bar[XB_XSUB(b.x)], 1u);
        const unsigned gen = old / nloc;
        if (old + 1u == (gen + 1u) * nloc) {
            __builtin_amdgcn_fence(__ATOMIC_RELEASE, "agent");
            asm volatile("s_waitcnt vmcnt(0)" ::: "memory");
            const unsigned og = xb_add(&bar[XB_TOP], 1u);
            const unsigned tg = og / nx;
            if (og + 1u == (tg + 1u) * nx) xb_add(&bar[XB_TOPGEN], 1u);
            else XB_SPIN(xb_ld(&bar[XB_TOPGEN]) == tg, bar);
            __builtin_amdgcn_fence(__ATOMIC_ACQUIRE, "agent");
            xb_add(&bar[XB_XGEN(b.x)], 1u);
            asm volatile("s_waitcnt vmcnt(0)" ::: "memory");
        } else {
            XB_SPIN(xb_ld(&bar[XB_XGEN(b.x)]) == gen, bar);
            __builtin_amdgcn_fence(__ATOMIC_ACQUIRE, "agent");
            asm volatile("s_waitcnt vmcnt(0)" ::: "memory");
        }
    }
    __syncthreads();
}

struct Args { const float* in[25]; float* out; unsigned char* ws; int ph_lo, ph_hi; };
__global__ void __launch_bounds__(NTHR, 2) mk_fwd(Args args) {
    extern __shared__ __attribute__((aligned(16))) unsigned char lds_raw[];
    Frame F;
    F.lds = (LAS unsigned char*)lds_raw; F.ws = args.ws; F.out = args.out;
    F.kin = (karg_ptr_t)__builtin_amdgcn_kernarg_segment_ptr();
    F.tid = threadIdx.x; F.lane = F.tid & 63; F.wave = __builtin_amdgcn_readfirstlane(F.tid >> 6);
    F.G = gridDim.x; { const int bx = blockIdx.x; F.vcu = (F.G % 8 == 0) ? (bx % 8) * (F.G / 8) + bx / 8 : bx; }
    const int lo = args.ph_lo, hi = args.ph_hi;
    { volatile LAS unsigned* MISC = (volatile LAS unsigned*)(F.lds + LDS_MISC); if (F.tid < 64) MISC[F.tid] = 0u; }
    __syncthreads();
    XcdBarrier bar; bar.bar = (unsigned*)(F.ws + WS_CTL) + CW_BAR; bar.x = 0; bar.st = nullptr;
    if (hi - lo > 1) bar = xcd_barrier_post((unsigned*)(F.ws + WS_CTL) + CW_BAR, (volatile LAS unsigned*)(F.lds + LDS_MISC) + 8);
#define IN(k) (lo <= (k) && (k) < hi)
#define SEAM(k) do { if (IN(k) && ((k) == 2 ? IN(4) : IN((k) + 1))) xcd_barrier(bar); } while (0)
    if (IN(0)) { p0_prologue(F); }
    SEAM(0);
    if (IN(1)) {
        ProbInProj P; P.S.init(MTOK, DIN, F.G, (int)blockIdx.x); P.A = (const char*)(F.ws + WS_XB); P.Bt = (const char*)(F.ws + WS_WIN); P.rstd1 = (const float*)(F.ws + WS_RSTD1);
        P.dst0 = (bf16_t*)(F.ws + WS_XR); P.qg = F.in(10); P.kg = F.in(11); P.xs = (LAS float*)(F.lds + LDS_AUX); P.lds = F.lds;
        pg8::gemm_phase<decltype(P), true>(F.lds, P);
    }
    SEAM(1);
    if (IN(2)) { att::mixer_phase(F); }
    SEAM(2);
    if (IN(4)) {
        ProbOutProj P; P.S.init(MTOK, DM, F.G, (int)blockIdx.x); P.A = (const char*)(F.ws + WS_Y); P.Bt = (const char*)(F.ws + WS_WOUT); P.xb = (const bf16_t*)(F.ws + WS_XB); P.x1h = (bf16_t*)(F.ws + WS_X1H); P.x1q = F.ws + WS_X1B; P.lds = F.lds;
        pg8::gemm_phase<decltype(P), true>(F.lds, P);
    }
    SEAM(4);
    if (IN(5)) { p5_router(F); }
    SEAM(5);
    if (IN(6)) {
        ProbMoe1 P; P.M = moe_setup<8, true>(F); P.A = (const char*)(F.ws + WS_X1B); P.W = (const char*)(F.ws + WS_W1); P.b1 = F.in(22); P.act = F.ws + WS_ACT; P.lds = F.lds;
        pg8::gemm_phase<decltype(P), true>(F.lds, P);
    }
    SEAM(6);
    if (IN(7)) {
        ProbMoe2 P; P.M = moe_setup<4, false>(F); P.A = (const char*)(F.ws + WS_ACT); P.W = (const char*)(F.ws + WS_W2); P.b2 = F.in(24); P.ys = F.ws + WS_YB; P.lds = F.lds;
        pg8::gemm_phase<decltype(P), true>(F.lds, P);
    }
    SEAM(7);
    if (IN(8)) { p8_combine(F); }
#undef IN
#undef SEAM
}

extern "C" void kernel_launch(void* const* d_in, const int* in_sizes, int n_in, void* d_out, int out_size, void* d_ws, size_t ws_size, hipStream_t stream) {
    static int grid = 0;
    if (grid == 0) {
        if (n_in != 25 || in_sizes[0] != MTOK * DM || out_size != MTOK * DM || ws_size < WS_END) {
            fprintf(stderr, "kernel_launch: unexpected problem (n_in %d, in0 %d, out %d, ws %zu); nothing launched\n", n_in, n_in > 0 ? in_sizes[0] : -1, out_size, ws_size); grid = -1; return; }
        int dev = 0, cus = 0, per_cu = 0;
        if (hipGetDevice(&dev) != hipSuccess || hipDeviceGetAttribute(&cus, hipDeviceAttributeMultiprocessorCount, dev) != hipSuccess) { grid = -1; return; }
        if (hipFuncSetAttribute((const void*)mk_fwd, hipFuncAttributeMaxDynamicSharedMemorySize, LDS_BYTES) != hipSuccess) { fprintf(stderr, "kernel_launch: hipFuncSetAttribute failed\n"); grid = -1; return; }
        if (hipOccupancyMaxActiveBlocksPerMultiprocessor(&per_cu, (const void*)mk_fwd, NTHR, LDS_BYTES) != hipSuccess || per_cu < 1) { fprintf(stderr, "kernel_launch: occupancy query says %d blocks/CU for %d B of LDS: the grid barrier needs every workgroup resident; nothing launched\n", per_cu, LDS_BYTES); (void)hipGetLastError(); grid = -1; return; }
        (void)hipGetLastError();
        grid = cus;
        if (grid != 256) { fprintf(stderr, "kernel_launch: built for a 256-CU device (got %d)\n", cus); grid = -1; return; }
    }
    if (grid < 0) return;
    (void)hipMemsetAsync((char*)d_ws + WS_CTL, 0, CTL_BYTES, stream);
    Args a{};
    for (int i = 0; i < 25; ++i) a.in[i] = (const float*)d_in[i];
    a.out = (float*)d_out; a.ws = (unsigned char*)d_ws;
#if MK_N_LAUNCHES == 1
    a.ph_lo = 0; a.ph_hi = NPHASE;
    hipLaunchKernelGGL(mk_fwd, dim3(grid), dim3(NTHR), LDS_BYTES, stream, a);
#else
    for (int p = 0; p < NPHASE; ++p) { a.ph_lo = p; a.ph_hi = p + 1; hipLaunchKernelGGL(mk_fwd, dim3(grid), dim3(NTHR), LDS_BYTES, stream, a); }
#endif
}
```

```cpp
#include <hip/hip_runtime.h>
#include <cstdio>
#include <cstdint>

#define LAS __attribute__((address_space(3)))
#define GAS __attribute__((address_space(1)))
typedef unsigned short bf16_t;
typedef short bf16x8 __attribute__((ext_vector_type(8)));
typedef short s16x4 __attribute__((ext_vector_type(4)));
typedef float f32x4 __attribute__((ext_vector_type(4)));
typedef float f32x2 __attribute__((ext_vector_type(2)));
typedef float f32x16 __attribute__((ext_vector_type(16)));
typedef unsigned u32x4 __attribute__((ext_vector_type(4)));
typedef unsigned u32x2 __attribute__((ext_vector_type(2)));

#ifndef MK_N_LAUNCHES
#define MK_N_LAUNCHES 1
#endif
constexpr int NPHASE = 9;

constexpr int NB = 16, SEQ = 2048, DM = 1024, MTOK = NB * SEQ;
constexpr int DIN = 2560, DRNN = 512, NEXP = 32, TOPK = 4, DFF = 1024, NASG = MTOK * TOPK;
constexpr float EPS = 1e-5f;
constexpr float LOG2E = 1.4426950408889634f;
constexpr int NWAVES = 8, NTHR = 512;
constexpr float YSCALE = 8.0f;
constexpr float WSCALE = 32.0f, ASCALE = 4.0f;

constexpr size_t MiB = (size_t)1 << 20;
constexpr size_t WS_CTL = 0, CTL_BYTES = 64 * 1024;
constexpr size_t WS_WIN = 2 * MiB;
constexpr size_t WS_WOUT = 8 * MiB;
constexpr size_t WS_WRH = 10 * MiB, WS_WRL = WS_WRH + 65536;
constexpr size_t WS_WAT = WS_WRH + 2 * 65536, WS_WXT = WS_WAT + 65536;
constexpr size_t WS_RSTD1 = 11 * MiB, WS_RSTD2 = WS_RSTD1 + 131072 * 2;
constexpr size_t WS_GATES = 12 * MiB;
constexpr size_t WS_POSI = 13 * MiB;
constexpr size_t WS_LIST = 16 * MiB;
constexpr size_t WS_W1 = 32 * MiB;
constexpr size_t WS_W2 = 160 * MiB;
constexpr size_t WS_XB = 224 * MiB;
constexpr size_t WS_XR = 288 * MiB, WS_GG = 320 * MiB, WS_Q = 352 * MiB, WS_K = 384 * MiB, WS_V = 416 * MiB;
constexpr size_t WS_Y = 448 * MiB;
constexpr size_t WS_X1B = 512 * MiB;
constexpr size_t WS_X1H = 712 * MiB;
constexpr size_t WS_ACT = 576 * MiB;
constexpr size_t WS_YB = 224 * MiB;
constexpr size_t WS_END = 848 * MiB;
constexpr int MAXTILES = NASG / 256 + NEXP;
constexpr int CW_TMO = 0, CW_QUEUE = 512, CW_CNT = 1024  , CW_BAR = 8192;

constexpr int RING_BYTES = 131072;
constexpr int LDS_AUX = RING_BYTES;
constexpr int LDS_MISC = RING_BYTES + 32768 - 256;
constexpr int LDS_BYTES = 163840;

__device__ __forceinline__ unsigned f2bf(float f) { unsigned u = __builtin_bit_cast(unsigned, f); return (u + 0x7fffu + ((u >> 16) & 1u)) >> 16; }
__device__ __forceinline__ float bf2f(unsigned h) { return __builtin_bit_cast(float, h << 16); }
typedef __bf16 bf16x2_t __attribute__((ext_vector_type(2)));
__device__ __forceinline__ unsigned cvt_pk_bf16(float lo, float hi) { f32x2 v = {lo, hi}; bf16x2_t b = __builtin_convertvector(v, bf16x2_t); return __builtin_bit_cast(unsigned, b); }
__device__ __forceinline__ unsigned pk2(float lo, float hi) { return cvt_pk_bf16(lo, hi); }
__device__ __forceinline__ void swap_rows16(unsigned& a, unsigned& b) { asm("s_nop 1\n\tv_permlane16_swap_b32 %0, %1" : "+v"(a), "+v"(b)); }
__device__ __forceinline__ void swap_rows32(unsigned& a, unsigned& b) { asm("s_nop 1\n\tv_permlane32_swap_b32 %0, %1" : "+v"(a), "+v"(b)); }
__device__ __forceinline__ float add_xor16(float v) { unsigned a = __builtin_bit_cast(unsigned, v), b = a; swap_rows16(a, b); return __builtin_bit_cast(float, a) + __builtin_bit_cast(float, b); }
__device__ __forceinline__ float add_xor32(float v) { unsigned a = __builtin_bit_cast(unsigned, v), b = a; swap_rows32(a, b); return __builtin_bit_cast(float, a) + __builtin_bit_cast(float, b); }
__device__ __forceinline__ float wave_sum(float v) {
#pragma unroll
    for (int o = 1; o < 64; o <<= 1) v += __shfl_xor(v, o);
    return v;
}
__device__ __forceinline__ float fast_sigmoid(float x) { return __builtin_amdgcn_rcpf(1.0f + __builtin_amdgcn_exp2f(-x * LOG2E)); }
__device__ __forceinline__ f32x4 gelu_tanh4(f32x4 x) {
    constexpr float A = -2.0f * 0.7978845608028654f * LOG2E, B = A * 0.044715f;
    const f32x4 t = (x * x * B + A) * x;
    const f32x4 d = (f32x4){__builtin_amdgcn_exp2f(t[0]), __builtin_amdgcn_exp2f(t[1]), __builtin_amdgcn_exp2f(t[2]), __builtin_amdgcn_exp2f(t[3])} + 1.0f;
    return x * (f32x4){__builtin_amdgcn_rcpf(d[0]), __builtin_amdgcn_rcpf(d[1]), __builtin_amdgcn_rcpf(d[2]), __builtin_amdgcn_rcpf(d[3])};
}
__device__ __forceinline__ unsigned pack_fp8x4(float a, float b, float c, float d) { unsigned t = 0; t = __builtin_amdgcn_cvt_pk_fp8_f32(a, b, t, false); t = __builtin_amdgcn_cvt_pk_fp8_f32(c, d, t, true); return t; }
#define LDS_WAIT() asm volatile("s_waitcnt lgkmcnt(0)" ::: "memory")
#define LDS_BARRIER() do { asm volatile("s_waitcnt lgkmcnt(0)" ::: "memory"); __builtin_amdgcn_s_barrier(); asm volatile("" ::: "memory"); } while (0)
__device__ __forceinline__ float ld_untracked(const float* p) { float v; asm volatile("global_load_dword %0, %1, off" : "=v"(v) : "v"(p) : "memory"); return v; }
#define VM_WAIT() asm volatile("s_waitcnt vmcnt(0)" ::: "memory")

typedef const float* const volatile __attribute__((address_space(4))) * karg_ptr_t;
struct Frame {
    LAS unsigned char* lds;
    unsigned char* ws;
    int tid, lane, wave, vcu, G;
    karg_ptr_t kin;
    float* out;
    __device__ __forceinline__ const float* in(int i) const { return kin[i]; }
};

namespace pg8 {
constexpr int BM = 256, BK = 64, HALF = 128, HTB = HALF * BK * 2, KD = 1024, NT = KD / BK;
__device__ __forceinline__ int lds_byte(int r, int c) { const int st = (r >> 4) * 2 + (c >> 5), rr = r & 15, cc = c & 31, ob = rr * 64 + cc * 2; return st * 1024 + (ob ^ (((ob >> 9) & 1) << 5)); }
__device__ __forceinline__ void stage_rc(int b, int& R, int& C) { const int st = b / 1024, sb = b % 1024, swz = sb ^ (((sb >> 9) & 1) << 5); R = (st >> 1) * 16 + swz / 64; C = (st & 1) * 32 + (swz % 64) / 2; }
__device__ __forceinline__ int perm32(int rho) { const int n = rho >> 4, i = rho & 15; return 8 * (i >> 2) + 4 * n + (i & 3); }
struct Unit { int pm, pn, e, tt; };

typedef int v4i_t __attribute__((ext_vector_type(4)));
typedef int v8i_t __attribute__((ext_vector_type(8)));
__device__ __forceinline__ v8i_t cat8(bf16x8 a, bf16x8 b) { return __builtin_shufflevector(__builtin_bit_cast(v4i_t, a), __builtin_bit_cast(v4i_t, b), 0, 1, 2, 3, 4, 5, 6, 7); }
template <class Prob, bool ALIGN_EPI>
__device__ __forceinline__ void gemm_phase(LAS unsigned char* lds, const Prob& P) {
    const int tid = threadIdx.x, wid = __builtin_amdgcn_readfirstlane(tid >> 6), lane = tid & 63, wr = wid >> 2, wc = wid & 3, fr = lane & 15, fq = lane >> 4;
    constexpr int K = Prob::FP8 ? KD / 2 : KD, nt = Prob::FP8 ? NT / 2 : NT;
    unsigned voffB[2];
#pragma unroll
    for (int i = 0; i < 2; ++i) { int R_, C_; stage_rc(tid * 16 + i * 8192, R_, C_); const int Rb = (R_ & ~31) + perm32(R_ & 31); voffB[i] = (unsigned)(Rb * K + C_) * 2u; }
    constexpr size_t kstep = (size_t)(BK * 2);
    constexpr size_t hstepB = (size_t)HALF * K * 2;
    const unsigned ldsw = (unsigned)wid * 1024u;
    const int aoff = lds_byte(wr * 64 + fr, fq * 8), boff = lds_byte(wc * 32 + fr, fq * 8);
#define PG8_SA(b, h) (((b) * 2 + (h)) * HTB)
#define PG8_SB(b, h) ((4 + (b) * 2 + (h)) * HTB)
#define PG8_STAGE(bufoff, gbase, voff) do { _Pragma("unroll") for (int _i = 0; _i < 2; ++_i) \
        __builtin_amdgcn_global_load_lds((const unsigned*)((const char*)(gbase) + (voff)[_i]), (LAS unsigned*)(lds + (bufoff) + ldsw + _i * 8192), 16, 0, 0); } while (0)
#define PG8_RD(off) (*(const LAS bf16x8*)(lds + (off)))
#define PG8_LDA(dst, b, h) do { _Pragma("unroll") for (int m = 0; m < 4; ++m) { if constexpr (Prob::FP8) dst##8[m] = cat8(PG8_RD(PG8_SA(b, h) + aoff + m * 2048), PG8_RD(PG8_SA(b, h) + aoff + m * 2048 + 1024)); \
        else { _Pragma("unroll") for (int k = 0; k < 2; ++k) dst[m][k] = PG8_RD(PG8_SA(b, h) + aoff + m * 2048 + k * 1024); } } } while (0)
#define PG8_LDB(dst, b, h) do { _Pragma("unroll") for (int n = 0; n < 2; ++n) { if constexpr (Prob::FP8) dst##8[n] = cat8(PG8_RD(PG8_SB(b, h) + boff + n * 2048), PG8_RD(PG8_SB(b, h) + boff + n * 2048 + 1024)); \
        else { _Pragma("unroll") for (int k = 0; k < 2; ++k) dst[n][k] = PG8_RD(PG8_SB(b, h) + boff + n * 2048 + k * 1024); } } } while (0)
#define PG8_MMA(ai, bj, At, Bt) do { __builtin_amdgcn_s_setprio(1); _Pragma("unroll") for (int m = 0; m < 4; ++m) _Pragma("unroll") for (int n = 0; n < 2; ++n) { \
        if constexpr (Prob::FP8) asm volatile("s_nop 1\n\tv_mfma_f32_16x16x128_f8f6f4 %0, %1, %2, %0" : "+v"(acc[ai][bj][m][n]) : "v"(Bt##8[n]), "v"(At##8[m])); \
        else { _Pragma("unroll") for (int k = 0; k < 2; ++k) acc[ai][bj][m][n] = __builtin_amdgcn_mfma_f32_16x16x32_bf16(Bt[n][k], At[m][k], acc[ai][bj][m][n], 0, 0, 0); } } \
        __builtin_amdgcn_s_setprio(0); } while (0)
#define PG8_WAIT_V(n) asm volatile("s_waitcnt vmcnt(" #n ")" ::: "memory")
#define PG8_WAIT_L(n) asm volatile("s_waitcnt lgkmcnt(" #n ")" ::: "memory")
#define PG8_BAR __builtin_amdgcn_s_barrier()
#define PG8_SCHED __builtin_amdgcn_sched_barrier(0)
    Unit cur, nxt; int ui = 0;
    if (!P.next(0, cur)) return;
    f32x4 acc[2][2][4][2];
#pragma unroll
    for (int a = 0; a < 2; ++a)
#pragma unroll
        for (int b = 0; b < 2; ++b)
#pragma unroll
            for (int m = 0; m < 4; ++m)
#pragma unroll
                for (int n = 0; n < 2; ++n) acc[a][b][m][n] = (f32x4){0.f, 0.f, 0.f, 0.f};
    bf16x8 At[4][2], B0[2][2], B1[2][2]; v8i_t At8[4], B08[2], B18[2]; (void)At; (void)B0; (void)B1; (void)At8; (void)B08; (void)B18;
    unsigned vo[2][2];
    { int R[2], C[2]; stage_rc(tid * 16, R[0], C[0]); stage_rc(tid * 16 + 8192, R[1], C[1]); P.aoff(cur, R, C, vo); }
    const char* cA = P.abase(cur);
    const char* cB = P.bptr(cur);
    float pfc = P.pre(cur, tid), pfn = 0.f;
    PG8_STAGE(PG8_SB(0, 0), cB, voffB); PG8_STAGE(PG8_SB(0, 1), cB + hstepB, voffB); PG8_STAGE(PG8_SA(0, 0), cA, vo[0]); PG8_STAGE(PG8_SA(0, 1), cA, vo[1]);
    if (wr == 1) PG8_BAR;
    PG8_WAIT_V(2); PG8_BAR;
    PG8_STAGE(PG8_SB(1, 0), cB + kstep, voffB); PG8_STAGE(PG8_SA(1, 0), cA + kstep, vo[0]); PG8_STAGE(PG8_SB(1, 1), cB + hstepB + kstep, voffB);
    PG8_WAIT_V(6); PG8_BAR;
    for (;;) {
        const bool has_next = P.next(ui + 1, nxt);
        const char* nB = has_next ? P.bptr(nxt) : cB;
        const char* nA = has_next ? P.abase(nxt) : cA;
#pragma nounroll
        for (int t = 0; t < nt; t += 2) {
            const bool last = (t == nt - 2);
            const char* a1 = cA + (size_t)(t + 1) * kstep;
            const char* a2 = last ? nA : cA + (size_t)(t + 2) * kstep; const char* b2 = last ? nB : cB + (size_t)(t + 2) * kstep;
            const char* a3 = a2 + kstep; const char* b3 = b2 + kstep;
            unsigned w2[2][2];
#pragma unroll
            for (int h = 0; h < 2; ++h)
#pragma unroll
                for (int i = 0; i < 2; ++i) w2[h][i] = vo[h][i];
            if (last && has_next) { int R[2], C[2]; stage_rc(tid * 16, R[0], C[0]); stage_rc(tid * 16 + 8192, R[1], C[1]); P.aoff(nxt, R, C, w2); pfn = P.pre(nxt, tid); }
            PG8_LDB(B0, 0, 0); PG8_LDB(B1, 0, 1); PG8_SCHED; PG8_LDA(At, 0, 0); PG8_STAGE(PG8_SA(1, 1), a1, vo[1]);
            PG8_WAIT_V(8); PG8_WAIT_L(0); PG8_BAR; PG8_MMA(0, 0, At, B0); PG8_MMA(0, 1, At, B1); PG8_BAR; PG8_SCHED;
            PG8_LDA(At, 0, 1); PG8_STAGE(PG8_SB(0, 0), b2, voffB); PG8_STAGE(PG8_SB(0, 1), b2 + hstepB, voffB); PG8_STAGE(PG8_SA(0, 0), a2, w2[0]);
            PG8_WAIT_V(8); PG8_WAIT_L(0); PG8_BAR; PG8_MMA(1, 0, At, B0); PG8_MMA(1, 1, At, B1); PG8_BAR; PG8_SCHED;
            PG8_LDB(B0, 1, 0); PG8_LDB(B1, 1, 1); PG8_SCHED; PG8_LDA(At, 1, 0); PG8_STAGE(PG8_SA(0, 1), a2, w2[1]);
            PG8_WAIT_V(8); PG8_WAIT_L(0); PG8_BAR; PG8_MMA(0, 0, At, B0); PG8_MMA(0, 1, At, B1); PG8_BAR; PG8_SCHED;
            PG8_LDA(At, 1, 1); PG8_STAGE(PG8_SB(1, 0), b3, voffB); PG8_STAGE(PG8_SB(1, 1), b3 + hstepB, voffB); PG8_STAGE(PG8_SA(1, 0), a3, w2[0]);
            PG8_WAIT_V(8); PG8_WAIT_L(0); PG8_BAR; PG8_MMA(1, 0, At, B0); PG8_MMA(1, 1, At, B1); PG8_BAR; PG8_SCHED;
        }
        if constexpr (ALIGN_EPI) { if (wr == 0) PG8_BAR; }
        { int fr_ = fr, fq_ = fq; asm volatile("" : "+v"(fr_), "+v"(fq_)); P.epi(acc, cur, wr, wc, fr_, fq_, pfc); }
        if (!has_next) break;
#pragma unroll
        for (int a = 0; a < 2; ++a)
#pragma unroll
            for (int b = 0; b < 2; ++b)
#pragma unroll
                for (int m = 0; m < 4; ++m)
#pragma unroll
                    for (int n = 0; n < 2; ++n) acc[a][b][m][n] = (f32x4){0.f, 0.f, 0.f, 0.f};
        cur = nxt; cB = nB; cA = nA; ++ui; pfc = pfn;
        { int R[2], C[2]; stage_rc(tid * 16, R[0], C[0]); stage_rc(tid * 16 + 8192, R[1], C[1]); P.aoff(cur, R, C, vo); }
        if constexpr (ALIGN_EPI) { if (wr == 1) PG8_BAR; }
    }
    PG8_WAIT_V(0);
    if constexpr (!ALIGN_EPI) { if (wr == 0) PG8_BAR; }
    PG8_BAR;
#undef PG8_SA
#undef PG8_SB
#undef PG8_STAGE
#undef PG8_LDA
#undef PG8_RD
#undef PG8_LDB
#undef PG8_MMA
#undef PG8_SCHED
}
struct StaticOrder {
    int nM, nN, nwg, G, c;
    __device__ void init(int M, int N, int G_, int c_) { nM = M / BM; nN = N / BM; nwg = nM * nN; G = G_; c = c_; }
    __device__ bool next(int i, int& pm, int& pn) const {
        const long L = (long)i * G + c; if (L >= nwg) return false;
        int wgid = (int)L; { const int q = nwg / 8, r = nwg % 8, xcd = wgid % 8, off = wgid / 8; wgid = (xcd < r ? xcd * (q + 1) : r * (q + 1) + (xcd - r) * q) + off; }
        const int nig = 8 * nN, gid = wgid / nig, fm = gid * 8, gsz = (nM - fm) < 8 ? (nM - fm) : 8;
        pm = fm + ((wgid % nig) % gsz); pn = (wgid % nig) / gsz; return true;
    }
};
}

__device__ __forceinline__ void p0_transpose_item(const float* W, int K, int N, bf16_t* WT, int out_row0, const float* g, LAS float* scr, int kb, int nb, int lane) {
    const int k0 = 64 * kb, n0 = 32 * nb;
#pragma unroll
    for (int i = 0; i < 8; ++i) { const int kk = 8 * i + (lane >> 3), c4 = lane & 7;
        *(LAS f32x4*)(scr + kk * 36 + ((4 * c4 + 4 * (kk >> 3)) & 31)) = __builtin_nontemporal_load((const f32x4*)(W + (size_t)(k0 + kk) * N + n0 + 4 * c4)); }
    LDS_WAIT(); asm volatile("" ::: "memory");
    const int c = lane & 7;
    float gv[8];
#pragma unroll
    for (int q = 0; q < 8; ++q) gv[q] = g ? g[k0 + 8 * c + q] : 1.0f;
#pragma unroll
    for (int j = 0; j < 4; ++j) { const int n = (lane >> 3) + 8 * j; const LAS float* s = scr + (8 * c) * 36 + ((n + 4 * c) & 31);
        u32x4 o; o.x = pk2(s[0 * 36] * gv[0], s[1 * 36] * gv[1]); o.y = pk2(s[2 * 36] * gv[2], s[3 * 36] * gv[3]); o.z = pk2(s[4 * 36] * gv[4], s[5 * 36] * gv[5]); o.w = pk2(s[6 * 36] * gv[6], s[7 * 36] * gv[7]);
        *(u32x4*)(WT + (size_t)(out_row0 + n) * K + k0 + 8 * c) = o; }
    LDS_WAIT(); asm volatile("" ::: "memory");
}
__device__ __forceinline__ void p0_prologue(Frame& F) {
    LAS float* scr = (LAS float*)(F.lds + F.wave * 16384);
    const int gw = F.vcu * NWAVES + F.wave, NGW = F.G * NWAVES;
    const float* x = F.in(0); const float* g1 = F.in(1); const float* w_in = F.in(2); const float* w_out = F.in(17); const float* g2 = F.in(18);
    bf16_t* WIN = (bf16_t*)(F.ws + WS_WIN); bf16_t* WOUT = (bf16_t*)(F.ws + WS_WOUT);
    constexpr int I_IN = 16 * 80, I_OUT = 16 * 32;
    constexpr int NITEMS = I_IN + I_OUT;
    for (int it = gw; it < NITEMS; it += NGW) {
        int r = it;
        if (r < I_IN) { const int kb = r / 80, nb = r % 80; p0_transpose_item(w_in, DM, DIN, WIN, 32 * nb, g1, scr, kb, nb, F.lane); continue; } r -= I_IN;
        { const int kb = r / 32, nb = r % 32; p0_transpose_item(w_out, DM, DM, WOUT, 32 * nb, nullptr, scr, kb, nb, F.lane); }
    }
    {
        const float* rw = F.in(19); bf16_t* WRH = (bf16_t*)(F.ws + WS_WRH); bf16_t* WRL = (bf16_t*)(F.ws + WS_WRL);
        const float* wa = F.in(5); const float* wx = F.in(7); bf16_t* WAT = (bf16_t*)(F.ws + WS_WAT); bf16_t* WXT = (bf16_t*)(F.ws + WS_WXT);
        const int gt = F.vcu * NTHR + F.tid, NGT = F.G * NTHR;
        for (int i = gt; i < 32768; i += NGT) {
            { const int n = i >> 10, k = i & 1023; const float v = rw[k * NEXP + n] * g2[k]; const unsigned h = f2bf(v); WRH[i] = (bf16_t)h; WRL[i] = (bf16_t)f2bf(v - bf2f(h)); }
            { const int nblk = i >> 12, j = (i >> 6) & 63, ii = i & 63; WAT[i] = (bf16_t)f2bf(wa[(nblk * 64 + ii) * 64 + j]); WXT[i] = (bf16_t)f2bf(wx[(nblk * 64 + ii) * 64 + j]); }
        }
    }
    {
        bf16_t* XB = (bf16_t*)(F.ws + WS_XB); float* RS1 = (float*)(F.ws + WS_RSTD1);
        for (int m = gw; m < MTOK; m += NGW) {
            const f32x4* xr = (const f32x4*)(x + (size_t)m * DM) + F.lane;
            f32x4 v[4]; float s = 0.f;
#pragma unroll
            for (int j = 0; j < 4; ++j) { v[j] = __builtin_nontemporal_load(&xr[64 * j]); s += (v[j].x * v[j].x + v[j].y * v[j].y) + (v[j].z * v[j].z + v[j].w * v[j].w); }
            s = wave_sum(s);
            if (F.lane == 0) RS1[m] = 1.0f / sqrtf(s * (1.0f / DM) + EPS);
            u32x2* o8 = (u32x2*)(XB + (size_t)m * DM) + F.lane;
#pragma unroll
            for (int j = 0; j < 4; ++j) { u32x2 w; w.x = pk2(v[j].x, v[j].y); w.y = pk2(v[j].z, v[j].w); o8[64 * j] = w; }
        }
    }
}

constexpr int STG_BUF0 = 3 * pg8::HTB, STG_BUF1 = LDS_AUX + 8192;
constexpr int LDS_PFX = LDS_AUX + 26624;
struct RowStager {
    LAS unsigned char* lds; int wr, wc, fr, fq, tid;
    template <class RowPtr> __device__ __forceinline__ void chunk(int c, u32x4 w0, u32x4 w1, const RowPtr& rowp) const {
        LAS unsigned char* buf = lds + ((c & 1) ? STG_BUF1 : STG_BUF0);
        const int rl = wr * 16 + fr, p0 = wc * 4 + fq;
        *(LAS u32x4*)(buf + rl * 512 + ((p0 ^ (rl & 7)) << 4)) = w0;
        *(LAS u32x4*)(buf + rl * 512 + (((16 + p0) ^ (rl & 7)) << 4)) = w1;
        asm volatile("s_waitcnt lgkmcnt(0)" ::: "memory"); __builtin_amdgcn_s_barrier(); asm volatile("" ::: "memory");
        const int ai = c >> 2, m = c & 3;
#pragma unroll
        for (int j = 0; j < 2; ++j) { const int p = tid + 512 * j, r2 = p >> 5, pi = p & 31;
            const u32x4 v = *(const LAS u32x4*)(buf + r2 * 512 + ((pi ^ (r2 & 7)) << 4));
            *(u32x4*)(rowp(ai * 128 + (r2 >> 4) * 64 + m * 16 + (r2 & 15)) + pi * 16) = v; }
    }
};

struct ProbInProj {
    static constexpr bool FP8 = false;
    pg8::StaticOrder S; const char* A; const char* Bt; const float* rstd1; bf16_t* dst0; const float* qg; const float* kg; LAS float* xs; LAS unsigned char* lds;
    __device__ __forceinline__ bool next(int i, pg8::Unit& u) const { u.e = 0; u.tt = 0; return S.next(i, u.pm, u.pn); }
    __device__ __forceinline__ const char* abase(const pg8::Unit& u) const { return A + (size_t)u.pm * 256 * DM * 2; }
    __device__ __forceinline__ void aoff(const pg8::Unit& u, const int (&R)[2], const int (&C)[2], unsigned (&vo)[2][2]) const {
#pragma unroll
        for (int h = 0; h < 2; ++h)
#pragma unroll
            for (int i = 0; i < 2; ++i) vo[h][i] = (unsigned)((h * 128 + R[i]) * DM + C[i]) * 2u;
    }
    __device__ __forceinline__ const char* bptr(const pg8::Unit& u) const { return Bt + (size_t)u.pn * 256 * DM * 2; }
    __device__ __forceinline__ float pre(const pg8::Unit& u, int tid) const { return ld_untracked(rstd1 + u.pm * 256 + (tid & 255)); }
    __device__ __forceinline__ void epi(f32x4 (&acc)[2][2][4][2], const pg8::Unit& u, int wr, int wc, int fr, int fq, float pf) const {
        const int type = u.pn >> 1;
        bf16_t* dst = dst0 + (size_t)type * ((WS_GG - WS_XR) / 2);
        const int row0 = u.pm * 256 + wr * 64 + fr, col0 = (u.pn & 1) * 256 + wc * 32 + 8 * fq;
        LAS float* pfx = (LAS float*)(lds + LDS_PFX);
        if (wr == 0) pfx[wc * 64 + fq * 16 + fr] = pf;
        asm volatile("s_waitcnt lgkmcnt(0)" ::: "memory"); __builtin_amdgcn_s_barrier(); asm volatile("" ::: "memory");
        float rs[2][4];
#pragma unroll
        for (int ai = 0; ai < 2; ++ai)
#pragma unroll
            for (int m = 0; m < 4; ++m) rs[ai][m] = pfx[wr * 64 + fr + ai * 128 + m * 16];
#pragma unroll
        for (int ai = 0; ai < 2; ++ai)
#pragma unroll
            for (int bj = 0; bj < 2; ++bj)
#pragma unroll
                for (int m = 0; m < 4; ++m)
#pragma unroll
                    for (int n = 0; n < 2; ++n) acc[ai][bj][m][n] = acc[ai][bj][m][n] * rs[ai][m];
        if (type == 1) {
#pragma unroll
            for (int ai = 0; ai < 2; ++ai)
#pragma unroll
                for (int bj = 0; bj < 2; ++bj)
#pragma unroll
                    for (int m = 0; m < 4; ++m)
#pragma unroll
                        for (int n = 0; n < 2; ++n) acc[ai][bj][m][n] = gelu_tanh4(acc[ai][bj][m][n]);
        }
        if (type == 2 || type == 3) {
            const int lane = fq * 16 + fr; (void)lane;
            float ss[2][4][2];
#pragma unroll
            for (int ai = 0; ai < 2; ++ai)
#pragma unroll
                for (int m = 0; m < 4; ++m)
#pragma unroll
                    for (int bj = 0; bj < 2; ++bj) { const f32x4 a = acc[ai][bj][m][0], b = acc[ai][bj][m][1]; const f32x4 q = a * a + b * b;
                        float s = (q[0] + q[1]) + (q[2] + q[3]);
                        s = add_xor16(s); s = add_xor32(s); ss[ai][m][bj] = s; }
            LAS float* mine = xs + ((wr * 4 + wc) * 8) * 32; LAS float* other = xs + ((wr * 4 + (wc ^ 1)) * 8) * 32;
            if (fq == 0) {
#pragma unroll
                for (int ai = 0; ai < 2; ++ai)
#pragma unroll
                    for (int m = 0; m < 4; ++m) { f32x2 w; w.x = ss[ai][m][0]; w.y = ss[ai][m][1]; *(LAS f32x2*)(mine + ((ai * 4 + m) * 16 + fr) * 2) = w; }
            }
            asm volatile("s_waitcnt lgkmcnt(0)" ::: "memory"); __builtin_amdgcn_s_barrier(); asm volatile("" ::: "memory");
            const float* g = (type == 2) ? qg : kg; const float sc = (type == 2) ? 0.125f * LOG2E : 1.0f;
            f32x4 gv[2];
#pragma unroll
            for (int n = 0; n < 2; ++n) gv[n] = *(const f32x4*)(g + 32 * (wc & 1) + 8 * fq + 4 * n) * sc;
#pragma unroll
            for (int ai = 0; ai < 2; ++ai)
#pragma unroll
                for (int m = 0; m < 4; ++m) { const f32x2 o = *(const LAS f32x2*)(other + ((ai * 4 + m) * 16 + fr) * 2);
#pragma unroll
                    for (int bj = 0; bj < 2; ++bj) { const float tot = ss[ai][m][bj] + (bj == 0 ? o.x : o.y); const float r = __builtin_amdgcn_rsqf(tot * (1.0f / 64.0f) + EPS);
#pragma unroll
                        for (int n = 0; n < 2; ++n) acc[ai][bj][m][n] = acc[ai][bj][m][n] * (gv[n] * r); } }
        }
        { const RowStager ST{lds, wr, wc, fr, fq, (wr * 4 + wc) * 64 + fq * 16 + fr};
          char* tbase = (char*)(dst + (size_t)u.pm * 256 * 512 + (u.pn & 1) * 256);
          auto rowp = [tbase](int r) { return tbase + (size_t)r * 1024; };
#pragma unroll
          for (int ai = 0; ai < 2; ++ai)
#pragma unroll
              for (int m = 0; m < 4; ++m) { u32x4 w[2];
#pragma unroll
                  for (int bj = 0; bj < 2; ++bj) { const f32x4 v0 = acc[ai][bj][m][0], v1 = acc[ai][bj][m][1];
                      w[bj].x = cvt_pk_bf16(v0[0], v0[1]); w[bj].y = cvt_pk_bf16(v0[2], v0[3]); w[bj].z = cvt_pk_bf16(v1[0], v1[1]); w[bj].w = cvt_pk_bf16(v1[2], v1[3]); }
                  ST.chunk(ai * 4 + m, w[0], w[1], rowp); } }
    }
};

__device__ __forceinline__ void conv_unit(Frame& F, int cu) {
    int lane = F.lane; asm volatile("" : "+v"(lane));
    const int wave = F.wave;
    LAS float* scr = (LAS float*)(F.lds + wave * 16384);
    const bool first = cu < 512;
    const int e = first ? (cu >> 4) : ((cu - 512) >> 3);
    const float* W = first ? F.in(21) + (size_t)e * DM * 2 * DFF : F.in(23) + (size_t)e * DFF * DM;
    unsigned char* WT = first ? F.ws + WS_W1 + (size_t)e * 2 * DFF * DM : F.ws + WS_W2 + (size_t)e * DM * DFF;
    const int N = first ? 2 * DFF : DM;
    const int c = lane & 3;
    float gv[16];
    { const float* g2 = F.in(18);
#pragma unroll
      for (int q = 0; q < 16; ++q) gv[q] = first ? g2[64 * (cu & 15) + 16 * c + q] * WSCALE : WSCALE; }
#define CV_GEOM(j, k0_, n0_, or_) do { const int idx_ = 8 * (j) + wave; \
        if (first) { k0_ = 64 * (cu & 15); n0_ = 32 * idx_; const int j0_ = n0_ & 1023; or_ = 256 * (j0_ >> 7) + (j0_ & 127) + ((n0_ >= 1024) ? 128 : 0); } \
        else { k0_ = 64 * (2 * ((cu - 512) & 7) + (idx_ >> 5)); n0_ = 32 * (idx_ & 31); or_ = n0_; } } while (0)
#define CV_LOAD(LD, k0_, n0_) do { _Pragma("unroll") for (int i = 0; i < 8; ++i) { const int kk = 8 * i + (lane >> 3), c4 = lane & 7; \
        LD[i] = __builtin_nontemporal_load((const f32x4*)(W + (size_t)((k0_) + kk) * N + (n0_) + 4 * c4)); } } while (0)
#define CV_ITEM(LD, j) do { \
        _Pragma("unroll") for (int i = 0; i < 8; ++i) { const int kk = 8 * i + (lane >> 3), c4 = lane & 7; \
            *(LAS f32x4*)(scr + kk * 36 + ((4 * c4 + 4 * (kk >> 3)) & 31)) = LD[i]; }         \
        int k0c, n0c, orc; CV_GEOM(j, k0c, n0c, orc); (void)n0c; \
        if ((j) + 2 < 8) { int k0n, n0n, orn; CV_GEOM((j) + 2, k0n, n0n, orn); (void)orn; CV_LOAD(LD, k0n, n0n); } \
        LDS_WAIT(); asm volatile("" ::: "memory"); \
        _Pragma("unroll") for (int j2 = 0; j2 < 2; ++j2) { const int n = (lane >> 2) + 16 * j2; const LAS float* sp = scr + (16 * c) * 36; \
            const int nc0 = (n + 8 * c) & 31, nc1 = (n + 8 * c + 4) & 31;           \
            unsigned w[4]; \
            _Pragma("unroll") for (int q = 0; q < 4; ++q) { unsigned t = 0; const int nc = (q < 2) ? nc0 : nc1; \
                t = __builtin_amdgcn_cvt_pk_fp8_f32(sp[(4 * q) * 36 + nc] * gv[4 * q], sp[(4 * q + 1) * 36 + nc] * gv[4 * q + 1], t, false); \
                t = __builtin_amdgcn_cvt_pk_fp8_f32(sp[(4 * q + 2) * 36 + nc] * gv[4 * q + 2], sp[(4 * q + 3) * 36 + nc] * gv[4 * q + 3], t, true); w[q] = t; } \
            *(u32x4*)(WT + (size_t)(orc + n) * 1024 + k0c + 16 * c) = (u32x4){w[0], w[1], w[2], w[3]}; } \
        LDS_WAIT(); asm volatile("" ::: "memory"); } while (0)
    f32x4 lda[8], ldb[8];
    { int k0, n0, orow; CV_GEOM(0, k0, n0, orow); (void)orow; CV_LOAD(lda, k0, n0); CV_GEOM(1, k0, n0, orow); CV_LOAD(ldb, k0, n0); }
    CV_ITEM(lda, 0); CV_ITEM(ldb, 1); CV_ITEM(lda, 2); CV_ITEM(ldb, 3); CV_ITEM(lda, 4); CV_ITEM(ldb, 5); CV_ITEM(lda, 6); CV_ITEM(ldb, 7);
#undef CV_ITEM
#undef CV_GEOM
#undef CV_LOAD
}

__device__ __forceinline__ void rglru_item(Frame& F, int item) {
    const int bb = item >> 3, nb = item & 7;
    int tid = F.tid; asm volatile("" : "+v"(tid));
    const int lane = tid & 63, wid = F.wave;
    const bf16_t* XR = (const bf16_t*)(F.ws + WS_XR); const bf16_t* GG = (const bf16_t*)(F.ws + WS_GG); bf16_t* Y = (bf16_t*)(F.ws + WS_Y);
    const float* conv_w = F.in(3); const float* conv_b = F.in(4); const float* ba = F.in(6); const float* bx = F.in(8); const float* lam = F.in(9);
    const bf16_t* WAT = (const bf16_t*)(F.ws + WS_WAT); const bf16_t* WXT = (const bf16_t*)(F.ws + WS_WXT);
    LAS bf16_t* XCb = (LAS bf16_t*)(F.lds);
    LAS float* XCf = (LAS float*)(F.lds + 9216);
    LAS float* RGl = (LAS float*)(F.lds + 9216 + 16384);
    LAS float* SEG = (LAS float*)(F.lds + 9216 + 16384 + 32768);
    LAS float* HC = (LAS float*)(F.lds + 9216 + 16384 + 32768 + 4096);
    const int ct = tid >> 3, cg = tid & 7, chb = nb * 64 + 8 * cg;
    float cw[4][8], cb[8];
#pragma unroll
    for (int j = 0; j < 4; ++j)
#pragma unroll
        for (int c = 0; c < 8; ++c) cw[j][c] = conv_w[j * DRNN + chb + c];
#pragma unroll
    for (int c = 0; c < 8; ++c) cb[c] = conv_b[chb + c];
    const int g = wid >> 2, mt = wid & 3, l15 = lane & 15, kq = lane >> 4;
    bf16x8 Bf[4][2];
    { const bf16_t* WT = (g == 0 ? WAT : WXT) + nb * 4096;
#pragma unroll
      for (int ntl = 0; ntl < 4; ++ntl)
#pragma unroll
          for (int ks = 0; ks < 2; ++ks) Bf[ntl][ks] = *(const bf16x8*)(WT + (16 * ntl + l15) * 64 + 32 * ks + 8 * kq); }
    float gbias[4];
#pragma unroll
    for (int ntl = 0; ntl < 4; ++ntl) gbias[ntl] = (g == 0 ? ba : bx)[nb * 64 + 16 * ntl + l15];
    const int sc = tid & 63, sg = tid >> 6;
    const float sp8 = 8.0f * log1pf(expf(-lam[nb * 64 + sc]));
    if (tid < 64) HC[tid] = 0.f;
    const size_t rowbase = (size_t)bb * SEQ;
    u32x4 xv[4];
#pragma unroll
    for (int j = 0; j < 4; ++j) { const int t = ct - 3 + j; xv[j] = (t >= 0) ? *(const u32x4*)(XR + (rowbase + t) * DRNN + chb) : (u32x4){0u, 0u, 0u, 0u}; }
    for (int c = 0; c < SEQ / 64; ++c) {
        const int t0 = 64 * c;
        {
            float xc[8];
#pragma unroll
            for (int q = 0; q < 8; ++q) xc[q] = cb[q];
#pragma unroll
            for (int j = 0; j < 4; ++j) { const unsigned w[4] = {xv[j].x, xv[j].y, xv[j].z, xv[j].w};
#pragma unroll
                for (int q = 0; q < 4; ++q) { xc[2 * q] += cw[j][2 * q] * bf2f(w[q] & 0xffffu); xc[2 * q + 1] += cw[j][2 * q + 1] * bf2f(w[q] >> 16); } }
            if (c + 1 < SEQ / 64) {
#pragma unroll
                for (int j = 0; j < 4; ++j) xv[j] = *(const u32x4*)(XR + (rowbase + t0 + 64 + ct - 3 + j) * DRNN + chb);
            }
            u32x4 pb; pb.x = pk2(xc[0], xc[1]); pb.y = pk2(xc[2], xc[3]); pb.z = pk2(xc[4], xc[5]); pb.w = pk2(xc[6], xc[7]);
            *(LAS u32x4*)(XCb + ct * 72 + 8 * cg) = pb;
            *(LAS f32x4*)(XCf + ct * 64 + 8 * cg) = (f32x4){xc[0], xc[1], xc[2], xc[3]};
            *(LAS f32x4*)(XCf + ct * 64 + 8 * cg + 4) = (f32x4){xc[4], xc[5], xc[6], xc[7]};
        }
        unsigned short gq[8];
#pragma unroll
        for (int s8 = 0; s8 < 8; ++s8) gq[s8] = GG[(rowbase + t0 + 8 * sg + s8) * DRNN + nb * 64 + sc];
        LDS_BARRIER();
        {
            bf16x8 Af[2];
#pragma unroll
            for (int ks = 0; ks < 2; ++ks) Af[ks] = *(const LAS bf16x8*)(XCb + (16 * mt + l15) * 72 + 32 * ks + 8 * kq);
#pragma unroll
            for (int ntl = 0; ntl < 4; ++ntl) {
                f32x4 d = (f32x4){0.f, 0.f, 0.f, 0.f};
#pragma unroll
                for (int ks = 0; ks < 2; ++ks) d = __builtin_amdgcn_mfma_f32_16x16x32_bf16(Af[ks], Bf[ntl][ks], d, 0, 0, 0);
#pragma unroll
                for (int r = 0; r < 4; ++r) RGl[g * 4096 + (16 * mt + 4 * kq + r) * 64 + 16 * ntl + l15] = fast_sigmoid(d[r] + gbias[ntl]);
            }
        }
        LDS_BARRIER();
        float av[8], uv[8]; float Aseg = 1.f, Hseg = 0.f;
#pragma unroll
        for (int s8 = 0; s8 < 8; ++s8) { const int tok = 8 * sg + s8;
            const float r = RGl[tok * 64 + sc], ig = RGl[4096 + tok * 64 + sc], xcv = XCf[tok * 64 + sc];
            const float la = -sp8 * r, y2 = 2.0f * la;
            const float a = __expf(la);
            const float om_s = -y2 * (1.0f + y2 * (0.5f + y2 * (0.16666667f + y2 * 0.041666668f))), om_e = 1.0f - a * a;
            const float om = (y2 > -0.1f) ? om_s : om_e;
            const float u = __builtin_amdgcn_sqrtf(om) * (ig * xcv);
            av[s8] = a; uv[s8] = u; Aseg *= a; Hseg = a * Hseg + u; }
        SEG[(sg * 64 + sc) * 2] = Aseg; SEG[(sg * 64 + sc) * 2 + 1] = Hseg;
        LDS_BARRIER();
        float h = HC[(c & 1) * 64 + sc];
        for (int s2 = 0; s2 < sg; ++s2) h = SEG[(s2 * 64 + sc) * 2] * h + SEG[(s2 * 64 + sc) * 2 + 1];
#pragma unroll
        for (int s8 = 0; s8 < 8; ++s8) { h = av[s8] * h + uv[s8]; Y[(rowbase + t0 + 8 * sg + s8) * DM + nb * 64 + sc] = (bf16_t)f2bf(h * bf2f(gq[s8])); }
        if (sg == 7) HC[((c + 1) & 1) * 64 + sc] = h;
    }
    __syncthreads();
}

namespace att {
constexpr float ATT_THR = 8.0f;
constexpr int LK0 = 0, LK1 = 8192, LV = 16384, LBUF = 32768  , LWS = 98304, LOX = 0;
__device__ __forceinline__ int crow(int r, int hi) { return (r & 3) + 8 * (r >> 2) + 4 * hi; }
__device__ __forceinline__ void glds16(const void* gsrc, unsigned lds_dst) { unsigned keep;
    asm volatile("s_mov_b32 %0, m0\n\ts_mov_b32 m0, %2\n\ts_nop 0\n\tglobal_load_lds_dwordx4 %1, off\n\ts_mov_b32 m0, %0" : "=&s"(keep) : "v"(gsrc), "s"(lds_dst) : "memory"); }
typedef __attribute__((address_space(3))) const char* lds_cptr;
typedef short v4i16_t __attribute__((ext_vector_type(4)));
__device__ __forceinline__ s16x4 vtr(lds_cptr p) { return __builtin_bit_cast(s16x4, __builtin_amdgcn_ds_read_tr16_b64_v4i16((__attribute__((address_space(3))) v4i16_t*)p)); }
template <int CTRL> __device__ __forceinline__ float dpp_f(float x) { return __int_as_float(__builtin_amdgcn_update_dpp(0, __float_as_int(x), CTRL, 0xf, 0xf, true)); }
__device__ __forceinline__ float rowmax_pos(const f32x16& p0, const f32x16& p1) {
    int a = 0, b = 0;
#pragma unroll
    for (int r = 0; r < 16; r += 2) { a = max(max(a, __float_as_int(p0[r])), __float_as_int(p0[r + 1])); b = max(max(b, __float_as_int(p1[r])), __float_as_int(p1[r + 1])); }
    a = max(a, b);
    unsigned ua = (unsigned)a, ub = ua; swap_rows32(ua, ub);
    return __int_as_float(max((int)ua, (int)ub));
}
__device__ __forceinline__ void attn_unit(Frame& F, int b, int h, int qb, float lam) {
    int lane = F.lane; asm volatile("" : "+v"(lane));
    const int r32 = lane & 31, hi = lane >> 5, wid = F.wave, mp = wid >> 2, wq = wid & 3;
    const bf16_t* Q = (const bf16_t*)(F.ws + WS_Q); const bf16_t* K = (const bf16_t*)(F.ws + WS_K); const bf16_t* V = (const bf16_t*)(F.ws + WS_V); bf16_t* Y = (bf16_t*)(F.ws + WS_Y);
    const float* subg = F.in(16);
    char* shm = (char*)F.lds;
    const unsigned lds0 = (unsigned)(uintptr_t)shm;
    const size_t rowbase = (size_t)b * SEQ; const int q0 = qb * 128;
    const int NT = 2 * (qb + 1);
    float* wsf = (float*)(shm + LWS) + wid * 64;
    bf16x8 qr[4];
    { const bf16_t* Qw = Q + (rowbase + q0 + wq * 32 + r32) * 512 + h * 128 + mp * 64;
#pragma unroll
      for (int d0 = 0; d0 < 4; ++d0) qr[d0] = *(const bf16x8*)(Qw + d0 * 16 + hi * 8); }
    const bf16_t* ks0 = K + (rowbase + lane) * 512 + h * 128 + wid * 8;
    const bf16_t* ks1 = ks0 + 64;
    const bf16_t* vs0 = V + (rowbase + 16 * (wid & 3) + (lane >> 2)) * 512 + h * 128 + (wid >> 2) * 32 + (lane & 3) * 8;
    const bf16_t* vs1 = vs0 + 64;
    const unsigned kd0 = (unsigned)__builtin_amdgcn_readfirstlane(lds0 + LK0 + wid * 1024), kd1 = (unsigned)__builtin_amdgcn_readfirstlane(lds0 + LK1 + wid * 1024);
    const unsigned vd0 = (unsigned)__builtin_amdgcn_readfirstlane(lds0 + LV + wid * 1024), vd1 = (unsigned)__builtin_amdgcn_readfirstlane(lds0 + LV + (wid + 8) * 1024);
    const lds_cptr shm3 = (lds_cptr)(F.lds);
    const lds_cptr kp0 = shm3 + (mp ? LK1 : LK0) + hi * 1024 + r32 * 16;
    const lds_cptr vp0 = shm3 + LV + ((lane >> 4) & 1) * 32 + (lane & 3) * 8 + (4 * hi + ((lane & 15) >> 2)) * 64;
    f32x16 negm = f32x16{}; asm volatile("" : "+v"(negm));
    float m_run = 0.f, l_run = 0.f;
    f32x16 o[4];
#pragma unroll
    for (int d = 0; d < 4; ++d) o[d] = f32x16{};
    const int qrel = wq * 32 + r32;
    glds16(ks0, kd0); glds16(ks1, kd1); glds16(vs0, vd0); glds16(vs1, vd1);
    asm volatile("" : "+v"(qr[0]), "+v"(qr[1]), "+v"(qr[2]), "+v"(qr[3]));
    f32x16 p0, p1;
    u32x4 pw[4];
    int bcur = 0, bprev = 0, bnext = LBUF;
#define ATT_QK(P0, P1, slot) do { _Pragma("unroll") for (int d0 = 0; d0 < 4; ++d0) { \
        const bf16x8 k0f = *(const __attribute__((address_space(3))) bf16x8*)(kp0 + (slot) + d0 * 2048); \
        const bf16x8 k1f = *(const __attribute__((address_space(3))) bf16x8*)(kp0 + (slot) + d0 * 2048 + 512); \
        if (d0 == 0) { P0 = __builtin_amdgcn_mfma_f32_32x32x16_bf16(k0f, qr[0], negm, 0, 0, 0); P1 = __builtin_amdgcn_mfma_f32_32x32x16_bf16(k1f, qr[0], negm, 0, 0, 0); } \
        else { P0 = __builtin_amdgcn_mfma_f32_32x32x16_bf16(k0f, qr[d0], P0, 0, 0, 0); P1 = __builtin_amdgcn_mfma_f32_32x32x16_bf16(k1f, qr[d0], P1, 0, 0, 0); } } } while (0)
#define ATT_MASK(P0, P1, t) do { if ((t) >= NT - 2) { const int kb_ = 64 * ((t) - (NT - 2)) + 4 * hi; \
        _Pragma("unroll") for (int r = 0; r < 16; ++r) { const int kv = kb_ + (r & 3) + 8 * (r >> 2); if (kv > qrel) P0[r] = -INFINITY; if (kv + 32 > qrel) P1[r] = -INFINITY; } } } while (0)
#define ATT_SUMPACK(P0, P1) do { float sacc = 0.f; _Pragma("unroll") for (int r = 0; r < 16; ++r) sacc += P0[r] + P1[r]; l_run += sacc; \
        pw[0] = (u32x4){cvt_pk_bf16(P0[0], P0[1]), cvt_pk_bf16(P0[2], P0[3]), cvt_pk_bf16(P0[4], P0[5]), cvt_pk_bf16(P0[6], P0[7])}; \
        pw[1] = (u32x4){cvt_pk_bf16(P0[8], P0[9]), cvt_pk_bf16(P0[10], P0[11]), cvt_pk_bf16(P0[12], P0[13]), cvt_pk_bf16(P0[14], P0[15])}; \
        pw[2] = (u32x4){cvt_pk_bf16(P1[0], P1[1]), cvt_pk_bf16(P1[2], P1[3]), cvt_pk_bf16(P1[4], P1[5]), cvt_pk_bf16(P1[6], P1[7])}; \
        pw[3] = (u32x4){cvt_pk_bf16(P1[8], P1[9]), cvt_pk_bf16(P1[10], P1[11]), cvt_pk_bf16(P1[12], P1[13]), cvt_pk_bf16(P1[14], P1[15])}; } while (0)
#define ATT_PV(slot) do { _Pragma("unroll") for (int db = 0; db < 4; ++db) { _Pragma("unroll") for (int ks = 0; ks < 4; ++ks) { \
        const s16x4 lo = vtr(vp0 + (slot) + db * 4096 + ks * 1024), hh = vtr(vp0 + (slot) + db * 4096 + ks * 1024 + 512); \
        const bf16x8 vf = (bf16x8){lo[0], lo[1], lo[2], lo[3], hh[0], hh[1], hh[2], hh[3]}; \
        o[db] = __builtin_amdgcn_mfma_f32_32x32x16_bf16(__builtin_bit_cast(bf16x8, pw[ks]), vf, o[db], 0, 0, 0); } } } while (0)
#define ATT_DECIDE(P0, P1, moved) do { const float rm = rowmax_pos(P0, P1); moved = false; \
        if (__any(rm > ATT_THR)) { const float dl = rm; m_run += dl; \
            _Pragma("unroll") for (int r = 0; r < 16; ++r) { P0[r] -= dl; P1[r] -= dl; negm[r] = -m_run; } \
            asm volatile("" : "+v"(negm)); \
            const float f = __builtin_amdgcn_exp2f(-dl); l_run *= f; if (hi == 0) wsf[r32] = f; moved = true; } } while (0)
#define ATT_RESCALE_O() do { asm volatile("s_waitcnt lgkmcnt(0)" ::: "memory"); _Pragma("unroll") for (int r = 0; r < 16; ++r) { const float fr_ = wsf[crow(r, hi)]; \
        _Pragma("unroll") for (int d = 0; d < 4; ++d) o[d][r] *= fr_; } } while (0)
    asm volatile("s_waitcnt vmcnt(0) lgkmcnt(0)" ::: "memory"); __builtin_amdgcn_s_barrier(); asm volatile("" ::: "memory");
    { const size_t go = (size_t)1 * 64 * 512; glds16(ks0 + go, kd0 + LBUF); glds16(ks1 + go, kd1 + LBUF); glds16(vs0 + go, vd0 + LBUF); glds16(vs1 + go, vd1 + LBUF); }
    ATT_QK(p0, p1, 0); ATT_MASK(p0, p1, 0);
    { bool moved; ATT_DECIDE(p0, p1, moved); (void)moved; }
#pragma unroll
    for (int r = 0; r < 16; ++r) { p0[r] = __builtin_amdgcn_exp2f(p0[r]); p1[r] = __builtin_amdgcn_exp2f(p1[r]); }
    bprev = 0; bcur = LBUF; bnext = 2 * LBUF;
#define SBAR() __builtin_amdgcn_sched_barrier(0)
#define PIN1(x) asm volatile("" : "+v"(x))
#define KRD(j, slot) (*(const __attribute__((address_space(3))) bf16x8*)(kp0 + (slot) + ((j) >> 1) * 2048 + ((j) & 1) * 512))
#define VRDF(i, slot) do { vlo[(i) % 3] = vtr(vp0 + (slot) + ((i) >> 2) * 4096 + ((i) & 3) * 1024); vhi[(i) % 3] = vtr(vp0 + (slot) + ((i) >> 2) * 4096 + ((i) & 3) * 1024 + 512); } while (0)
#define VFRG(i) (bf16x8){vlo[(i) % 3][0], vlo[(i) % 3][1], vlo[(i) % 3][2], vlo[(i) % 3][3], vhi[(i) % 3][0], vhi[(i) % 3][1], vhi[(i) % 3][2], vhi[(i) % 3][3]}
#define GAPA(j, N0, N1, slot, PA, B, PWW, W0, W1) do { \
        if ((j) == 0) N0 = __builtin_amdgcn_mfma_f32_32x32x16_bf16(kf[0], qr[0], negm, 0, 0, 0); \
        else if ((j) == 1) N1 = __builtin_amdgcn_mfma_f32_32x32x16_bf16(kf[1], qr[0], negm, 0, 0, 0); \
        else if (((j) & 1) == 0) N0 = __builtin_amdgcn_mfma_f32_32x32x16_bf16(kf[(j) % 3], qr[(j) >> 1], N0, 0, 0, 0); \
        else N1 = __builtin_amdgcn_mfma_f32_32x32x16_bf16(kf[(j) % 3], qr[(j) >> 1], N1, 0, 0, 0); \
        if ((j) + 2 < 8) kf[((j) + 2) % 3] = KRD((j) + 2, slot); \
        sacc += PA[B]; sacc += PA[B + 1]; sacc += PA[B + 2]; sacc += PA[B + 3]; PIN1(sacc); \
        PWW[W0] = cvt_pk_bf16(PA[B], PA[B + 1]); PWW[W1] = cvt_pk_bf16(PA[B + 2], PA[B + 3]); PIN1(PWW); SBAR(); } while (0)
#define GAPB(i, slot, X, NX, B) do { \
        o[(i) >> 2] = __builtin_amdgcn_mfma_f32_32x32x16_bf16(__builtin_bit_cast(bf16x8, pw[(i) & 3]), VFRG(i), o[(i) >> 2], 0, 0, 0); \
        if ((i) + 2 < 16) VRDF((i) + 2, slot); \
        X[B] = __builtin_amdgcn_exp2f(NX[B]); X[B + 1] = __builtin_amdgcn_exp2f(NX[B + 1]); PIN1(X); SBAR(); } while (0)
#define ATT_STEP(t, MASKED) do { \
        asm volatile("s_waitcnt vmcnt(0) lgkmcnt(0)" ::: "memory"); \
        __builtin_amdgcn_s_barrier(); \
        asm volatile("" ::: "memory"); \
        if ((t) + 1 < NT) { const size_t go = (size_t)((t) + 1) * 64 * 512; const unsigned b1 = (unsigned)bnext; \
            glds16(ks0 + go, kd0 + b1); glds16(ks1 + go, kd1 + b1); glds16(vs0 + go, vd0 + b1); glds16(vs1 + go, vd1 + b1); } \
        SBAR(); \
        f32x16 n0, n1; bf16x8 kf[3]; s16x4 vlo[3], vhi[3]; float sacc = 0.f; u32x4 q0_, q1_, q2_, q3_; \
        kf[0] = KRD(0, bcur); kf[1] = KRD(1, bcur); SBAR(); \
        GAPA(0, n0, n1, bcur, p0, 0, q0_, 0, 1); GAPA(1, n0, n1, bcur, p0, 4, q0_, 2, 3); GAPA(2, n0, n1, bcur, p0, 8, q1_, 0, 1); GAPA(3, n0, n1, bcur, p0, 12, q1_, 2, 3); \
        GAPA(4, n0, n1, bcur, p1, 0, q2_, 0, 1); GAPA(5, n0, n1, bcur, p1, 4, q2_, 2, 3); GAPA(6, n0, n1, bcur, p1, 8, q3_, 0, 1); GAPA(7, n0, n1, bcur, p1, 12, q3_, 2, 3); \
        l_run += sacc; pw[0] = q0_; pw[1] = q1_; pw[2] = q2_; pw[3] = q3_; \
        VRDF(0, bprev); VRDF(1, bprev); SBAR();                         \
        if (MASKED) ATT_MASK(n0, n1, t); \
        bool moved; ATT_DECIDE(n0, n1, moved); \
        SBAR(); \
        GAPB(0, bprev, p0, n0, 0); GAPB(1, bprev, p0, n0, 2); GAPB(2, bprev, p0, n0, 4); GAPB(3, bprev, p0, n0, 6); \
        GAPB(4, bprev, p0, n0, 8); GAPB(5, bprev, p0, n0, 10); GAPB(6, bprev, p0, n0, 12); GAPB(7, bprev, p0, n0, 14); \
        GAPB(8, bprev, p1, n1, 0); GAPB(9, bprev, p1, n1, 2); GAPB(10, bprev, p1, n1, 4); GAPB(11, bprev, p1, n1, 6); \
        GAPB(12, bprev, p1, n1, 8); GAPB(13, bprev, p1, n1, 10); GAPB(14, bprev, p1, n1, 12); GAPB(15, bprev, p1, n1, 14); \
        if (moved) ATT_RESCALE_O(); \
        bprev = bcur; bcur = bnext; bnext = (bnext == 2 * LBUF) ? 0 : bnext + LBUF; } while (0)
    { int t = 1;
      for (; t < NT - 2; ++t) ATT_STEP(t, false);
      for (; t < NT; ++t) ATT_STEP(t, true); }
#undef ATT_STEP
#undef GAPA
#undef GAPB
#undef KRD
#undef VRDF
#undef VFRG
#undef SBAR
#undef PIN1
    ATT_SUMPACK(p0, p1);
    ATT_PV(bprev);
#undef ATT_QK
#undef ATT_MASK
#undef ATT_SUMPACK
#undef ATT_PV
#undef ATT_DECIDE
#undef ATT_RESCALE_O
    l_run = add_xor32(l_run);
    if (hi == 0) wsf[32 + r32] = l_run;
    asm volatile("s_waitcnt lgkmcnt(0)" ::: "memory");
    f32x16 rliv;
#pragma unroll
    for (int g = 0; g < 4; ++g) { const f32x4 lv = *(const f32x4*)(wsf + 32 + 8 * g + 4 * hi);
#pragma unroll
        for (int j = 0; j < 4; ++j) rliv[4 * g + j] = __builtin_amdgcn_rcpf(lv[j]); }
    __syncthreads();
    float* ox = (float*)(shm + LOX) + wq * 4096;
    if (mp == 1) {
#pragma unroll
        for (int db = 0; db < 4; ++db) { const f32x16 t = o[db] * rliv;
#pragma unroll
            for (int g = 0; g < 4; ++g) *(f32x4*)(ox + ((db * 4 + g) * 64 + lane) * 4) = (f32x4){t[4 * g], t[4 * g + 1], t[4 * g + 2], t[4 * g + 3]}; }
    }
    __syncthreads();
    if (mp == 0) {
        f32x16 ssv = f32x16{};
#pragma unroll
        for (int db = 0; db < 4; ++db) { f32x16 x1;
#pragma unroll
            for (int g = 0; g < 4; ++g) { const f32x4 t = *(const f32x4*)(ox + ((db * 4 + g) * 64 + lane) * 4); x1[4 * g] = t[0]; x1[4 * g + 1] = t[1]; x1[4 * g + 2] = t[2]; x1[4 * g + 3] = t[3]; }
            const f32x16 v = o[db] * rliv - x1 * lam; o[db] = v; ssv = v * v + ssv; }
#pragma unroll
        for (int r = 0; r < 16; ++r) { float sv = ssv[r];
            sv += dpp_f<0xB1>(sv); sv += dpp_f<0x4E>(sv); sv += dpp_f<0x141>(sv); sv += dpp_f<0x140>(sv);
            sv = add_xor16(sv);
            ssv[r] = 0.8f * __builtin_amdgcn_rsqf(sv * (1.0f / 128.0f) + EPS); }
        float sg[4];
#pragma unroll
        for (int db = 0; db < 4; ++db) sg[db] = subg[32 * db + r32];
        bf16_t* stg = (bf16_t*)ox;
#pragma unroll
        for (int db = 0; db < 4; ++db) { const f32x16 t = o[db] * (ssv * sg[db]);
#pragma unroll
            for (int r = 0; r < 16; r += 2) { const unsigned w = cvt_pk_bf16(t[r], t[r + 1]);
                stg[crow(r, hi) * 128 + 32 * db + r32] = (bf16_t)(w & 0xffffu); stg[crow(r + 1, hi) * 128 + 32 * db + r32] = (bf16_t)(w >> 16); } }
        asm volatile("s_waitcnt lgkmcnt(0)" ::: "memory");
        bf16_t* yb = Y + (rowbase + q0 + wq * 32) * DM + 512 + h * 128;
#pragma unroll
        for (int i = 0; i < 8; ++i) { const int q = lane + 64 * i, row = q >> 4, pc = q & 15;
            const u32x4 v = *(const u32x4*)(stg + row * 128 + pc * 8);
            *(u32x4*)(yb + (size_t)row * DM + pc * 8) = v; }
    }
}
constexpr int NCONV = 768, NQUEUE = 128 + 1024 + NCONV;
__device__ __forceinline__ void mixer_phase(Frame& F) {
    const float* lq1 = F.in(12); const float* lk1 = F.in(13); const float* lq2 = F.in(14); const float* lk2 = F.in(15);
    float a1 = lq1[F.lane] * lk1[F.lane], a2 = lq2[F.lane] * lk2[F.lane];
    a1 = wave_sum(a1); a2 = wave_sum(a2);
    const float lam = expf(a1) - expf(a2) + 0.2f;
    unsigned* qhead = (unsigned*)(F.ws + WS_CTL) + CW_QUEUE;
    volatile LAS unsigned* slot = (volatile LAS unsigned*)(F.lds + LDS_MISC) + 16;
    for (;;) {
        if (F.tid == 0) slot[0] = __hip_atomic_fetch_add(qhead, 1u, __ATOMIC_RELAXED, __HIP_MEMORY_SCOPE_AGENT);
        __syncthreads();
        const int u = (int)__builtin_amdgcn_readfirstlane(slot[0]);
        if (u >= NQUEUE) break;
        if (u < 128) { rglru_item(F, u); continue; }
        const int v = u - 128;
        if (v < 2 * NCONV && (v & 1)) { conv_unit(F, v >> 1); __syncthreads(); continue; }
        const int idx = (v < 2 * NCONV) ? (v >> 1) : v - NCONV, qb = 15 - (idx >> 6), bh = idx & 63;
        attn_unit(F, bh >> 2, bh & 3, qb, lam); __syncthreads();
    }
    __syncthreads();
}
}

struct ProbOutProj {
    static constexpr bool FP8 = false;
    pg8::StaticOrder S; const char* A; const char* Bt; const bf16_t* xb; bf16_t* x1h; unsigned char* x1q; LAS unsigned char* lds;
    __device__ __forceinline__ bool next(int i, pg8::Unit& u) const { u.e = 0; u.tt = 0; return S.next(i, u.pm, u.pn); }
    __device__ __forceinline__ const char* abase(const pg8::Unit& u) const { return A + (size_t)u.pm * 256 * DM * 2; }
    __device__ __forceinline__ void aoff(const pg8::Unit& u, const int (&R)[2], const int (&C)[2], unsigned (&vo)[2][2]) const {
#pragma unroll
        for (int h = 0; h < 2; ++h)
#pragma unroll
            for (int i = 0; i < 2; ++i) vo[h][i] = (unsigned)((h * 128 + R[i]) * DM + C[i]) * 2u;
    }
    __device__ __forceinline__ const char* bptr(const pg8::Unit& u) const { return Bt + (size_t)u.pn * 256 * DM * 2; }
    __device__ __forceinline__ float pre(const pg8::Unit&, int) const { return 0.f; }
    __device__ __forceinline__ void epi(f32x4 (&acc)[2][2][4][2], const pg8::Unit& u, int wr, int wc, int fr, int fq, float) const {
        const int tid = (wr * 4 + wc) * 64 + fq * 16 + fr;
        const size_t tile0 = (size_t)u.pm * 256 * DM + (size_t)u.pn * 256;
        u32x4 xres[8][2];
#pragma unroll
        for (int c = 0; c < 8; ++c)
#pragma unroll
            for (int j = 0; j < 2; ++j) { const int p = tid + 512 * j, r2 = p >> 5, pi = p & 31;
                xres[c][j] = *(const u32x4*)(xb + tile0 + (size_t)((c >> 2) * 128 + (r2 >> 4) * 64 + (c & 3) * 16 + (r2 & 15)) * DM + pi * 8); }
#pragma unroll
        for (int ai = 0; ai < 2; ++ai)
#pragma unroll
            for (int m = 0; m < 4; ++m) { const int c = ai * 4 + m;
                LAS unsigned char* buf = lds + ((c & 1) ? STG_BUF1 : STG_BUF0);
                const int rl = wr * 16 + fr, p0 = wc * 4 + fq;
#pragma unroll
                for (int bj = 0; bj < 2; ++bj) { const f32x4 v0 = acc[ai][bj][m][0], v1 = acc[ai][bj][m][1];
                    u32x4 w; w.x = cvt_pk_bf16(v0[0], v0[1]); w.y = cvt_pk_bf16(v0[2], v0[3]); w.z = cvt_pk_bf16(v1[0], v1[1]); w.w = cvt_pk_bf16(v1[2], v1[3]);
                    *(LAS u32x4*)(buf + rl * 512 + (((bj * 16 + p0) ^ (rl & 7)) << 4)) = w; }
                asm volatile("s_waitcnt lgkmcnt(0)" ::: "memory"); __builtin_amdgcn_s_barrier(); asm volatile("" ::: "memory");
#pragma unroll
                for (int j = 0; j < 2; ++j) { const int p = tid + 512 * j, r2 = p >> 5, pi = p & 31;
                    const u32x4 a = *(const LAS u32x4*)(buf + r2 * 512 + ((pi ^ (r2 & 7)) << 4));
                    const size_t off = tile0 + (size_t)(ai * 128 + (r2 >> 4) * 64 + m * 16 + (r2 & 15)) * DM + pi * 8;
                    const u32x4 xv = xres[c][j];
                    const unsigned aw[4] = {a.x, a.y, a.z, a.w}, xw[4] = {xv.x, xv.y, xv.z, xv.w};
                    float v[8];
#pragma unroll
                    for (int q = 0; q < 4; ++q) { v[2 * q] = bf2f(aw[q] & 0xffffu) + bf2f(xw[q] & 0xffffu); v[2 * q + 1] = bf2f(aw[q] >> 16) + bf2f(xw[q] >> 16); }
                    u32x4 hb; hb.x = cvt_pk_bf16(v[0], v[1]); hb.y = cvt_pk_bf16(v[2], v[3]); hb.z = cvt_pk_bf16(v[4], v[5]); hb.w = cvt_pk_bf16(v[6], v[7]);
                    *(u32x4*)(x1h + off) = hb;
                    u32x2 w8; w8.x = pack_fp8x4(v[0], v[1], v[2], v[3]); w8.y = pack_fp8x4(v[4], v[5], v[6], v[7]);
                    *(u32x2*)(x1q + off) = w8; } }
    }
};

__device__ __forceinline__ void p5_router(Frame& F) {
    const int lane = F.lane, r32 = lane & 31, hi = lane >> 5, wid = F.wave, tl = wid & 3, kh = wid >> 2, tid = F.tid;
    const bf16_t* x1 = (const bf16_t*)(F.ws + WS_X1H); const bf16_t* WRH = (const bf16_t*)(F.ws + WS_WRH); const bf16_t* WRL = (const bf16_t*)(F.ws + WS_WRL);
    const float* rb = F.in(20);
    unsigned* ctl = (unsigned*)(F.ws + WS_CTL);
    int* LIST = (int*)(F.ws + WS_LIST); float* GATES = (float*)(F.ws + WS_GATES); float* RS2 = (float*)(F.ws + WS_RSTD2); int* POSI = (int*)(F.ws + WS_POSI);
    LAS float* T = (LAS float*)(F.lds);
    LAS float* SS = (LAS float*)(F.lds + 2 * 4 * 32 * 33 * 4);
    LAS unsigned* CNTL = (LAS unsigned*)(F.lds + 2 * 4 * 32 * 33 * 4 + 1024);
    float rbv[8];
#pragma unroll
    for (int j = 0; j < 8; ++j) rbv[j] = rb[8 * (tid & 3) + j];
    for (int blk = F.vcu; blk < MTOK / 128; blk += F.G) {
        const int R0 = blk * 128;
        if (tid < 32) CNTL[tid] = 0u;
        f32x16 acc = f32x16{}; float ssq = 0.f;
        const bf16_t* xrow = x1 + (size_t)(R0 + tl * 32 + r32) * DM + kh * 512 + hi * 8;
        const bf16_t* wh = WRH + r32 * DM + kh * 512 + hi * 8; const bf16_t* wl = WRL + r32 * DM + kh * 512 + hi * 8;
#pragma unroll 8
        for (int s = 0; s < 32; ++s) {
            const u32x4 xa = *(const u32x4*)(xrow + 16 * s);
            const unsigned xw[4] = {xa.x, xa.y, xa.z, xa.w};
#pragma unroll
            for (int j = 0; j < 4; ++j) { const float a = bf2f(xw[j] & 0xffffu), b = bf2f(xw[j] >> 16); ssq += a * a + b * b; }
            const bf16x8 bh = *(const bf16x8*)(wh + 16 * s), bl = *(const bf16x8*)(wl + 16 * s);
            acc = __builtin_amdgcn_mfma_f32_32x32x16_bf16(__builtin_bit_cast(bf16x8, xa), bh, acc, 0, 0, 0);
            acc = __builtin_amdgcn_mfma_f32_32x32x16_bf16(__builtin_bit_cast(bf16x8, xa), bl, acc, 0, 0, 0);
        }
        ssq = add_xor32(ssq);
#pragma unroll
        for (int r = 0; r < 16; ++r) T[((kh * 4 + tl) * 32 + att::crow(r, hi)) * 33 + r32] = acc[r];
        if (hi == 0) SS[(kh * 4 + tl) * 32 + r32] = ssq;
        __syncthreads();
        int ek[4]; float gk[4]; unsigned rk[4] = {0u, 0u, 0u, 0u}; float rstd2;
        const int srow = tid >> 2, sq = tid & 3;
        {
            const int tile = srow >> 5, rr = srow & 31;
            rstd2 = __builtin_amdgcn_rsqf((SS[tile * 32 + rr] + SS[(4 + tile) * 32 + rr]) * (1.0f / DM) + EPS);
            const LAS float* ta = T + (tile * 32 + rr) * 33 + 8 * sq; const LAS float* tb = T + ((4 + tile) * 32 + rr) * 33 + 8 * sq;
            float v[8];
#pragma unroll
            for (int j = 0; j < 8; ++j) v[j] = (ta[j] + tb[j]) * rstd2 + rbv[j];
            float vk[4];
#pragma unroll
            for (int k = 0; k < 4; ++k) { float best = -INFINITY; int be = 8 * sq;
#pragma unroll
                for (int j = 0; j < 8; ++j) if (v[j] > best) { best = v[j]; be = 8 * sq + j; }
                { const float ob = att::dpp_f<0xB1>(best); const int oe = __builtin_amdgcn_update_dpp(0, be, 0xB1, 0xf, 0xf, true); if (ob > best || (ob == best && oe < be)) { best = ob; be = oe; } }
                { const float ob = att::dpp_f<0x4E>(best); const int oe = __builtin_amdgcn_update_dpp(0, be, 0x4E, 0xf, 0xf, true); if (ob > best || (ob == best && oe < be)) { best = ob; be = oe; } }
                ek[k] = be; vk[k] = best;
#pragma unroll
                for (int j = 0; j < 8; ++j) if (be == 8 * sq + j) v[j] = -INFINITY; }
            float den = 0.f;
#pragma unroll
            for (int k = 0; k < 4; ++k) { gk[k] = __expf(vk[k] - vk[0]); den += gk[k]; }
            const float rden = 1.0f / den;
#pragma unroll
            for (int k = 0; k < 4; ++k) { gk[k] *= rden; if (sq == 0) rk[k] = __hip_atomic_fetch_add(CNTL + ek[k], 1u, __ATOMIC_RELAXED, __HIP_MEMORY_SCOPE_WORKGROUP); }
        }
        __syncthreads();
        if (tid < 32) { const unsigned n = CNTL[tid]; CNTL[32 + tid] = n ? atomicAdd(ctl + CW_CNT + 64 * tid, n) : 0u; }
        __syncthreads();
        if (sq == 0) {
            const int tok = R0 + srow;
            RS2[tok] = rstd2;
#pragma unroll
            for (int k = 0; k < 4; ++k) { const int li = (int)(CNTL[32 + ek[k]] + rk[k]); LIST[(size_t)ek[k] * MTOK + li] = tok * 4 + k; GATES[tok * 4 + k] = gk[k]; POSI[tok * 4 + k] = (ek[k] << 15) | li; }
        }
        __syncthreads();
    }
}

constexpr int MOE_MAXS = 24;
struct MoeSched { LAS int* TB; LAS int* TE; LAS int* TAB; int tlo, thi, mt, pn, mpb; };
constexpr int MOE_CNTS = 25600 / 4;
__device__ __forceinline__ void moe_prefix(Frame& F, LAS int* TB) {
    const unsigned* ctl = (const unsigned*)(F.ws + WS_CTL);
    if (F.tid < 64) {
        const int e = F.tid; const int c = (e < NEXP) ? (int)__hip_atomic_load(ctl + CW_CNT + 64 * (e & 31), __ATOMIC_RELAXED, __HIP_MEMORY_SCOPE_AGENT) : 0;
        const int tiles = (c + 255) >> 8; int incl = tiles;
#pragma unroll
        for (int o = 1; o < 32; o <<= 1) { const int y = __shfl_up(incl, o); if (e >= o) incl += y; }
        if (e < NEXP) { TB[e] = incl - tiles; TB[MOE_CNTS + e] = c; }
        if (e == NEXP - 1) TB[NEXP] = incl;
    }
    __syncthreads();
}
template <int NPN, bool TABLE>
__device__ __forceinline__ MoeSched moe_setup(Frame& F) {
    MoeSched M;
    M.TB = (LAS int*)(F.lds + LDS_AUX); M.TE = M.TB + 40; M.TAB = M.TB + 64;
    moe_prefix(F, M.TB);
    const int T = __builtin_amdgcn_readfirstlane(M.TB[NEXP]), x = F.vcu >> 5, i = F.vcu & 31;
    M.mpb = 32 / NPN; M.mt = __builtin_amdgcn_readfirstlane(i / NPN); M.pn = __builtin_amdgcn_readfirstlane(i % NPN);
    M.tlo = __builtin_amdgcn_readfirstlane((x * T) >> 3); M.thi = __builtin_amdgcn_readfirstlane(((x + 1) * T) >> 3);
    const int* LIST = (const int*)(F.ws + WS_LIST); const float* RS2 = (const float*)(F.ws + WS_RSTD2);
    if (F.tid < MOE_MAXS) { const int t = M.tlo + F.tid * M.mpb + M.mt; int e = 0; if (t < M.thi) { for (int q = 0; q < NEXP; ++q) if (M.TB[q + 1] <= t) e = q + 1; } M.TE[F.tid] = e; }
    __syncthreads();
    if (TABLE) {
        constexpr int NIT = MOE_MAXS * 256 / NTHR;
        int lst[NIT];
#pragma unroll
        for (int it = 0; it < NIT; ++it) { const int idx = F.tid + NTHR * it, s = idx >> 8, r = idx & 255, t = M.tlo + s * M.mpb + M.mt;
            const int e = M.TE[s]; const int li = (t - M.TB[e]) * 256 + r;
            lst[it] = (t < M.thi && li < M.TB[MOE_CNTS + e]) ? LIST[(size_t)e * MTOK + li] : -1; }
        float rsv[NIT];
#pragma unroll
        for (int it = 0; it < NIT; ++it) rsv[it] = (lst[it] >= 0) ? RS2[lst[it] >> 2] : 0.f;
#pragma unroll
        for (int it = 0; it < NIT; ++it) M.TAB[F.tid + NTHR * it] = (lst[it] >= 0) ? ((lst[it] >> 2) | (int)((f2bf(rsv[it]) & 0x7fffu) << 15)) : 0;
    }
    __syncthreads();
    return M;
}
struct ProbMoe1 {
    static constexpr bool FP8 = true;
    MoeSched M; const char* A; const char* W; const float* b1; unsigned char* act; LAS unsigned char* lds;
    __device__ __forceinline__ bool next(int s, pg8::Unit& u) const { const int t = __builtin_amdgcn_readfirstlane(M.tlo + s * M.mpb + M.mt); if (s >= MOE_MAXS || t >= __builtin_amdgcn_readfirstlane(M.thi)) return false; u.pn = M.pn; u.pm = t; u.tt = s;
        u.e = __builtin_amdgcn_readfirstlane(M.TE[s]); return true; }
    __device__ __forceinline__ const char* abase(const pg8::Unit&) const { return A; }
    __device__ __forceinline__ void aoff(const pg8::Unit& u, const int (&R)[2], const int (&C)[2], unsigned (&vo)[2][2]) const {
#pragma unroll
        for (int h = 0; h < 2; ++h)
#pragma unroll
            for (int i = 0; i < 2; ++i) vo[h][i] = (unsigned)((M.TAB[u.tt * 256 + h * 128 + R[i]] & 0x7fff) * DM + C[i] * 2);
    }
    __device__ __forceinline__ const char* bptr(const pg8::Unit& u) const { return W + ((size_t)u.e * 2 * DFF + (size_t)u.pn * 256) * DM; }
    __device__ __forceinline__ float pre(const pg8::Unit& u, int tid) const { const int t = tid & 255; return ld_untracked(b1 + (size_t)u.e * 2 * DFF + u.pn * 128 + (t & 127) + ((t >> 7) ? DFF : 0)); }
    __device__ __forceinline__ void epi(f32x4 (&acc)[2][2][4][2], const pg8::Unit& u, int wr, int wc, int fr, int fq, float pf) const {
        asm volatile("s_nop 15\n\ts_nop 7" ::: "memory");
        const int rl0 = wr * 64 + fr, cj = u.pn * 128 + wc * 32 + 8 * fq;
        LAS float* pfx = (LAS float*)(lds + LDS_PFX);
        if (wr == 0) pfx[wc * 64 + fq * 16 + fr] = pf;
        asm volatile("s_waitcnt lgkmcnt(0)" ::: "memory"); __builtin_amdgcn_s_barrier(); asm volatile("" ::: "memory");
        const LAS float* bg = pfx + wc * 32 + 8 * fq; const LAS float* bu = bg + 128;
        constexpr float CS = -1.702f * LOG2E, KA = ASCALE / CS;
        f32x4 bg0 = *(const LAS f32x4*)bg, bg1 = *(const LAS f32x4*)(bg + 4); const f32x4 bu0 = *(const LAS f32x4*)bu, bu1 = *(const LAS f32x4*)(bu + 4);
        bg0 = bg0 * CS; bg1 = bg1 * CS;
#pragma unroll
        for (int ai = 0; ai < 2; ++ai)
#pragma unroll
            for (int m = 0; m < 4; ++m) { const int rl = rl0 + ai * 128 + m * 16; const float rs = bf2f((unsigned)M.TAB[u.tt * 256 + rl] >> 15) * (1.0f / WSCALE), rsc = rs * CS;
                float a[8];
#pragma unroll
                for (int n = 0; n < 2; ++n)
#pragma unroll
                    for (int jp = 0; jp < 2; ++jp) {
                        const f32x2 ag = {acc[ai][0][m][n][2 * jp], acc[ai][0][m][n][2 * jp + 1]}, au = {acc[ai][1][m][n][2 * jp], acc[ai][1][m][n][2 * jp + 1]};
                        const f32x2 bgp = n ? (f32x2){bg1[2 * jp], bg1[2 * jp + 1]} : (f32x2){bg0[2 * jp], bg0[2 * jp + 1]};
                        const f32x2 bup = n ? (f32x2){bu1[2 * jp], bu1[2 * jp + 1]} : (f32x2){bu0[2 * jp], bu0[2 * jp + 1]};
                        const f32x2 z = ag * (f32x2){rsc, rsc} + bgp, hu = au * (f32x2){rs, rs} + bup;
                        const f32x2 zc = {fmaxf(z.x, 7.0f * CS), fmaxf(z.y, 7.0f * CS)};
                        const f32x2 up = {__builtin_amdgcn_fmed3f(hu.x, -7.0f, 7.0f), __builtin_amdgcn_fmed3f(hu.y, -7.0f, 7.0f)};
                        const f32x2 den = (f32x2){__builtin_amdgcn_exp2f(zc.x), __builtin_amdgcn_exp2f(zc.y)} + (f32x2){1.0f, 1.0f};
                        const f32x2 sg = {__builtin_amdgcn_rcpf(den.x), __builtin_amdgcn_rcpf(den.y)};
                        const f32x2 r = (zc * sg) * (up * (f32x2){KA, KA} + (f32x2){KA, KA});
                        a[4 * n + 2 * jp] = r.x; a[4 * n + 2 * jp + 1] = r.y; }
                u32x2 w; w.x = pack_fp8x4(a[0], a[1], a[2], a[3]); w.y = pack_fp8x4(a[4], a[5], a[6], a[7]);
                *(u32x2*)(act + ((size_t)u.pm * 256 + rl) * DFF + cj) = w; }
    }
};
struct ProbMoe2 {
    static constexpr bool FP8 = true;
    MoeSched M; const char* A; const char* W; const float* b2; unsigned char* ys; LAS unsigned char* lds;
    __device__ __forceinline__ bool next(int s, pg8::Unit& u) const { const int t = __builtin_amdgcn_readfirstlane(M.tlo + s * M.mpb + M.mt); if (s >= MOE_MAXS || t >= __builtin_amdgcn_readfirstlane(M.thi)) return false; u.pn = M.pn; u.pm = t; u.tt = s;
        u.e = __builtin_amdgcn_readfirstlane(M.TE[s]); return true; }
    __device__ __forceinline__ const char* abase(const pg8::Unit& u) const { return A + (size_t)u.pm * 256 * DFF; }
    __device__ __forceinline__ void aoff(const pg8::Unit& u, const int (&R)[2], const int (&C)[2], unsigned (&vo)[2][2]) const {
#pragma unroll
        for (int h = 0; h < 2; ++h)
#pragma unroll
            for (int i = 0; i < 2; ++i) vo[h][i] = (unsigned)((h * 128 + R[i]) * DFF + C[i] * 2);
    }
    __device__ __forceinline__ const char* bptr(const pg8::Unit& u) const { return W + ((size_t)u.e * DM + (size_t)u.pn * 256) * DFF; }
    __device__ __forceinline__ float pre(const pg8::Unit& u, int tid) const { return ld_untracked(b2 + (size_t)u.e * DM + u.pn * 256 + (tid & 255)); }
    __device__ __forceinline__ void epi(f32x4 (&acc)[2][2][4][2], const pg8::Unit& u, int wr, int wc, int fr, int fq, float pf) const {
        asm volatile("s_nop 15\n\ts_nop 7" ::: "memory");
        const int rl0 = wr * 64 + fr, col0 = u.pn * 256 + wc * 32 + 8 * fq;
        LAS float* pfx = (LAS float*)(lds + LDS_PFX);
        if (wr == 0) pfx[wc * 64 + fq * 16 + fr] = pf;
        asm volatile("s_waitcnt lgkmcnt(0)" ::: "memory"); __builtin_amdgcn_s_barrier(); asm volatile("" ::: "memory");
        const LAS float* bp = pfx + wc * 32 + 8 * fq;
        f32x4 bv[2][2];
#pragma unroll
        for (int bj = 0; bj < 2; ++bj) { bv[bj][0] = *(const LAS f32x4*)(bp + bj * 128) * YSCALE; bv[bj][1] = *(const LAS f32x4*)(bp + bj * 128 + 4) * YSCALE; }
        constexpr float sc = YSCALE / (WSCALE * ASCALE);
        char* tbase = (char*)ys + ((size_t)u.pm * 256) * DM + u.pn * 256;
        const int tid = (wr * 4 + wc) * 64 + fq * 16 + fr;
#pragma unroll
        for (int ai = 0; ai < 2; ++ai)
#pragma unroll
            for (int mh = 0; mh < 2; ++mh) { const int c = ai * 2 + mh; LAS unsigned char* buf = lds + ((c & 1) ? STG_BUF1 : STG_BUF0);
#pragma unroll
                for (int ml = 0; ml < 2; ++ml) { const int m = mh * 2 + ml, rl = ml * 32 + wr * 16 + fr;
#pragma unroll
                    for (int bj = 0; bj < 2; ++bj) { const f32x4 v0 = acc[ai][bj][m][0] * sc + bv[bj][0], v1 = acc[ai][bj][m][1] * sc + bv[bj][1];
                        u32x2 w; w.x = pack_fp8x4(v0[0], v0[1], v0[2], v0[3]); w.y = pack_fp8x4(v1[0], v1[1], v1[2], v1[3]);
                        const int slot = bj * 16 + wc * 4 + fq;
                        *(LAS u32x2*)(buf + rl * 256 + ((slot ^ ((rl & 7) << 1)) << 3)) = w; } }
                asm volatile("s_waitcnt lgkmcnt(0)" ::: "memory"); __builtin_amdgcn_s_barrier(); asm volatile("" ::: "memory");
#pragma unroll
                for (int j = 0; j < 2; ++j) { const int p = tid + 512 * j, r2 = p >> 4, pi = p & 15;
                    const u32x4 v = *(const LAS u32x4*)(buf + r2 * 256 + (((2 * pi) ^ ((r2 & 7) << 1)) << 3));
                    const int trow = ai * 128 + ((r2 >> 4) & 1) * 64 + (mh * 2 + (r2 >> 5)) * 16 + (r2 & 15);
                    *(u32x4*)(tbase + (size_t)trow * DM + pi * 16) = v; } }
    }
};
static_assert(256 + MOE_MAXS * 256 * 4 <= 32768 - 512, "MoE tables fit the AUX region");

__device__ __forceinline__ void p8_combine(Frame& F) {
    const int gw = F.vcu * NWAVES + F.wave, NGW = F.G * NWAVES;
    LAS int* TB = (LAS int*)(F.lds + LDS_AUX);
    moe_prefix(F, TB);
    const unsigned char* YS = F.ws + WS_YB; const int* POSI = (const int*)(F.ws + WS_POSI); const float* GATES = (const float*)(F.ws + WS_GATES);
    const bf16_t* X1H = (const bf16_t*)(F.ws + WS_X1H);
    for (int m = gw; m < MTOK; m += NGW) {
        f32x4* op = (f32x4*)(F.out + (size_t)m * DM) + F.lane;
        const u32x2* xp = (const u32x2*)(X1H + (size_t)m * DM) + F.lane;
        const int pv = POSI[m * 4 + (F.lane & 3)]; const float gv = GATES[m * 4 + (F.lane & 3)] * (1.0f / YSCALE);
        f32x4 v[4];
#pragma unroll
        for (int j = 0; j < 4; ++j) { const u32x2 w = xp[64 * j]; v[j].x = bf2f(w.x & 0xffffu); v[j].y = bf2f(w.x >> 16); v[j].z = bf2f(w.y & 0xffffu); v[j].w = bf2f(w.y >> 16); }
#pragma unroll
        for (int k = 0; k < 4; ++k) { const int p = __builtin_amdgcn_readlane(pv, k); const float g = __builtin_bit_cast(float, __builtin_amdgcn_readlane(__builtin_bit_cast(int, gv), k));
            const int pos = TB[p >> 15] * 256 + (p & 32767);
            const unsigned* yp = (const unsigned*)(YS + (size_t)pos * DM) + F.lane;
#pragma unroll
            for (int j = 0; j < 4; ++j) { const unsigned w = yp[64 * j]; const f32x2 lo = __builtin_amdgcn_cvt_pk_f32_fp8(w, false), hi2 = __builtin_amdgcn_cvt_pk_f32_fp8(w, true);
                v[j].x += g * lo.x; v[j].y += g * lo.y; v[j].z += g * hi2.x; v[j].w += g * hi2.y; } }
#pragma unroll
        for (int j = 0; j < 4; ++j) op[64 * j] = v[j];
    }
}

typedef GAS unsigned gu32;
#define XB_TMO      128
#define XB_XCNT(j)  (256  + 64 * (j))
#define XB_XSUB(j)  (1280 + 64 * (j))
#define XB_XGEN(j)  (2304 + 64 * (j))
#define XB_TOP      3328
#define XB_TOPGEN   3392
#define XCD_BAR_WORDS 3456
#define XB_SPIN_CAP (1u << 20)
__device__ __forceinline__ unsigned xb_ld(unsigned* p)              { return __hip_atomic_load(p, __ATOMIC_RELAXED, __HIP_MEMORY_SCOPE_AGENT); }
__device__ __forceinline__ unsigned xb_add(unsigned* p, unsigned v) { return __hip_atomic_fetch_add(p, v, __ATOMIC_RELAXED, __HIP_MEMORY_SCOPE_AGENT); }
__device__ __forceinline__ unsigned xb_xcc_id() { return (unsigned)__builtin_amdgcn_s_getreg((3 << 11) | 20) & 0xFu; }
#define XB_SPIN(cond, bar) do { unsigned _sp = 0; while (cond) { __builtin_amdgcn_s_sleep(1); \
    if ((++_sp & 255u) == 0u) { if (xb_ld(&(bar)[XB_TMO])) break; if (_sp > XB_SPIN_CAP) { atomicAdd(&(bar)[XB_TMO], 1u); break; } } } } while (0)
struct XcdBarrier { unsigned* bar; unsigned x; volatile LAS unsigned* st; };
__device__ __forceinline__ XcdBarrier xcd_barrier_post(unsigned* bar, volatile LAS unsigned* st) {
    XcdBarrier b; b.bar = bar; b.x = xb_xcc_id(); b.st = st;
    if (threadIdx.x == 0) (void)xb_add(&bar[XB_XCNT(b.x)], 1u);
    return b;
}
__device__ __forceinline__ void xcd_barrier_complete(unsigned* bar, unsigned x, unsigned& nloc, unsigned& nx) {
    const unsigned G = gridDim.x * gridDim.y * gridDim.z;
    unsigned sum, cnt, mine, sp = 0u;
    for (;;) {
        sum = 0u; cnt = 0u; mine = 0u;
#pragma unroll
        for (unsigned j = 0; j < 16; ++j) { const unsigned c = xb_ld(&bar[XB_XCNT(j)]); sum += c; cnt += (c > 0u) ? 1u : 0u; mine = (j == x) ? c : mine; }
        if (sum == G) break;
        __builtin_amdgcn_s_sleep(1);
        if ((++sp & 255u) == 0u) { if (xb_ld(&bar[XB_TMO])) break; if (sp > XB_SPIN_CAP) { atomicAdd(&bar[XB_TMO], 1u); break; } }
    }
    nloc = mine > 0u ? mine : 1u; nx = cnt > 0u ? cnt : 1u;
}
__device__ __forceinline__ void xcd_barrier(const XcdBarrier& b) {
    asm volatile("s_waitcnt vmcnt(0)" ::: "memory");
    __syncthreads();
    if (threadIdx.x == 0) {
        unsigned* bar = b.bar;
        __builtin_amdgcn_s_waitcnt(0);
        unsigned nloc = b.st[0], nx = b.st[1];
        if (nloc == 0u) { xcd_barrier_complete(bar, b.x, nloc, nx); b.st[0] = nloc; b.st[1] = nx; }
        const unsigned old = xb_add(&bar[XB_XSUB(b.x)], 1u);
        const unsigned gen = old / nloc;
        if (old + 1u == (gen + 1u) * nloc) {
            __builtin_amdgcn_fence(__ATOMIC_RELEASE, "agent");
            asm volatile("s_waitcnt vmcnt(0)" ::: "memory");
            const unsigned og = xb_add(&bar[XB_TOP], 1u);
            const unsigned tg = og / nx;
            if (og + 1u == (tg + 1u) * nx) xb_add(&bar[XB_TOPGEN], 1u);
            else XB_SPIN(xb_ld(&bar[XB_TOPGEN]) == tg, bar);
            __builtin_amdgcn_fence(__ATOMIC_ACQUIRE, "agent");
            xb_add(&bar[XB_XGEN(b.x)], 1u);
            asm volatile("s_waitcnt vmcnt(0)" ::: "memory");
        } else {
            XB_SPIN(xb_ld(&bar[XB_XGEN(b.x)]) == gen, bar);
            __builtin_amdgcn_fence(__ATOMIC_ACQUIRE, "agent");
            asm volatile("s_waitcnt vmcnt(0)" ::: "memory");
        }
    }
    __syncthreads();
}

struct Args { const float* in[25]; float* out; unsigned char* ws; int ph_lo, ph_hi; };
__global__ void __launch_bounds__(NTHR, 2) mk_fwd(Args args) {
    extern __shared__ __attribute__((aligned(16))) unsigned char lds_raw[];
    Frame F;
    F.lds = (LAS unsigned char*)lds_raw; F.ws = args.ws; F.out = args.out;
    F.kin = (karg_ptr_t)__builtin_amdgcn_kernarg_segment_ptr();
    F.tid = threadIdx.x; F.lane = F.tid & 63; F.wave = __builtin_amdgcn_readfirstlane(F.tid >> 6);
    F.G = gridDim.x; { const int bx = blockIdx.x; F.vcu = (F.G % 8 == 0) ? (bx % 8) * (F.G / 8) + bx / 8 : bx; }
    const int lo = args.ph_lo, hi = args.ph_hi;
    { volatile LAS unsigned* MISC = (volatile LAS unsigned*)(F.lds + LDS_MISC); if (F.tid < 64) MISC[F.tid] = 0u; }
    __syncthreads();
    XcdBarrier bar; bar.bar = (unsigned*)(F.ws + WS_CTL) + CW_BAR; bar.x = 0; bar.st = nullptr;
    if (hi - lo > 1) bar = xcd_barrier_post((unsigned*)(F.ws + WS_CTL) + CW_BAR, (volatile LAS unsigned*)(F.lds + LDS_MISC) + 8);
#define IN(k) (lo <= (k) && (k) < hi)
#define SEAM(k) do { if (IN(k) && ((k) == 2 ? IN(4) : IN((k) + 1))) xcd_barrier(bar); } while (0)
    if (IN(0)) { p0_prologue(F); }
    SEAM(0);
    if (IN(1)) {
        ProbInProj P; P.S.init(MTOK, DIN, F.G, (int)blockIdx.x); P.A = (const char*)(F.ws + WS_XB); P.Bt = (const char*)(F.ws + WS_WIN); P.rstd1 = (const float*)(F.ws + WS_RSTD1);
        P.dst0 = (bf16_t*)(F.ws + WS_XR); P.qg = F.in(10); P.kg = F.in(11); P.xs = (LAS float*)(F.lds + LDS_AUX); P.lds = F.lds;
        pg8::gemm_phase<decltype(P), true>(F.lds, P);
    }
    SEAM(1);
    if (IN(2)) { att::mixer_phase(F); }
    SEAM(2);
    if (IN(4)) {
        ProbOutProj P; P.S.init(MTOK, DM, F.G, (int)blockIdx.x); P.A = (const char*)(F.ws + WS_Y); P.Bt = (const char*)(F.ws + WS_WOUT); P.xb = (const bf16_t*)(F.ws + WS_XB); P.x1h = (bf16_t*)(F.ws + WS_X1H); P.x1q = F.ws + WS_X1B; P.lds = F.lds;
        pg8::gemm_phase<decltype(P), true>(F.lds, P);
    }
    SEAM(4);
    if (IN(5)) { p5_router(F); }
    SEAM(5);
    if (IN(6)) {
        ProbMoe1 P; P.M = moe_setup<8, true>(F); P.A = (const char*)(F.ws + WS_X1B); P.W = (const char*)(F.ws + WS_W1); P.b1 = F.in(22); P.act = F.ws + WS_ACT; P.lds = F.lds;
        pg8::gemm_phase<decltype(P), true>(F.lds, P);
    }
    SEAM(6);
    if (IN(7)) {
        ProbMoe2 P; P.M = moe_setup<4, false>(F); P.A = (const char*)(F.ws + WS_ACT); P.W = (const char*)(F.ws + WS_W2); P.b2 = F.in(24); P.ys = F.ws + WS_YB; P.lds = F.lds;
        pg8::gemm_phase<decltype(P), true>(F.lds, P);
    }
    SEAM(7);
    if (IN(8)) { p8_combine(F); }
#undef IN
#undef SEAM
}

extern "C" void kernel_launch(void* const* d_in, const int* in_sizes, int n_in, void* d_out, int out_size, void* d_ws, size_t ws_size, hipStream_t stream) {
    static int grid = 0;
    if (grid == 0) {
        if (n_in != 25 || in_sizes[0] != MTOK * DM || out_size != MTOK * DM || ws_size < WS_END) {
            fprintf(stderr, "kernel_launch: unexpected problem (n_in %d, in0 %d, out %d, ws %zu); nothing launched\n", n_in, n_in > 0 ? in_sizes[0] : -1, out_size, ws_size); grid = -1; return; }
        int dev = 0, cus = 0, per_cu = 0;
        if (hipGetDevice(&dev) != hipSuccess || hipDeviceGetAttribute(&cus, hipDeviceAttributeMultiprocessorCount, dev) != hipSuccess) { grid = -1; return; }
        if (hipFuncSetAttribute((const void*)mk_fwd, hipFuncAttributeMaxDynamicSharedMemorySize, LDS_BYTES) != hipSuccess) { fprintf(stderr, "kernel_launch: hipFuncSetAttribute failed\n"); grid = -1; return; }
        if (hipOccupancyMaxActiveBlocksPerMultiprocessor(&per_cu, (const void*)mk_fwd, NTHR, LDS_BYTES) != hipSuccess || per_cu < 1) { fprintf(stderr, "kernel_launch: occupancy query says %d blocks/CU for %d B of LDS: the grid barrier needs every workgroup resident; nothing launched\n", per_cu, LDS_BYTES); (void)hipGetLastError(); grid = -1; return; }
        (void)hipGetLastError();
        grid = cus;
        if (grid != 256) { fprintf(stderr, "kernel_launch: built for a 256-CU device (got %d)\n", cus); grid = -1; return; }
    }
    if (grid < 0) return;
    (void)hipMemsetAsync((char*)d_ws + WS_CTL, 0, CTL_BYTES, stream);
    Args a{};
    for (int i = 0; i < 25; ++i) a.in[i] = (const float*)d_in[i];
    a.out = (float*)d_out; a.ws = (unsigned char*)d_ws;
#if MK_N_LAUNCHES == 1
    a.ph_lo = 0; a.ph_hi = NPHASE;
    hipLaunchKernelGGL(mk_fwd, dim3(grid), dim3(NTHR), LDS_BYTES, stream, a);
#else
    for (int p = 0; p < NPHASE; ++p) { a.ph_lo = p; a.ph_hi = p + 1; hipLaunchKernelGGL(mk_fwd, dim3(grid), dim3(NTHR), LDS_BYTES, stream, a); }
#endif
}
```

```cpp
#include <hip/hip_runtime.h>
#include <cstdio>
#include <cstdint>

#define LAS __attribute__((address_space(3)))
#define GAS __attribute__((address_space(1)))
typedef unsigned short bf16_t;
typedef short bf16x8 __attribute__((ext_vector_type(8)));
typedef short s16x4 __attribute__((ext_vector_type(4)));
typedef float f32x4 __attribute__((ext_vector_type(4)));
typedef float f32x2 __attribute__((ext_vector_type(2)));
typedef float f32x16 __attribute__((ext_vector_type(16)));
typedef unsigned u32x4 __attribute__((ext_vector_type(4)));
typedef unsigned u32x2 __attribute__((ext_vector_type(2)));

#ifndef MK_N_LAUNCHES
#define MK_N_LAUNCHES 1
#endif
constexpr int NPHASE = 9;

constexpr int NB = 16, SEQ = 2048, DM = 1024, MTOK = NB * SEQ;
constexpr int DIN = 2560, DRNN = 512, NEXP = 32, TOPK = 4, DFF = 1024, NASG = MTOK * TOPK;
constexpr float EPS = 1e-5f;
constexpr float LOG2E = 1.4426950408889634f;
constexpr int NWAVES = 8, NTHR = 512;
constexpr float YSCALE = 8.0f;
constexpr float WSCALE = 32.0f, ASCALE = 4.0f;

constexpr size_t MiB = (size_t)1 << 20;
constexpr size_t WS_CTL = 0, CTL_BYTES = 64 * 1024;
constexpr size_t WS_WIN = 2 * MiB;
constexpr size_t WS_WOUT = 8 * MiB;
constexpr size_t WS_WRH = 10 * MiB, WS_WRL = WS_WRH + 65536;
constexpr size_t WS_WAT = WS_WRH + 2 * 65536, WS_WXT = WS_WAT + 65536;
constexpr size_t WS_RSTD1 = 11 * MiB, WS_RSTD2 = WS_RSTD1 + 131072 * 2;
constexpr size_t WS_GATES = 12 * MiB;
constexpr size_t WS_POSI = 13 * MiB;
constexpr size_t WS_LIST = 16 * MiB;
constexpr size_t WS_W1 = 32 * MiB;
constexpr size_t WS_W2 = 160 * MiB;
constexpr size_t WS_XB = 224 * MiB;
constexpr size_t WS_XR = 288 * MiB, WS_GG = 320 * MiB, WS_Q = 352 * MiB, WS_K = 384 * MiB, WS_V = 416 * MiB;
constexpr size_t WS_Y = 448 * MiB;
constexpr size_t WS_X1B = 512 * MiB;
constexpr size_t WS_X1H = 712 * MiB;
constexpr size_t WS_ACT = 576 * MiB;
constexpr size_t WS_YB = 224 * MiB;
constexpr size_t WS_END = 848 * MiB;
constexpr int MAXTILES = NASG / 256 + NEXP;
constexpr int CW_TMO = 0, CW_QUEUE = 512, CW_CNT = 1024  , CW_BAR = 8192;

constexpr int RING_BYTES = 131072;
constexpr int LDS_AUX = RING_BYTES;
constexpr int LDS_MISC = RING_BYTES + 32768 - 256;
constexpr int LDS_BYTES = 163840;

__device__ __forceinline__ unsigned f2bf(float f) { unsigned u = __builtin_bit_cast(unsigned, f); return (u + 0x7fffu + ((u >> 16) & 1u)) >> 16; }
__device__ __forceinline__ float bf2f(unsigned h) { return __builtin_bit_cast(float, h << 16); }
typedef __bf16 bf16x2_t __attribute__((ext_vector_type(2)));
__device__ __forceinline__ unsigned cvt_pk_bf16(float lo, float hi) { f32x2 v = {lo, hi}; bf16x2_t b = __builtin_convertvector(v, bf16x2_t); return __builtin_bit_cast(unsigned, b); }
__device__ __forceinline__ unsigned pk2(float lo, float hi) { return cvt_pk_bf16(lo, hi); }
__device__ __forceinline__ void swap_rows16(unsigned& a, unsigned& b) { asm("s_nop 1\n\tv_permlane16_swap_b32 %0, %1" : "+v"(a), "+v"(b)); }
__device__ __forceinline__ void swap_rows32(unsigned& a, unsigned& b) { asm("s_nop 1\n\tv_permlane32_swap_b32 %0, %1" : "+v"(a), "+v"(b)); }
__device__ __forceinline__ float add_xor16(float v) { unsigned a = __builtin_bit_cast(unsigned, v), b = a; swap_rows16(a, b); return __builtin_bit_cast(float, a) + __builtin_bit_cast(float, b); }
__device__ __forceinline__ float add_xor32(float v) { unsigned a = __builtin_bit_cast(unsigned, v), b = a; swap_rows32(a, b); return __builtin_bit_cast(float, a) + __builtin_bit_cast(float, b); }
__device__ __forceinline__ float wave_sum(float v) {
#pragma unroll
    for (int o = 1; o < 64; o <<= 1) v += __shfl_xor(v, o);
    return v;
}
__device__ __forceinline__ float fast_sigmoid(float x) { return __builtin_amdgcn_rcpf(1.0f + __builtin_amdgcn_exp2f(-x * LOG2E)); }
__device__ __forceinline__ f32x4 gelu_tanh4(f32x4 x) {
    constexpr float A = -2.0f * 0.7978845608028654f * LOG2E, B = A * 0.044715f;
    const f32x4 t = (x * x * B + A) * x;
    const f32x4 d = (f32x4){__builtin_amdgcn_exp2f(t[0]), __builtin_amdgcn_exp2f(t[1]), __builtin_amdgcn_exp2f(t[2]), __builtin_amdgcn_exp2f(t[3])} + 1.0f;
    return x * (f32x4){__builtin_amdgcn_rcpf(d[0]), __builtin_amdgcn_rcpf(d[1]), __builtin_amdgcn_rcpf(d[2]), __builtin_amdgcn_rcpf(d[3])};
}
__device__ __forceinline__ unsigned pack_fp8x4(float a, float b, float c, float d) { unsigned t = 0; t = __builtin_amdgcn_cvt_pk_fp8_f32(a, b, t, false); t = __builtin_amdgcn_cvt_pk_fp8_f32(c, d, t, true); return t; }
#define LDS_WAIT() asm volatile("s_waitcnt lgkmcnt(0)" ::: "memory")
#define LDS_BARRIER() do { asm volatile("s_waitcnt lgkmcnt(0)" ::: "memory"); __builtin_amdgcn_s_barrier(); asm volatile("" ::: "memory"); } while (0)
__device__ __forceinline__ float ld_untracked(const float* p) { float v; asm volatile("global_load_dword %0, %1, off" : "=v"(v) : "v"(p) : "memory"); return v; }
#define VM_WAIT() asm volatile("s_waitcnt vmcnt(0)" ::: "memory")

typedef const float* const volatile __attribute__((address_space(4))) * karg_ptr_t;
struct Frame {
    LAS unsigned char* lds;
    unsigned char* ws;
    int tid, lane, wave, vcu, G;
    karg_ptr_t kin;
    float* out;
    __device__ __forceinline__ const float* in(int i) const { return kin[i]; }
};

namespace pg8 {
constexpr int BM = 256, BK = 64, HALF = 128, HTB = HALF * BK * 2, KD = 1024, NT = KD / BK;
__device__ __forceinline__ int lds_byte(int r, int c) { const int st = (r >> 4) * 2 + (c >> 5), rr = r & 15, cc = c & 31, ob = rr * 64 + cc * 2; return st * 1024 + (ob ^ (((ob >> 9) & 1) << 5)); }
__device__ __forceinline__ void stage_rc(int b, int& R, int& C) { const int st = b / 1024, sb = b % 1024, swz = sb ^ (((sb >> 9) & 1) << 5); R = (st >> 1) * 16 + swz / 64; C = (st & 1) * 32 + (swz % 64) / 2; }
__device__ __forceinline__ int perm32(int rho) { const int n = rho >> 4, i = rho & 15; return 8 * (i >> 2) + 4 * n + (i & 3); }
struct Unit { int pm, pn, e, tt; };

typedef int v4i_t __attribute__((ext_vector_type(4)));
typedef int v8i_t __attribute__((ext_vector_type(8)));
__device__ __forceinline__ v8i_t cat8(bf16x8 a, bf16x8 b) { return __builtin_shufflevector(__builtin_bit_cast(v4i_t, a), __builtin_bit_cast(v4i_t, b), 0, 1, 2, 3, 4, 5, 6, 7); }
template <class Prob, bool ALIGN_EPI>
__device__ __forceinline__ void gemm_phase(LAS unsigned char* lds, const Prob& P) {
    const int tid = threadIdx.x, wid = __builtin_amdgcn_readfirstlane(tid >> 6), lane = tid & 63, wr = wid >> 2, wc = wid & 3, fr = lane & 15, fq = lane >> 4;
    constexpr int K = Prob::FP8 ? KD / 2 : KD, nt = Prob::FP8 ? NT / 2 : NT;
    unsigned voffB[2];
#pragma unroll
    for (int i = 0; i < 2; ++i) { int R_, C_; stage_rc(tid * 16 + i * 8192, R_, C_); const int Rb = (R_ & ~31) + perm32(R_ & 31); voffB[i] = (unsigned)(Rb * K + C_) * 2u; }
    constexpr size_t kstep = (size_t)(BK * 2);
    constexpr size_t hstepB = (size_t)HALF * K * 2;
    const unsigned ldsw = (unsigned)wid * 1024u;
    const int aoff = lds_byte(wr * 64 + fr, fq * 8), boff = lds_byte(wc * 32 + fr, fq * 8);
#define PG8_SA(b, h) (((b) * 2 + (h)) * HTB)
#define PG8_SB(b, h) ((4 + (b) * 2 + (h)) * HTB)
#define PG8_STAGE(bufoff, gbase, voff) do { _Pragma("unroll") for (int _i = 0; _i < 2; ++_i) \
        __builtin_amdgcn_global_load_lds((const unsigned*)((const char*)(gbase) + (voff)[_i]), (LAS unsigned*)(lds + (bufoff) + ldsw + _i * 8192), 16, 0, 0); } while (0)
#define PG8_RD(off) (*(const LAS bf16x8*)(lds + (off)))
#define PG8_LDA(dst, b, h) do { _Pragma("unroll") for (int m = 0; m < 4; ++m) { if constexpr (Prob::FP8) dst##8[m] = cat8(PG8_RD(PG8_SA(b, h) + aoff + m * 2048), PG8_RD(PG8_SA(b, h) + aoff + m * 2048 + 1024)); \
        else { _Pragma("unroll") for (int k = 0; k < 2; ++k) dst[m][k] = PG8_RD(PG8_SA(b, h) + aoff + m * 2048 + k * 1024); } } } while (0)
#define PG8_LDB(dst, b, h) do { _Pragma("unroll") for (int n = 0; n < 2; ++n) { if constexpr (Prob::FP8) dst##8[n] = cat8(PG8_RD(PG8_SB(b, h) + boff + n * 2048), PG8_RD(PG8_SB(b, h) + boff + n * 2048 + 1024)); \
        else { _Pragma("unroll") for (int k = 0; k < 2; ++k) dst[n][k] = PG8_RD(PG8_SB(b, h) + boff + n * 2048 + k * 1024); } } } while (0)
#define PG8_MMA(ai, bj, At, Bt) do { __builtin_amdgcn_s_setprio(1); _Pragma("unroll") for (int m = 0; m < 4; ++m) _Pragma("unroll") for (int n = 0; n < 2; ++n) { \
        if constexpr (Prob::FP8) asm volatile("s_nop 1\n\tv_mfma_f32_16x16x128_f8f6f4 %0, %1, %2, %0" : "+v"(acc[ai][bj][m][n]) : "v"(Bt##8[n]), "v"(At##8[m])); \
        else { _Pragma("unroll") for (int k = 0; k < 2; ++k) acc[ai][bj][m][n] = __builtin_amdgcn_mfma_f32_16x16x32_bf16(Bt[n][k], At[m][k], acc[ai][bj][m][n], 0, 0, 0); } } \
        __builtin_amdgcn_s_setprio(0); } while (0)
#define PG8_WAIT_V(n) asm volatile("s_waitcnt vmcnt(" #n ")" ::: "memory")
#define PG8_WAIT_L(n) asm volatile("s_waitcnt lgkmcnt(" #n ")" ::: "memory")
#define PG8_BAR __builtin_amdgcn_s_barrier()
#define PG8_SCHED __builtin_amdgcn_sched_barrier(0)
    Unit cur, nxt; int ui = 0;
    if (!P.next(0, cur)) return;
    f32x4 acc[2][2][4][2];
#pragma unroll
    for (int a = 0; a < 2; ++a)
#pragma unroll
        for (int b = 0; b < 2; ++b)
#pragma unroll
            for (int m = 0; m < 4; ++m)
#pragma unroll
                for (int n = 0; n < 2; ++n) acc[a][b][m][n] = (f32x4){0.f, 0.f, 0.f, 0.f};
    bf16x8 At[4][2], B0[2][2], B1[2][2]; v8i_t At8[4], B08[2], B18[2]; (void)At; (void)B0; (void)B1; (void)At8; (void)B08; (void)B18;
    unsigned vo[2][2];
    { int R[2], C[2]; stage_rc(tid * 16, R[0], C[0]); stage_rc(tid * 16 + 8192, R[1], C[1]); P.aoff(cur, R, C, vo); }
    const char* cA = P.abase(cur);
    const char* cB = P.bptr(cur);
    float pfc = P.pre(cur, tid), pfn = 0.f;
    PG8_STAGE(PG8_SB(0, 0), cB, voffB); PG8_STAGE(PG8_SB(0, 1), cB + hstepB, voffB); PG8_STAGE(PG8_SA(0, 0), cA, vo[0]); PG8_STAGE(PG8_SA(0, 1), cA, vo[1]);
    if (wr == 1) PG8_BAR;
    PG8_WAIT_V(2); PG8_BAR;
    PG8_STAGE(PG8_SB(1, 0), cB + kstep, voffB); PG8_STAGE(PG8_SA(1, 0), cA + kstep, vo[0]); PG8_STAGE(PG8_SB(1, 1), cB + hstepB + kstep, voffB);
    PG8_WAIT_V(6); PG8_BAR;
    for (;;) {
        const bool has_next = P.next(ui + 1, nxt);
        const char* nB = has_next ? P.bptr(nxt) : cB;
        const char* nA = has_next ? P.abase(nxt) : cA;
#pragma nounroll
        for (int t = 0; t < nt; t += 2) {
            const bool last = (t == nt - 2);
            const char* a1 = cA + (size_t)(t + 1) * kstep;
            const char* a2 = last ? nA : cA + (size_t)(t + 2) * kstep; const char* b2 = last ? nB : cB + (size_t)(t + 2) * kstep;
            const char* a3 = a2 + kstep; const char* b3 = b2 + kstep;
            unsigned w2[2][2];
#pragma unroll
            for (int h = 0; h < 2; ++h)
#pragma unroll
                for (int i = 0; i < 2; ++i) w2[h][i] = vo[h][i];
            if (last && has_next) { int R[2], C[2]; stage_rc(tid * 16, R[0], C[0]); stage_rc(tid * 16 + 8192, R[1], C[1]); P.aoff(nxt, R, C, w2); pfn = P.pre(nxt, tid); }
            PG8_LDB(B0, 0, 0); PG8_LDB(B1, 0, 1); PG8_SCHED; PG8_LDA(At, 0, 0); PG8_STAGE(PG8_SA(1, 1), a1, vo[1]);
            PG8_WAIT_V(8); PG8_WAIT_L(0); PG8_BAR; PG8_MMA(0, 0, At, B0); PG8_MMA(0, 1, At, B1); PG8_BAR; PG8_SCHED;
            PG8_LDA(At, 0, 1); PG8_STAGE(PG8_SB(0, 0), b2, voffB); PG8_STAGE(PG8_SB(0, 1), b2 + hstepB, voffB); PG8_STAGE(PG8_SA(0, 0), a2, w2[0]);
            PG8_WAIT_V(8); PG8_WAIT_L(0); PG8_BAR; PG8_MMA(1, 0, At, B0); PG8_MMA(1, 1, At, B1); PG8_BAR; PG8_SCHED;
            PG8_LDB(B0, 1, 0); PG8_LDB(B1, 1, 1); PG8_SCHED; PG8_LDA(At, 1, 0); PG8_STAGE(PG8_SA(0, 1), a2, w2[1]);
            PG8_WAIT_V(8); PG8_WAIT_L(0); PG8_BAR; PG8_MMA(0, 0, At, B0); PG8_MMA(0, 1, At, B1); PG8_BAR; PG8_SCHED;
            PG8_LDA(At, 1, 1); PG8_STAGE(PG8_SB(1, 0), b3, voffB); PG8_STAGE(PG8_SB(1, 1), b3 + hstepB, voffB); PG8_STAGE(PG8_SA(1, 0), a3, w2[0]);
            PG8_WAIT_V(8); PG8_WAIT_L(0); PG8_BAR; PG8_MMA(1, 0, At, B0); PG8_MMA(1, 1, At, B1); PG8_BAR; PG8_SCHED;
        }
        if constexpr (ALIGN_EPI) { if (wr == 0) PG8_BAR; }
        { int fr_ = fr, fq_ = fq; asm volatile("" : "+v"(fr_), "+v"(fq_)); P.epi(acc, cur, wr, wc, fr_, fq_, pfc); }
        if (!has_next) break;
#pragma unroll
        for (int a = 0; a < 2; ++a)
#pragma unroll
            for (int b = 0; b < 2; ++b)
#pragma unroll
                for (int m = 0; m < 4; ++m)
#pragma unroll
                    for (int n = 0; n < 2; ++n) acc[a][b][m][n] = (f32x4){0.f, 0.f, 0.f, 0.f};
        cur = nxt; cB = nB; cA = nA; ++ui; pfc = pfn;
        { int R[2], C[2]; stage_rc(tid * 16, R[0], C[0]); stage_rc(tid * 16 + 8192, R[1], C[1]); P.aoff(cur, R, C, vo); }
        if constexpr (ALIGN_EPI) { if (wr == 1) PG8_BAR; }
    }
    PG8_WAIT_V(0);
    if constexpr (!ALIGN_EPI) { if (wr == 0) PG8_BAR; }
    PG8_BAR;
#undef PG8_SA
#undef PG8_SB
#undef PG8_STAGE
#undef PG8_LDA
#undef PG8_RD
#undef PG8_LDB
#undef PG8_MMA
#undef PG8_SCHED
}
struct StaticOrder {
    int nM, nN, nwg, G, c;
    __device__ void init(int M, int N, int G_, int c_) { nM = M / BM; nN = N / BM; nwg = nM * nN; G = G_; c = c_; }
    __device__ bool next(int i, int& pm, int& pn) const {
        const long L = (long)i * G + c; if (L >= nwg) return false;
        int wgid = (int)L; { const int q = nwg / 8, r = nwg % 8, xcd = wgid % 8, off = wgid / 8; wgid = (xcd < r ? xcd * (q + 1) : r * (q + 1) + (xcd - r) * q) + off; }
        const int nig = 8 * nN, gid = wgid / nig, fm = gid * 8, gsz = (nM - fm) < 8 ? (nM - fm) : 8;
        pm = fm + ((wgid % nig) % gsz); pn = (wgid % nig) / gsz; return true;
    }
};
}

__device__ __forceinline__ void p0_transpose_item(const float* W, int K, int N, bf16_t* WT, int out_row0, const float* g, LAS float* scr, int kb, int nb, int lane) {
    const int k0 = 64 * kb, n0 = 32 * nb;
#pragma unroll
    for (int i = 0; i < 8; ++i) { const int kk = 8 * i + (lane >> 3), c4 = lane & 7;
        *(LAS f32x4*)(scr + kk * 36 + ((4 * c4 + 4 * (kk >> 3)) & 31)) = __builtin_nontemporal_load((const f32x4*)(W + (size_t)(k0 + kk) * N + n0 + 4 * c4)); }
    LDS_WAIT(); asm volatile("" ::: "memory");
    const int c = lane & 7;
    float gv[8];
#pragma unroll
    for (int q = 0; q < 8; ++q) gv[q] = g ? g[k0 + 8 * c + q] : 1.0f;
#pragma unroll
    for (int j = 0; j < 4; ++j) { const int n = (lane >> 3) + 8 * j; const LAS float* s = scr + (8 * c) * 36 + ((n + 4 * c) & 31);
        u32x4 o; o.x = pk2(s[0 * 36] * gv[0], s[1 * 36] * gv[1]); o.y = pk2(s[2 * 36] * gv[2], s[3 * 36] * gv[3]); o.z = pk2(s[4 * 36] * gv[4], s[5 * 36] * gv[5]); o.w = pk2(s[6 * 36] * gv[6], s[7 * 36] * gv[7]);
        *(u32x4*)(WT + (size_t)(out_row0 + n) * K + k0 + 8 * c) = o; }
    LDS_WAIT(); asm volatile("" ::: "memory");
}
__device__ __forceinline__ void p0_prologue(Frame& F) {
    LAS float* scr = (LAS float*)(F.lds + F.wave * 16384);
    const int gw = F.vcu * NWAVES + F.wave, NGW = F.G * NWAVES;
    const float* x = F.in(0); const float* g1 = F.in(1); const float* w_in = F.in(2); const float* w_out = F.in(17); const float* g2 = F.in(18);
    bf16_t* WIN = (bf16_t*)(F.ws + WS_WIN); bf16_t* WOUT = (bf16_t*)(F.ws + WS_WOUT);
    constexpr int I_IN = 16 * 80, I_OUT = 16 * 32;
    constexpr int NITEMS = I_IN + I_OUT;
    for (int it = gw; it < NITEMS; it += NGW) {
        int r = it;
        if (r < I_IN) { const int kb = r / 80, nb = r % 80; p0_transpose_item(w_in, DM, DIN, WIN, 32 * nb, g1, scr, kb, nb, F.lane); continue; } r -= I_IN;
        { const int kb = r / 32, nb = r % 32; p0_transpose_item(w_out, DM, DM, WOUT, 32 * nb, nullptr, scr, kb, nb, F.lane); }
    }
    {
        const float* rw = F.in(19); bf16_t* WRH = (bf16_t*)(F.ws + WS_WRH); bf16_t* WRL = (bf16_t*)(F.ws + WS_WRL);
        const float* wa = F.in(5); const float* wx = F.in(7); bf16_t* WAT = (bf16_t*)(F.ws + WS_WAT); bf16_t* WXT = (bf16_t*)(F.ws + WS_WXT);
        const int gt = F.vcu * NTHR + F.tid, NGT = F.G * NTHR;
        for (int i = gt; i < 32768; i += NGT) {
            { const int n = i >> 10, k = i & 1023; const float v = rw[k * NEXP + n] * g2[k]; const unsigned h = f2bf(v); WRH[i] = (bf16_t)h; WRL[i] = (bf16_t)f2bf(v - bf2f(h)); }
            { const int nblk = i >> 12, j = (i >> 6) & 63, ii = i & 63; WAT[i] = (bf16_t)f2bf(wa[(nblk * 64 + ii) * 64 + j]); WXT[i] = (bf16_t)f2bf(wx[(nblk * 64 + ii) * 64 + j]); }
        }
    }
    {
        bf16_t* XB = (bf16_t*)(F.ws + WS_XB); float* RS1 = (float*)(F.ws + WS_RSTD1);
        for (int m = gw; m < MTOK; m += NGW) {
            const f32x4* xr = (const f32x4*)(x + (size_t)m * DM) + F.lane;
            f32x4 v[4]; float s = 0.f;
#pragma unroll
            for (int j = 0; j < 4; ++j) { v[j] = __builtin_nontemporal_load(&xr[64 * j]); s += (v[j].x * v[j].x + v[j].y * v[j].y) + (v[j].z * v[j].z + v[j].w * v[j].w); }
            s = wave_sum(s);
            if (F.lane == 0) RS1[m] = 1.0f / sqrtf(s * (1.0f / DM) + EPS);
            u32x2* o8 = (u32x2*)(XB + (size_t)m * DM) + F.lane;
#pragma unroll
            for (int j = 0; j < 4; ++j) { u32x2 w; w.x = pk2(v[j].x, v[j].y); w.y = pk2(v[j].z, v[j].w); o8[64 * j] = w; }
        }
    }
}

constexpr int STG_BUF0 = 3 * pg8::HTB, STG_BUF1 = LDS_AUX + 8192;
constexpr int LDS_PFX = LDS_AUX + 26624;
struct RowStager {
    LAS unsigned char* lds; int wr, wc, fr, fq, tid;
    template <class RowPtr> __device__ __forceinline__ void chunk(int c, u32x4 w0, u32x4 w1, const RowPtr& rowp) const {
        LAS unsigned char* buf = lds + ((c & 1) ? STG_BUF1 : STG_BUF0);
        const int rl = wr * 16 + fr, p0 = wc * 4 + fq;
        *(LAS u32x4*)(buf + rl * 512 + ((p0 ^ (rl & 7)) << 4)) = w0;
        *(LAS u32x4*)(buf + rl * 512 + (((16 + p0) ^ (rl & 7)) << 4)) = w1;
        asm volatile("s_waitcnt lgkmcnt(0)" ::: "memory"); __builtin_amdgcn_s_barrier(); asm volatile("" ::: "memory");
        const int ai = c >> 2, m = c & 3;
#pragma unroll
        for (int j = 0; j < 2; ++j) { const int p = tid + 512 * j, r2 = p >> 5, pi = p & 31;
            const u32x4 v = *(const LAS u32x4*)(buf + r2 * 512 + ((pi ^ (r2 & 7)) << 4));
            *(u32x4*)(rowp(ai * 128 + (r2 >> 4) * 64 + m * 16 + (r2 & 15)) + pi * 16) = v; }
    }
};

struct ProbInProj {
    static constexpr bool FP8 = false;
    pg8::StaticOrder S; const char* A; const char* Bt; const float* rstd1; bf16_t* dst0; const float* qg; const float* kg; LAS float* xs; LAS unsigned char* lds;
    __device__ __forceinline__ bool next(int i, pg8::Unit& u) const { u.e = 0; u.tt = 0; return S.next(i, u.pm, u.pn); }
    __device__ __forceinline__ const char* abase(const pg8::Unit& u) const { return A + (size_t)u.pm * 256 * DM * 2; }
    __device__ __forceinline__ void aoff(const pg8::Unit& u, const int (&R)[2], const int (&C)[2], unsigned (&vo)[2][2]) const {
#pragma unroll
        for (int h = 0; h < 2; ++h)
#pragma unroll
            for (int i = 0; i < 2; ++i) vo[h][i] = (unsigned)((h * 128 + R[i]) * DM + C[i]) * 2u;
    }
    __device__ __forceinline__ const char* bptr(const pg8::Unit& u) const { return Bt + (size_t)u.pn * 256 * DM * 2; }
    __device__ __forceinline__ float pre(const pg8::Unit& u, int tid) const { return ld_untracked(rstd1 + u.pm * 256 + (tid & 255)); }
    __device__ __forceinline__ void epi(f32x4 (&acc)[2][2][4][2], const pg8::Unit& u, int wr, int wc, int fr, int fq, float pf) const {
        const int type = u.pn >> 1;
        bf16_t* dst = dst0 + (size_t)type * ((WS_GG - WS_XR) / 2);
        const int row0 = u.pm * 256 + wr * 64 + fr, col0 = (u.pn & 1) * 256 + wc * 32 + 8 * fq;
        LAS float* pfx = (LAS float*)(lds + LDS_PFX);
        if (wr == 0) pfx[wc * 64 + fq * 16 + fr] = pf;
        asm volatile("s_waitcnt lgkmcnt(0)" ::: "memory"); __builtin_amdgcn_s_barrier(); asm volatile("" ::: "memory");
        float rs[2][4];
#pragma unroll
        for (int ai = 0; ai < 2; ++ai)
#pragma unroll
            for (int m = 0; m < 4; ++m) rs[ai][m] = pfx[wr * 64 + fr + ai * 128 + m * 16];
#pragma unroll
        for (int ai = 0; ai < 2; ++ai)
#pragma unroll
            for (int bj = 0; bj < 2; ++bj)
#pragma unroll
                for (int m = 0; m < 4; ++m)
#pragma unroll
                    for (int n = 0; n < 2; ++n) acc[ai][bj][m][n] = acc[ai][bj][m][n] * rs[ai][m];
        if (type == 1) {
#pragma unroll
            for (int ai = 0; ai < 2; ++ai)
#pragma unroll
                for (int bj = 0; bj < 2; ++bj)
#pragma unroll
                    for (int m = 0; m < 4; ++m)
#pragma unroll
                        for (int n = 0; n < 2; ++n) acc[ai][bj][m][n] = gelu_tanh4(acc[ai][bj][m][n]);
        }
        if (type == 2 || type == 3) {
            const int lane = fq * 16 + fr; (void)lane;
            float ss[2][4][2];
#pragma unroll
            for (int ai = 0; ai < 2; ++ai)
#pragma unroll
                for (int m = 0; m < 4; ++m)
#pragma unroll
                    for (int bj = 0; bj < 2; ++bj) { const f32x4 a = acc[ai][bj][m][0], b = acc[ai][bj][m][1]; const f32x4 q = a * a + b * b;
                        float s = (q[0] + q[1]) + (q[2] + q[3]);
                        s = add_xor16(s); s = add_xor32(s); ss[ai][m][bj] = s; }
            LAS float* mine = xs + ((wr * 4 + wc) * 8) * 32; LAS float* other = xs + ((wr * 4 + (wc ^ 1)) * 8) * 32;
            if (fq == 0) {
#pragma unroll
                for (int ai = 0; ai < 2; ++ai)
#pragma unroll
                    for (int m = 0; m < 4; ++m) { f32x2 w; w.x = ss[ai][m][0]; w.y = ss[ai][m][1]; *(LAS f32x2*)(mine + ((ai * 4 + m) * 16 + fr) * 2) = w; }
            }
            asm volatile("s_waitcnt lgkmcnt(0)" ::: "memory"); __builtin_amdgcn_s_barrier(); asm volatile("" ::: "memory");
            const float* g = (type == 2) ? qg : kg; const float sc = (type == 2) ? 0.125f * LOG2E : 1.0f;
            f32x4 gv[2];
#pragma unroll
            for (int n = 0; n < 2; ++n) gv[n] = *(const f32x4*)(g + 32 * (wc & 1) + 8 * fq + 4 * n) * sc;
#pragma unroll
            for (int ai = 0; ai < 2; ++ai)
#pragma unroll
                for (int m = 0; m < 4; ++m) { const f32x2 o = *(const LAS f32x2*)(other + ((ai * 4 + m) * 16 + fr) * 2);
#pragma unroll
                    for (int bj = 0; bj < 2; ++bj) { const float tot = ss[ai][m][bj] + (bj == 0 ? o.x : o.y); const float r = __builtin_amdgcn_rsqf(tot * (1.0f / 64.0f) + EPS);
#pragma unroll
                        for (int n = 0; n < 2; ++n) acc[ai][bj][m][n] = acc[ai][bj][m][n] * (gv[n] * r); } }
        }
        { const RowStager ST{lds, wr, wc, fr, fq, (wr * 4 + wc) * 64 + fq * 16 + fr};
          char* tbase = (char*)(dst + (size_t)u.pm * 256 * 512 + (u.pn & 1) * 256);
          auto rowp = [tbase](int r) { return tbase + (size_t)r * 1024; };
#pragma unroll
          for (int ai = 0; ai < 2; ++ai)
#pragma unroll
              for (int m = 0; m < 4; ++m) { u32x4 w[2];
#pragma unroll
                  for (int bj = 0; bj < 2; ++bj) { const f32x4 v0 = acc[ai][bj][m][0], v1 = acc[ai][bj][m][1];
                      w[bj].x = cvt_pk_bf16(v0[0], v0[1]); w[bj].y = cvt_pk_bf16(v0[2], v0[3]); w[bj].z = cvt_pk_bf16(v1[0], v1[1]); w[bj].w = cvt_pk_bf16(v1[2], v1[3]); }
                  ST.chunk(ai * 4 + m, w[0], w[1], rowp); } }
    }
};

template <int NJ>
__device__ __forceinline__ void conv_unit(Frame& F, int cu, int j0) {
    int lane = F.lane; asm volatile("" : "+v"(lane));
    const int wave = F.wave;
    LAS float* scr = (LAS float*)(F.lds + wave * 16384);
    const bool first = cu < 512;
    const int e = first ? (cu >> 4) : ((cu - 512) >> 3);
    const float* W = first ? F.in(21) + (size_t)e * DM * 2 * DFF : F.in(23) + (size_t)e * DFF * DM;
    unsigned char* WT = first ? F.ws + WS_W1 + (size_t)e * 2 * DFF * DM : F.ws + WS_W2 + (size_t)e * DM * DFF;
    const int N = first ? 2 * DFF : DM;
    const int c = lane & 3;
    float gv[16];
    { const float* g2 = F.in(18);
#pragma unroll
      for (int q = 0; q < 16; ++q) gv[q] = first ? g2[64 * (cu & 15) + 16 * c + q] * WSCALE : WSCALE; }
#define CV_GEOM(j, k0_, n0_, or_) do { const int idx_ = 8 * (j) + wave; \
        if (first) { k0_ = 64 * (cu & 15); n0_ = 32 * idx_; const int j0_ = n0_ & 1023; or_ = 256 * (j0_ >> 7) + (j0_ & 127) + ((n0_ >= 1024) ? 128 : 0); } \
        else { k0_ = 64 * (2 * ((cu - 512) & 7) + (idx_ >> 5)); n0_ = 32 * (idx_ & 31); or_ = n0_; } } while (0)
#define CV_LOAD(LD, k0_, n0_) do { _Pragma("unroll") for (int i = 0; i < 8; ++i) { const int kk = 8 * i + (lane >> 3), c4 = lane & 7; \
        LD[i] = __builtin_nontemporal_load((const f32x4*)(W + (size_t)((k0_) + kk) * N + (n0_) + 4 * c4)); } } while (0)
#define CV_ITEM(LD, j) do { \
        _Pragma("unroll") for (int i = 0; i < 8; ++i) { const int kk = 8 * i + (lane >> 3), c4 = lane & 7; \
            *(LAS f32x4*)(scr + kk * 36 + ((4 * c4 + 4 * (kk >> 3)) & 31)) = LD[i]; }         \
        int k0c, n0c, orc; CV_GEOM(j0 + (j), k0c, n0c, orc); (void)n0c; \
        if ((j) + 2 < NJ) { int k0n, n0n, orn; CV_GEOM(j0 + (j) + 2, k0n, n0n, orn); (void)orn; CV_LOAD(LD, k0n, n0n); } \
        LDS_WAIT(); asm volatile("" ::: "memory"); \
        _Pragma("unroll") for (int j2 = 0; j2 < 2; ++j2) { const int n = (lane >> 2) + 16 * j2; const LAS float* sp = scr + (16 * c) * 36; \
            const int nc0 = (n + 8 * c) & 31, nc1 = (n + 8 * c + 4) & 31;           \
            unsigned w[4]; \
            _Pragma("unroll") for (int q = 0; q < 4; ++q) { unsigned t = 0; const int nc = (q < 2) ? nc0 : nc1; \
                t = __builtin_amdgcn_cvt_pk_fp8_f32(sp[(4 * q) * 36 + nc] * gv[4 * q], sp[(4 * q + 1) * 36 + nc] * gv[4 * q + 1], t, false); \
                t = __builtin_amdgcn_cvt_pk_fp8_f32(sp[(4 * q + 2) * 36 + nc] * gv[4 * q + 2], sp[(4 * q + 3) * 36 + nc] * gv[4 * q + 3], t, true); w[q] = t; } \
            *(u32x4*)(WT + (size_t)(orc + n) * 1024 + k0c + 16 * c) = (u32x4){w[0], w[1], w[2], w[3]}; } \
        LDS_WAIT(); asm volatile("" ::: "memory"); } while (0)
    f32x4 lda[8], ldb[8];
    { int k0, n0, orow; CV_GEOM(j0, k0, n0, orow); (void)orow; CV_LOAD(lda, k0, n0); CV_GEOM(j0 + 1, k0, n0, orow); CV_LOAD(ldb, k0, n0); }
    CV_ITEM(lda, 0); CV_ITEM(ldb, 1);
    if constexpr (NJ == 8) { CV_ITEM(lda, 2); CV_ITEM(ldb, 3); CV_ITEM(lda, 4); CV_ITEM(ldb, 5); CV_ITEM(lda, 6); CV_ITEM(ldb, 7); }
#undef CV_ITEM
#undef CV_GEOM
#undef CV_LOAD
}

constexpr int NCONV = 384, NCONV_ALL = 768, NFILL = (NCONV_ALL - NCONV) * 4, CW_FILLQ = 640;
__device__ __forceinline__ void filler_unit(Frame& F, unsigned t) { conv_unit<2>(F, NCONV + (int)(t >> 2), 2 * (int)(t & 3)); }
__device__ __forceinline__ void filler_drain(Frame& F) {
    unsigned* fq = (unsigned*)(F.ws + WS_CTL) + CW_FILLQ;
    volatile LAS unsigned* st = (volatile LAS unsigned*)(F.lds + LDS_MISC) + 8;
    for (;;) {
        if (F.tid == 0) st[7] = __hip_atomic_fetch_add(fq, 1u, __ATOMIC_RELAXED, __HIP_MEMORY_SCOPE_AGENT);
        __syncthreads();
        const unsigned t = (unsigned)__builtin_amdgcn_readfirstlane((int)st[7]);
        if (t >= (unsigned)NFILL) break;
        filler_unit(F, t);
        __syncthreads();
    }
    __syncthreads();
}

__device__ __forceinline__ void rglru_item(Frame& F, int item) {
    const int bb = item >> 3, nb = item & 7;
    int tid = F.tid; asm volatile("" : "+v"(tid));
    const int lane = tid & 63, wid = F.wave;
    const bf16_t* XR = (const bf16_t*)(F.ws + WS_XR); const bf16_t* GG = (const bf16_t*)(F.ws + WS_GG); bf16_t* Y = (bf16_t*)(F.ws + WS_Y);
    const float* conv_w = F.in(3); const float* conv_b = F.in(4); const float* ba = F.in(6); const float* bx = F.in(8); const float* lam = F.in(9);
    const bf16_t* WAT = (const bf16_t*)(F.ws + WS_WAT); const bf16_t* WXT = (const bf16_t*)(F.ws + WS_WXT);
    LAS bf16_t* XCb = (LAS bf16_t*)(F.lds);
    LAS float* XCf = (LAS float*)(F.lds + 9216);
    LAS float* RGl = (LAS float*)(F.lds + 9216 + 16384);
    LAS float* SEG = (LAS float*)(F.lds + 9216 + 16384 + 32768);
    LAS float* HC = (LAS float*)(F.lds + 9216 + 16384 + 32768 + 4096);
    const int ct = tid >> 3, cg = tid & 7, chb = nb * 64 + 8 * cg;
    float cw[4][8], cb[8];
#pragma unroll
    for (int j = 0; j < 4; ++j)
#pragma unroll
        for (int c = 0; c < 8; ++c) cw[j][c] = conv_w[j * DRNN + chb + c];
#pragma unroll
    for (int c = 0; c < 8; ++c) cb[c] = conv_b[chb + c];
    const int g = wid >> 2, mt = wid & 3, l15 = lane & 15, kq = lane >> 4;
    bf16x8 Bf[4][2];
    { const bf16_t* WT = (g == 0 ? WAT : WXT) + nb * 4096;
#pragma unroll
      for (int ntl = 0; ntl < 4; ++ntl)
#pragma unroll
          for (int ks = 0; ks < 2; ++ks) Bf[ntl][ks] = *(const bf16x8*)(WT + (16 * ntl + l15) * 64 + 32 * ks + 8 * kq); }
    float gbias[4];
#pragma unroll
    for (int ntl = 0; ntl < 4; ++ntl) gbias[ntl] = (g == 0 ? ba : bx)[nb * 64 + 16 * ntl + l15];
    const int sc = tid & 63, sg = tid >> 6;
    const float sp8 = 8.0f * log1pf(expf(-lam[nb * 64 + sc]));
    if (tid < 64) HC[tid] = 0.f;
    const size_t rowbase = (size_t)bb * SEQ;
    u32x4 xv[4];
#pragma unroll
    for (int j = 0; j < 4; ++j) { const int t = ct - 3 + j; xv[j] = (t >= 0) ? *(const u32x4*)(XR + (rowbase + t) * DRNN + chb) : (u32x4){0u, 0u, 0u, 0u}; }
    for (int c = 0; c < SEQ / 64; ++c) {
        const int t0 = 64 * c;
        {
            float xc[8];
#pragma unroll
            for (int q = 0; q < 8; ++q) xc[q] = cb[q];
#pragma unroll
            for (int j = 0; j < 4; ++j) { const unsigned w[4] = {xv[j].x, xv[j].y, xv[j].z, xv[j].w};
#pragma unroll
                for (int q = 0; q < 4; ++q) { xc[2 * q] += cw[j][2 * q] * bf2f(w[q] & 0xffffu); xc[2 * q + 1] += cw[j][2 * q + 1] * bf2f(w[q] >> 16); } }
            if (c + 1 < SEQ / 64) {
#pragma unroll
                for (int j = 0; j < 4; ++j) xv[j] = *(const u32x4*)(XR + (rowbase + t0 + 64 + ct - 3 + j) * DRNN + chb);
            }
            u32x4 pb; pb.x = pk2(xc[0], xc[1]); pb.y = pk2(xc[2], xc[3]); pb.z = pk2(xc[4], xc[5]); pb.w = pk2(xc[6], xc[7]);
            *(LAS u32x4*)(XCb + ct * 72 + 8 * cg) = pb;
            *(LAS f32x4*)(XCf + ct * 64 + 8 * cg) = (f32x4){xc[0], xc[1], xc[2], xc[3]};
            *(LAS f32x4*)(XCf + ct * 64 + 8 * cg + 4) = (f32x4){xc[4], xc[5], xc[6], xc[7]};
        }
        unsigned short gq[8];
#pragma unroll
        for (int s8 = 0; s8 < 8; ++s8) gq[s8] = GG[(rowbase + t0 + 8 * sg + s8) * DRNN + nb * 64 + sc];
        LDS_BARRIER();
        {
            bf16x8 Af[2];
#pragma unroll
            for (int ks = 0; ks < 2; ++ks) Af[ks] = *(const LAS bf16x8*)(XCb + (16 * mt + l15) * 72 + 32 * ks + 8 * kq);
#pragma unroll
            for (int ntl = 0; ntl < 4; ++ntl) {
                f32x4 d = (f32x4){0.f, 0.f, 0.f, 0.f};
#pragma unroll
                for (int ks = 0; ks < 2; ++ks) d = __builtin_amdgcn_mfma_f32_16x16x32_bf16(Af[ks], Bf[ntl][ks], d, 0, 0, 0);
#pragma unroll
                for (int r = 0; r < 4; ++r) RGl[g * 4096 + (16 * mt + 4 * kq + r) * 64 + 16 * ntl + l15] = fast_sigmoid(d[r] + gbias[ntl]);
            }
        }
        LDS_BARRIER();
        float av[8], uv[8]; float Aseg = 1.f, Hseg = 0.f;
#pragma unroll
        for (int s8 = 0; s8 < 8; ++s8) { const int tok = 8 * sg + s8;
            const float r = RGl[tok * 64 + sc], ig = RGl[4096 + tok * 64 + sc], xcv = XCf[tok * 64 + sc];
            const float la = -sp8 * r, y2 = 2.0f * la;
            const float a = __expf(la);
            const float om_s = -y2 * (1.0f + y2 * (0.5f + y2 * (0.16666667f + y2 * 0.041666668f))), om_e = 1.0f - a * a;
            const float om = (y2 > -0.1f) ? om_s : om_e;
            const float u = __builtin_amdgcn_sqrtf(om) * (ig * xcv);
            av[s8] = a; uv[s8] = u; Aseg *= a; Hseg = a * Hseg + u; }
        SEG[(sg * 64 + sc) * 2] = Aseg; SEG[(sg * 64 + sc) * 2 + 1] = Hseg;
        LDS_BARRIER();
        float h = HC[(c & 1) * 64 + sc];
        for (int s2 = 0; s2 < sg; ++s2) h = SEG[(s2 * 64 + sc) * 2] * h + SEG[(s2 * 64 + sc) * 2 + 1];
#pragma unroll
        for (int s8 = 0; s8 < 8; ++s8) { h = av[s8] * h + uv[s8]; Y[(rowbase + t0 + 8 * sg + s8) * DM + nb * 64 + sc] = (bf16_t)f2bf(h * bf2f(gq[s8])); }
        if (sg == 7) HC[((c + 1) & 1) * 64 + sc] = h;
    }
    __syncthreads();
}

namespace att {
constexpr float ATT_THR = 8.0f;
constexpr int LK0 = 0, LK1 = 8192, LV = 16384, LBUF = 32768  , LWS = 98304, LOX = 0;
__device__ __forceinline__ int crow(int r, int hi) { return (r & 3) + 8 * (r >> 2) + 4 * hi; }
__device__ __forceinline__ void glds16(const void* gsrc, unsigned lds_dst) { unsigned keep;
    asm volatile("s_mov_b32 %0, m0\n\ts_mov_b32 m0, %2\n\ts_nop 0\n\tglobal_load_lds_dwordx4 %1, off\n\ts_mov_b32 m0, %0" : "=&s"(keep) : "v"(gsrc), "s"(lds_dst) : "memory"); }
typedef __attribute__((address_space(3))) const char* lds_cptr;
typedef short v4i16_t __attribute__((ext_vector_type(4)));
__device__ __forceinline__ s16x4 vtr(lds_cptr p) { return __builtin_bit_cast(s16x4, __builtin_amdgcn_ds_read_tr16_b64_v4i16((__attribute__((address_space(3))) v4i16_t*)p)); }
template <int CTRL> __device__ __forceinline__ float dpp_f(float x) { return __int_as_float(__builtin_amdgcn_update_dpp(0, __float_as_int(x), CTRL, 0xf, 0xf, true)); }
__device__ __forceinline__ float rowmax_pos(const f32x16& p0, const f32x16& p1) {
    int a = 0, b = 0;
#pragma unroll
    for (int r = 0; r < 16; r += 2) { a = max(max(a, __float_as_int(p0[r])), __float_as_int(p0[r + 1])); b = max(max(b, __float_as_int(p1[r])), __float_as_int(p1[r + 1])); }
    a = max(a, b);
    unsigned ua = (unsigned)a, ub = ua; swap_rows32(ua, ub);
    return __int_as_float(max((int)ua, (int)ub));
}
__device__ __forceinline__ void attn_unit(Frame& F, int b, int h, int qb, float lam) {
    int lane = F.lane; asm volatile("" : "+v"(lane));
    const int r32 = lane & 31, hi = lane >> 5, wid = F.wave, mp = wid >> 2, wq = wid & 3;
    const bf16_t* Q = (const bf16_t*)(F.ws + WS_Q); const bf16_t* K = (const bf16_t*)(F.ws + WS_K); const bf16_t* V = (const bf16_t*)(F.ws + WS_V); bf16_t* Y = (bf16_t*)(F.ws + WS_Y);
    const float* subg = F.in(16);
    char* shm = (char*)F.lds;
    const unsigned lds0 = (unsigned)(uintptr_t)shm;
    const size_t rowbase = (size_t)b * SEQ; const int q0 = qb * 128;
    const int NT = 2 * (qb + 1);
    float* wsf = (float*)(shm + LWS) + wid * 64;
    bf16x8 qr[4];
    { const bf16_t* Qw = Q + (rowbase + q0 + wq * 32 + r32) * 512 + h * 128 + mp * 64;
#pragma unroll
      for (int d0 = 0; d0 < 4; ++d0) qr[d0] = *(const bf16x8*)(Qw + d0 * 16 + hi * 8); }
    const bf16_t* ks0 = K + (rowbase + lane) * 512 + h * 128 + wid * 8;
    const bf16_t* ks1 = ks0 + 64;
    const bf16_t* vs0 = V + (rowbase + 16 * (wid & 3) + (lane >> 2)) * 512 + h * 128 + (wid >> 2) * 32 + (lane & 3) * 8;
    const bf16_t* vs1 = vs0 + 64;
    const unsigned kd0 = (unsigned)__builtin_amdgcn_readfirstlane(lds0 + LK0 + wid * 1024), kd1 = (unsigned)__builtin_amdgcn_readfirstlane(lds0 + LK1 + wid * 1024);
    const unsigned vd0 = (unsigned)__builtin_amdgcn_readfirstlane(lds0 + LV + wid * 1024), vd1 = (unsigned)__builtin_amdgcn_readfirstlane(lds0 + LV + (wid + 8) * 1024);
    const lds_cptr shm3 = (lds_cptr)(F.lds);
    const lds_cptr kp0 = shm3 + (mp ? LK1 : LK0) + hi * 1024 + r32 * 16;
    const lds_cptr vp0 = shm3 + LV + ((lane >> 4) & 1) * 32 + (lane & 3) * 8 + (4 * hi + ((lane & 15) >> 2)) * 64;
    f32x16 negm = f32x16{}; asm volatile("" : "+v"(negm));
    float m_run = 0.f, l_run = 0.f;
    f32x16 o[4];
#pragma unroll
    for (int d = 0; d < 4; ++d) o[d] = f32x16{};
    const int qrel = wq * 32 + r32;
    glds16(ks0, kd0); glds16(ks1, kd1); glds16(vs0, vd0); glds16(vs1, vd1);
    asm volatile("" : "+v"(qr[0]), "+v"(qr[1]), "+v"(qr[2]), "+v"(qr[3]));
    f32x16 p0, p1;
    u32x4 pw[4];
    int bcur = 0, bprev = 0, bnext = LBUF;
#define ATT_QK(P0, P1, slot) do { _Pragma("unroll") for (int d0 = 0; d0 < 4; ++d0) { \
        const bf16x8 k0f = *(const __attribute__((address_space(3))) bf16x8*)(kp0 + (slot) + d0 * 2048); \
        const bf16x8 k1f = *(const __attribute__((address_space(3))) bf16x8*)(kp0 + (slot) + d0 * 2048 + 512); \
        if (d0 == 0) { P0 = __builtin_amdgcn_mfma_f32_32x32x16_bf16(k0f, qr[0], negm, 0, 0, 0); P1 = __builtin_amdgcn_mfma_f32_32x32x16_bf16(k1f, qr[0], negm, 0, 0, 0); } \
        else { P0 = __builtin_amdgcn_mfma_f32_32x32x16_bf16(k0f, qr[d0], P0, 0, 0, 0); P1 = __builtin_amdgcn_mfma_f32_32x32x16_bf16(k1f, qr[d0], P1, 0, 0, 0); } } } while (0)
#define ATT_MASK(P0, P1, t) do { if ((t) >= NT - 2) { const int kb_ = 64 * ((t) - (NT - 2)) + 4 * hi; \
        _Pragma("unroll") for (int r = 0; r < 16; ++r) { const int kv = kb_ + (r & 3) + 8 * (r >> 2); if (kv > qrel) P0[r] = -INFINITY; if (kv + 32 > qrel) P1[r] = -INFINITY; } } } while (0)
#define ATT_SUMPACK(P0, P1) do { float sacc = 0.f; _Pragma("unroll") for (int r = 0; r < 16; ++r) sacc += P0[r] + P1[r]; l_run += sacc; \
        pw[0] = (u32x4){cvt_pk_bf16(P0[0], P0[1]), cvt_pk_bf16(P0[2], P0[3]), cvt_pk_bf16(P0[4], P0[5]), cvt_pk_bf16(P0[6], P0[7])}; \
        pw[1] = (u32x4){cvt_pk_bf16(P0[8], P0[9]), cvt_pk_bf16(P0[10], P0[11]), cvt_pk_bf16(P0[12], P0[13]), cvt_pk_bf16(P0[14], P0[15])}; \
        pw[2] = (u32x4){cvt_pk_bf16(P1[0], P1[1]), cvt_pk_bf16(P1[2], P1[3]), cvt_pk_bf16(P1[4], P1[5]), cvt_pk_bf16(P1[6], P1[7])}; \
        pw[3] = (u32x4){cvt_pk_bf16(P1[8], P1[9]), cvt_pk_bf16(P1[10], P1[11]), cvt_pk_bf16(P1[12], P1[13]), cvt_pk_bf16(P1[14], P1[15])}; } while (0)
#define ATT_PV(slot) do { _Pragma("unroll") for (int db = 0; db < 4; ++db) { _Pragma("unroll") for (int ks = 0; ks < 4; ++ks) { \
        const s16x4 lo = vtr(vp0 + (slot) + db * 4096 + ks * 1024), hh = vtr(vp0 + (slot) + db * 4096 + ks * 1024 + 512); \
        const bf16x8 vf = (bf16x8){lo[0], lo[1], lo[2], lo[3], hh[0], hh[1], hh[2], hh[3]}; \
        o[db] = __builtin_amdgcn_mfma_f32_32x32x16_bf16(__builtin_bit_cast(bf16x8, pw[ks]), vf, o[db], 0, 0, 0); } } } while (0)
#define ATT_DECIDE(P0, P1, moved) do { const float rm = rowmax_pos(P0, P1); moved = false; \
        if (__any(rm > ATT_THR)) { const float dl = rm; m_run += dl; \
            _Pragma("unroll") for (int r = 0; r < 16; ++r) { P0[r] -= dl; P1[r] -= dl; negm[r] = -m_run; } \
            asm volatile("" : "+v"(negm)); \
            const float f = __builtin_amdgcn_exp2f(-dl); l_run *= f; if (hi == 0) wsf[r32] = f; moved = true; } } while (0)
#define ATT_RESCALE_O() do { asm volatile("s_waitcnt lgkmcnt(0)" ::: "memory"); _Pragma("unroll") for (int r = 0; r < 16; ++r) { const float fr_ = wsf[crow(r, hi)]; \
        _Pragma("unroll") for (int d = 0; d < 4; ++d) o[d][r] *= fr_; } } while (0)
    asm volatile("s_waitcnt vmcnt(0) lgkmcnt(0)" ::: "memory"); __builtin_amdgcn_s_barrier(); asm volatile("" ::: "memory");
    { const size_t go = (size_t)1 * 64 * 512; glds16(ks0 + go, kd0 + LBUF); glds16(ks1 + go, kd1 + LBUF); glds16(vs0 + go, vd0 + LBUF); glds16(vs1 + go, vd1 + LBUF); }
    ATT_QK(p0, p1, 0); ATT_MASK(p0, p1, 0);
    { bool moved; ATT_DECIDE(p0, p1, moved); (void)moved; }
#pragma unroll
    for (int r = 0; r < 16; ++r) { p0[r] = __builtin_amdgcn_exp2f(p0[r]); p1[r] = __builtin_amdgcn_exp2f(p1[r]); }
    bprev = 0; bcur = LBUF; bnext = 2 * LBUF;
#define SBAR() __builtin_amdgcn_sched_barrier(0)
#define PIN1(x) asm volatile("" : "+v"(x))
#define KRD(j, slot) (*(const __attribute__((address_space(3))) bf16x8*)(kp0 + (slot) + ((j) >> 1) * 2048 + ((j) & 1) * 512))
#define VRDF(i, slot) do { vlo[(i) % 3] = vtr(vp0 + (slot) + ((i) >> 2) * 4096 + ((i) & 3) * 1024); vhi[(i) % 3] = vtr(vp0 + (slot) + ((i) >> 2) * 4096 + ((i) & 3) * 1024 + 512); } while (0)
#define VFRG(i) (bf16x8){vlo[(i) % 3][0], vlo[(i) % 3][1], vlo[(i) % 3][2], vlo[(i) % 3][3], vhi[(i) % 3][0], vhi[(i) % 3][1], vhi[(i) % 3][2], vhi[(i) % 3][3]}
#define GAPA(j, N0, N1, slot, PA, B, PWW, W0, W1) do { \
        if ((j) == 0) N0 = __builtin_amdgcn_mfma_f32_32x32x16_bf16(kf[0], qr[0], negm, 0, 0, 0); \
        else if ((j) == 1) N1 = __builtin_amdgcn_mfma_f32_32x32x16_bf16(kf[1], qr[0], negm, 0, 0, 0); \
        else if (((j) & 1) == 0) N0 = __builtin_amdgcn_mfma_f32_32x32x16_bf16(kf[(j) % 3], qr[(j) >> 1], N0, 0, 0, 0); \
        else N1 = __builtin_amdgcn_mfma_f32_32x32x16_bf16(kf[(j) % 3], qr[(j) >> 1], N1, 0, 0, 0); \
        if ((j) + 2 < 8) kf[((j) + 2) % 3] = KRD((j) + 2, slot); \
        sacc += PA[B]; sacc += PA[B + 1]; sacc += PA[B + 2]; sacc += PA[B + 3]; PIN1(sacc); \
        PWW[W0] = cvt_pk_bf16(PA[B], PA[B + 1]); PWW[W1] = cvt_pk_bf16(PA[B + 2], PA[B + 3]); PIN1(PWW); SBAR(); } while (0)
#define GAPB(i, slot, X, NX, B) do { \
        o[(i) >> 2] = __builtin_amdgcn_mfma_f32_32x32x16_bf16(__builtin_bit_cast(bf16x8, pw[(i) & 3]), VFRG(i), o[(i) >> 2], 0, 0, 0); \
        if ((i) + 2 < 16) VRDF((i) + 2, slot); \
        X[B] = __builtin_amdgcn_exp2f(NX[B]); X[B + 1] = __builtin_amdgcn_exp2f(NX[B + 1]); PIN1(X); SBAR(); } while (0)
#define ATT_STEP(t, MASKED) do { \
        asm volatile("s_waitcnt vmcnt(0) lgkmcnt(0)" ::: "memory"); \
        __builtin_amdgcn_s_barrier(); \
        asm volatile("" ::: "memory"); \
        if ((t) + 1 < NT) { const size_t go = (size_t)((t) + 1) * 64 * 512; const unsigned b1 = (unsigned)bnext; \
            glds16(ks0 + go, kd0 + b1); glds16(ks1 + go, kd1 + b1); glds16(vs0 + go, vd0 + b1); glds16(vs1 + go, vd1 + b1); } \
        SBAR(); \
        f32x16 n0, n1; bf16x8 kf[3]; s16x4 vlo[3], vhi[3]; float sacc = 0.f; u32x4 q0_, q1_, q2_, q3_; \
        kf[0] = KRD(0, bcur); kf[1] = KRD(1, bcur); SBAR(); \
        GAPA(0, n0, n1, bcur, p0, 0, q0_, 0, 1); GAPA(1, n0, n1, bcur, p0, 4, q0_, 2, 3); GAPA(2, n0, n1, bcur, p0, 8, q1_, 0, 1); GAPA(3, n0, n1, bcur, p0, 12, q1_, 2, 3); \
        GAPA(4, n0, n1, bcur, p1, 0, q2_, 0, 1); GAPA(5, n0, n1, bcur, p1, 4, q2_, 2, 3); GAPA(6, n0, n1, bcur, p1, 8, q3_, 0, 1); GAPA(7, n0, n1, bcur, p1, 12, q3_, 2, 3); \
        l_run += sacc; pw[0] = q0_; pw[1] = q1_; pw[2] = q2_; pw[3] = q3_; \
        VRDF(0, bprev); VRDF(1, bprev); SBAR();                         \
        if (MASKED) ATT_MASK(n0, n1, t); \
        bool moved; ATT_DECIDE(n0, n1, moved); \
        SBAR(); \
        GAPB(0, bprev, p0, n0, 0); GAPB(1, bprev, p0, n0, 2); GAPB(2, bprev, p0, n0, 4); GAPB(3, bprev, p0, n0, 6); \
        GAPB(4, bprev, p0, n0, 8); GAPB(5, bprev, p0, n0, 10); GAPB(6, bprev, p0, n0, 12); GAPB(7, bprev, p0, n0, 14); \
        GAPB(8, bprev, p1, n1, 0); GAPB(9, bprev, p1, n1, 2); GAPB(10, bprev, p1, n1, 4); GAPB(11, bprev, p1, n1, 6); \
        GAPB(12, bprev, p1, n1, 8); GAPB(13, bprev, p1, n1, 10); GAPB(14, bprev, p1, n1, 12); GAPB(15, bprev, p1, n1, 14); \
        if (moved) ATT_RESCALE_O(); \
        bprev = bcur; bcur = bnext; bnext = (bnext == 2 * LBUF) ? 0 : bnext + LBUF; } while (0)
    { int t = 1;
      for (; t < NT - 2; ++t) ATT_STEP(t, false);
      for (; t < NT; ++t) ATT_STEP(t, true); }
#undef ATT_STEP
#undef GAPA
#undef GAPB
#undef KRD
#undef VRDF
#undef VFRG
#undef SBAR
#undef PIN1
    ATT_SUMPACK(p0, p1);
    ATT_PV(bprev);
#undef ATT_QK
#undef ATT_MASK
#undef ATT_SUMPACK
#undef ATT_PV
#undef ATT_DECIDE
#undef ATT_RESCALE_O
    l_run = add_xor32(l_run);
    if (hi == 0) wsf[32 + r32] = l_run;
    asm volatile("s_waitcnt lgkmcnt(0)" ::: "memory");
    f32x16 rliv;
#pragma unroll
    for (int g = 0; g < 4; ++g) { const f32x4 lv = *(const f32x4*)(wsf + 32 + 8 * g + 4 * hi);
#pragma unroll
        for (int j = 0; j < 4; ++j) rliv[4 * g + j] = __builtin_amdgcn_rcpf(lv[j]); }
    __syncthreads();
    float* ox = (float*)(shm + LOX) + wq * 4096;
    if (mp == 1) {
#pragma unroll
        for (int db = 0; db < 4; ++db) { const f32x16 t = o[db] * rliv;
#pragma unroll
            for (int g = 0; g < 4; ++g) *(f32x4*)(ox + ((db * 4 + g) * 64 + lane) * 4) = (f32x4){t[4 * g], t[4 * g + 1], t[4 * g + 2], t[4 * g + 3]}; }
    }
    __syncthreads();
    if (mp == 0) {
        f32x16 ssv = f32x16{};
#pragma unroll
        for (int db = 0; db < 4; ++db) { f32x16 x1;
#pragma unroll
            for (int g = 0; g < 4; ++g) { const f32x4 t = *(const f32x4*)(ox + ((db * 4 + g) * 64 + lane) * 4); x1[4 * g] = t[0]; x1[4 * g + 1] = t[1]; x1[4 * g + 2] = t[2]; x1[4 * g + 3] = t[3]; }
            const f32x16 v = o[db] * rliv - x1 * lam; o[db] = v; ssv = v * v + ssv; }
#pragma unroll
        for (int r = 0; r < 16; ++r) { float sv = ssv[r];
            sv += dpp_f<0xB1>(sv); sv += dpp_f<0x4E>(sv); sv += dpp_f<0x141>(sv); sv += dpp_f<0x140>(sv);
            sv = add_xor16(sv);
            ssv[r] = 0.8f * __builtin_amdgcn_rsqf(sv * (1.0f / 128.0f) + EPS); }
        float sg[4];
#pragma unroll
        for (int db = 0; db < 4; ++db) sg[db] = subg[32 * db + r32];
        bf16_t* stg = (bf16_t*)ox;
#pragma unroll
        for (int db = 0; db < 4; ++db) { const f32x16 t = o[db] * (ssv * sg[db]);
#pragma unroll
            for (int r = 0; r < 16; r += 2) { const unsigned w = cvt_pk_bf16(t[r], t[r + 1]);
                stg[crow(r, hi) * 128 + 32 * db + r32] = (bf16_t)(w & 0xffffu); stg[crow(r + 1, hi) * 128 + 32 * db + r32] = (bf16_t)(w >> 16); } }
        asm volatile("s_waitcnt lgkmcnt(0)" ::: "memory");
        bf16_t* yb = Y + (rowbase + q0 + wq * 32) * DM + 512 + h * 128;
#pragma unroll
        for (int i = 0; i < 8; ++i) { const int q = lane + 64 * i, row = q >> 4, pc = q & 15;
            const u32x4 v = *(const u32x4*)(stg + row * 128 + pc * 8);
            *(u32x4*)(yb + (size_t)row * DM + pc * 8) = v; }
    }
}
constexpr int NQUEUE = 128 + 1024 + NCONV;
__device__ __forceinline__ void mixer_phase(Frame& F) {
    const float* lq1 = F.in(12); const float* lk1 = F.in(13); const float* lq2 = F.in(14); const float* lk2 = F.in(15);
    float a1 = lq1[F.lane] * lk1[F.lane], a2 = lq2[F.lane] * lk2[F.lane];
    a1 = wave_sum(a1); a2 = wave_sum(a2);
    const float lam = expf(a1) - expf(a2) + 0.2f;
    unsigned* qhead = (unsigned*)(F.ws + WS_CTL) + CW_QUEUE;
    volatile LAS unsigned* slot = (volatile LAS unsigned*)(F.lds + LDS_MISC) + 16;
    for (;;) {
        if (F.tid == 0) slot[0] = __hip_atomic_fetch_add(qhead, 1u, __ATOMIC_RELAXED, __HIP_MEMORY_SCOPE_AGENT);
        __syncthreads();
        const int u = (int)__builtin_amdgcn_readfirstlane(slot[0]);
        if (u >= NQUEUE) break;
        if (u < 128) { rglru_item(F, u); continue; }
        const int v = u - 128;
        if (v < 2 * NCONV && (v & 1)) { conv_unit<8>(F, v >> 1, 0); __syncthreads(); continue; }
        const int idx = (v < 2 * NCONV) ? (v >> 1) : v - NCONV, qb = 15 - (idx >> 6), bh = idx & 63;
        attn_unit(F, bh >> 2, bh & 3, qb, lam); __syncthreads();
    }
    __syncthreads();
}
}

struct ProbOutProj {
    static constexpr bool FP8 = false;
    pg8::StaticOrder S; const char* A; const char* Bt; const bf16_t* xb; bf16_t* x1h; unsigned char* x1q; LAS unsigned char* lds;
    __device__ __forceinline__ bool next(int i, pg8::Unit& u) const { u.e = 0; u.tt = 0; return S.next(i, u.pm, u.pn); }
    __device__ __forceinline__ const char* abase(const pg8::Unit& u) const { return A + (size_t)u.pm * 256 * DM * 2; }
    __device__ __forceinline__ void aoff(const pg8::Unit& u, const int (&R)[2], const int (&C)[2], unsigned (&vo)[2][2]) const {
#pragma unroll
        for (int h = 0; h < 2; ++h)
#pragma unroll
            for (int i = 0; i < 2; ++i) vo[h][i] = (unsigned)((h * 128 + R[i]) * DM + C[i]) * 2u;
    }
    __device__ __forceinline__ const char* bptr(const pg8::Unit& u) const { return Bt + (size_t)u.pn * 256 * DM * 2; }
    __device__ __forceinline__ float pre(const pg8::Unit&, int) const { return 0.f; }
    __device__ __forceinline__ void epi(f32x4 (&acc)[2][2][4][2], const pg8::Unit& u, int wr, int wc, int fr, int fq, float) const {
        const int tid = (wr * 4 + wc) * 64 + fq * 16 + fr;
        const size_t tile0 = (size_t)u.pm * 256 * DM + (size_t)u.pn * 256;
        u32x4 xres[8][2];
#pragma unroll
        for (int c = 0; c < 8; ++c)
#pragma unroll
            for (int j = 0; j < 2; ++j) { const int p = tid + 512 * j, r2 = p >> 5, pi = p & 31;
                xres[c][j] = *(const u32x4*)(xb + tile0 + (size_t)((c >> 2) * 128 + (r2 >> 4) * 64 + (c & 3) * 16 + (r2 & 15)) * DM + pi * 8); }
#pragma unroll
        for (int ai = 0; ai < 2; ++ai)
#pragma unroll
            for (int m = 0; m < 4; ++m) { const int c = ai * 4 + m;
                LAS unsigned char* buf = lds + ((c & 1) ? STG_BUF1 : STG_BUF0);
                const int rl = wr * 16 + fr, p0 = wc * 4 + fq;
#pragma unroll
                for (int bj = 0; bj < 2; ++bj) { const f32x4 v0 = acc[ai][bj][m][0], v1 = acc[ai][bj][m][1];
                    u32x4 w; w.x = cvt_pk_bf16(v0[0], v0[1]); w.y = cvt_pk_bf16(v0[2], v0[3]); w.z = cvt_pk_bf16(v1[0], v1[1]); w.w = cvt_pk_bf16(v1[2], v1[3]);
                    *(LAS u32x4*)(buf + rl * 512 + (((bj * 16 + p0) ^ (rl & 7)) << 4)) = w; }
                asm volatile("s_waitcnt lgkmcnt(0)" ::: "memory"); __builtin_amdgcn_s_barrier(); asm volatile("" ::: "memory");
#pragma unroll
                for (int j = 0; j < 2; ++j) { const int p = tid + 512 * j, r2 = p >> 5, pi = p & 31;
                    const u32x4 a = *(const LAS u32x4*)(buf + r2 * 512 + ((pi ^ (r2 & 7)) << 4));
                    const size_t off = tile0 + (size_t)(ai * 128 + (r2 >> 4) * 64 + m * 16 + (r2 & 15)) * DM + pi * 8;
                    const u32x4 xv = xres[c][j];
                    const unsigned aw[4] = {a.x, a.y, a.z, a.w}, xw[4] = {xv.x, xv.y, xv.z, xv.w};
                    float v[8];
#pragma unroll
                    for (int q = 0; q < 4; ++q) { v[2 * q] = bf2f(aw[q] & 0xffffu) + bf2f(xw[q] & 0xffffu); v[2 * q + 1] = bf2f(aw[q] >> 16) + bf2f(xw[q] >> 16); }
                    u32x4 hb; hb.x = cvt_pk_bf16(v[0], v[1]); hb.y = cvt_pk_bf16(v[2], v[3]); hb.z = cvt_pk_bf16(v[4], v[5]); hb.w = cvt_pk_bf16(v[6], v[7]);
                    *(u32x4*)(x1h + off) = hb;
                    u32x2 w8; w8.x = pack_fp8x4(v[0], v[1], v[2], v[3]); w8.y = pack_fp8x4(v[4], v[5], v[6], v[7]);
                    *(u32x2*)(x1q + off) = w8; } }
    }
};

__device__ __forceinline__ void p5_router(Frame& F) {
    const int lane = F.lane, r32 = lane & 31, hi = lane >> 5, wid = F.wave, tl = wid & 3, kh = wid >> 2, tid = F.tid;
    const bf16_t* x1 = (const bf16_t*)(F.ws + WS_X1H); const bf16_t* WRH = (const bf16_t*)(F.ws + WS_WRH); const bf16_t* WRL = (const bf16_t*)(F.ws + WS_WRL);
    const float* rb = F.in(20);
    unsigned* ctl = (unsigned*)(F.ws + WS_CTL);
    int* LIST = (int*)(F.ws + WS_LIST); float* GATES = (float*)(F.ws + WS_GATES); float* RS2 = (float*)(F.ws + WS_RSTD2); int* POSI = (int*)(F.ws + WS_POSI);
    LAS float* T = (LAS float*)(F.lds);
    LAS float* SS = (LAS float*)(F.lds + 2 * 4 * 32 * 33 * 4);
    LAS unsigned* CNTL = (LAS unsigned*)(F.lds + 2 * 4 * 32 * 33 * 4 + 1024);
    float rbv[8];
#pragma unroll
    for (int j = 0; j < 8; ++j) rbv[j] = rb[8 * (tid & 3) + j];
    for (int blk = F.vcu; blk < MTOK / 128; blk += F.G) {
        const int R0 = blk * 128;
        if (tid < 32) CNTL[tid] = 0u;
        f32x16 acc = f32x16{}; float ssq = 0.f;
        const bf16_t* xrow = x1 + (size_t)(R0 + tl * 32 + r32) * DM + kh * 512 + hi * 8;
        const bf16_t* wh = WRH + r32 * DM + kh * 512 + hi * 8; const bf16_t* wl = WRL + r32 * DM + kh * 512 + hi * 8;
#pragma unroll 8
        for (int s = 0; s < 32; ++s) {
            const u32x4 xa = *(const u32x4*)(xrow + 16 * s);
            const unsigned xw[4] = {xa.x, xa.y, xa.z, xa.w};
#pragma unroll
            for (int j = 0; j < 4; ++j) { const float a = bf2f(xw[j] & 0xffffu), b = bf2f(xw[j] >> 16); ssq += a * a + b * b; }
            const bf16x8 bh = *(const bf16x8*)(wh + 16 * s), bl = *(const bf16x8*)(wl + 16 * s);
            acc = __builtin_amdgcn_mfma_f32_32x32x16_bf16(__builtin_bit_cast(bf16x8, xa), bh, acc, 0, 0, 0);
            acc = __builtin_amdgcn_mfma_f32_32x32x16_bf16(__builtin_bit_cast(bf16x8, xa), bl, acc, 0, 0, 0);
        }
        ssq = add_xor32(ssq);
#pragma unroll
        for (int r = 0; r < 16; ++r) T[((kh * 4 + tl) * 32 + att::crow(r, hi)) * 33 + r32] = acc[r];
        if (hi == 0) SS[(kh * 4 + tl) * 32 + r32] = ssq;
        __syncthreads();
        int ek[4]; float gk[4]; unsigned rk[4] = {0u, 0u, 0u, 0u}; float rstd2;
        const int srow = tid >> 2, sq = tid & 3;
        {
            const int tile = srow >> 5, rr = srow & 31;
            rstd2 = __builtin_amdgcn_rsqf((SS[tile * 32 + rr] + SS[(4 + tile) * 32 + rr]) * (1.0f / DM) + EPS);
            const LAS float* ta = T + (tile * 32 + rr) * 33 + 8 * sq; const LAS float* tb = T + ((4 + tile) * 32 + rr) * 33 + 8 * sq;
            float v[8];
#pragma unroll
            for (int j = 0; j < 8; ++j) v[j] = (ta[j] + tb[j]) * rstd2 + rbv[j];
            float vk[4];
#pragma unroll
            for (int k = 0; k < 4; ++k) { float best = -INFINITY; int be = 8 * sq;
#pragma unroll
                for (int j = 0; j < 8; ++j) if (v[j] > best) { best = v[j]; be = 8 * sq + j; }
                { const float ob = att::dpp_f<0xB1>(best); const int oe = __builtin_amdgcn_update_dpp(0, be, 0xB1, 0xf, 0xf, true); if (ob > best || (ob == best && oe < be)) { best = ob; be = oe; } }
                { const float ob = att::dpp_f<0x4E>(best); const int oe = __builtin_amdgcn_update_dpp(0, be, 0x4E, 0xf, 0xf, true); if (ob > best || (ob == best && oe < be)) { best = ob; be = oe; } }
                ek[k] = be; vk[k] = best;
#pragma unroll
                for (int j = 0; j < 8; ++j) if (be == 8 * sq + j) v[j] = -INFINITY; }
            float den = 0.f;
#pragma unroll
            for (int k = 0; k < 4; ++k) { gk[k] = __expf(vk[k] - vk[0]); den += gk[k]; }
            const float rden = 1.0f / den;
#pragma unroll
            for (int k = 0; k < 4; ++k) { gk[k] *= rden; if (sq == 0) rk[k] = __hip_atomic_fetch_add(CNTL + ek[k], 1u, __ATOMIC_RELAXED, __HIP_MEMORY_SCOPE_WORKGROUP); }
        }
        __syncthreads();
        if (tid < 32) { const unsigned n = CNTL[tid]; CNTL[32 + tid] = n ? atomicAdd(ctl + CW_CNT + 64 * tid, n) : 0u; }
        __syncthreads();
        if (sq == 0) {
            const int tok = R0 + srow;
            RS2[tok] = rstd2;
#pragma unroll
            for (int k = 0; k < 4; ++k) { const int li = (int)(CNTL[32 + ek[k]] + rk[k]); LIST[(size_t)ek[k] * MTOK + li] = tok * 4 + k; GATES[tok * 4 + k] = gk[k]; POSI[tok * 4 + k] = (ek[k] << 15) | li; }
        }
        __syncthreads();
    }
}

constexpr int MOE_MAXS = 24;
struct MoeSched { LAS int* TB; LAS int* TE; LAS int* TAB; int tlo, thi, mt, pn, mpb; };
constexpr int MOE_CNTS = 25600 / 4;
__device__ __forceinline__ void moe_prefix(Frame& F, LAS int* TB) {
    const unsigned* ctl = (const unsigned*)(F.ws + WS_CTL);
    if (F.tid < 64) {
        const int e = F.tid; const int c = (e < NEXP) ? (int)__hip_atomic_load(ctl + CW_CNT + 64 * (e & 31), __ATOMIC_RELAXED, __HIP_MEMORY_SCOPE_AGENT) : 0;
        const int tiles = (c + 255) >> 8; int incl = tiles;
#pragma unroll
        for (int o = 1; o < 32; o <<= 1) { const int y = __shfl_up(incl, o); if (e >= o) incl += y; }
        if (e < NEXP) { TB[e] = incl - tiles; TB[MOE_CNTS + e] = c; }
        if (e == NEXP - 1) TB[NEXP] = incl;
    }
    __syncthreads();
}
template <int NPN, bool TABLE>
__device__ __forceinline__ MoeSched moe_setup(Frame& F) {
    MoeSched M;
    M.TB = (LAS int*)(F.lds + LDS_AUX); M.TE = M.TB + 40; M.TAB = M.TB + 64;
    moe_prefix(F, M.TB);
    const int T = __builtin_amdgcn_readfirstlane(M.TB[NEXP]), x = F.vcu >> 5, i = F.vcu & 31;
    M.mpb = 32 / NPN; M.mt = __builtin_amdgcn_readfirstlane(i / NPN); M.pn = __builtin_amdgcn_readfirstlane(i % NPN);
    M.tlo = __builtin_amdgcn_readfirstlane((x * T) >> 3); M.thi = __builtin_amdgcn_readfirstlane(((x + 1) * T) >> 3);
    const int* LIST = (const int*)(F.ws + WS_LIST); const float* RS2 = (const float*)(F.ws + WS_RSTD2);
    if (F.tid < MOE_MAXS) { const int t = M.tlo + F.tid * M.mpb + M.mt; int e = 0; if (t < M.thi) { for (int q = 0; q < NEXP; ++q) if (M.TB[q + 1] <= t) e = q + 1; } M.TE[F.tid] = e; }
    __syncthreads();
    if (TABLE) {
        constexpr int NIT = MOE_MAXS * 256 / NTHR;
        int lst[NIT];
#pragma unroll
        for (int it = 0; it < NIT; ++it) { const int idx = F.tid + NTHR * it, s = idx >> 8, r = idx & 255, t = M.tlo + s * M.mpb + M.mt;
            const int e = M.TE[s]; const int li = (t - M.TB[e]) * 256 + r;
            lst[it] = (t < M.thi && li < M.TB[MOE_CNTS + e]) ? LIST[(size_t)e * MTOK + li] : -1; }
        float rsv[NIT];
#pragma unroll
        for (int it = 0; it < NIT; ++it) rsv[it] = (lst[it] >= 0) ? RS2[lst[it] >> 2] : 0.f;
#pragma unroll
        for (int it = 0; it < NIT; ++it) M.TAB[F.tid + NTHR * it] = (lst[it] >= 0) ? ((lst[it] >> 2) | (int)((f2bf(rsv[it]) & 0x7fffu) << 15)) : 0;
    }
    __syncthreads();
    return M;
}
struct ProbMoe1 {
    static constexpr bool FP8 = true;
    MoeSched M; const char* A; const char* W; const float* b1; unsigned char* act; LAS unsigned char* lds;
    __device__ __forceinline__ bool next(int s, pg8::Unit& u) const { const int t = __builtin_amdgcn_readfirstlane(M.tlo + s * M.mpb + M.mt); if (s >= MOE_MAXS || t >= __builtin_amdgcn_readfirstlane(M.thi)) return false; u.pn = M.pn; u.pm = t; u.tt = s;
        u.e = __builtin_amdgcn_readfirstlane(M.TE[s]); return true; }
    __device__ __forceinline__ const char* abase(const pg8::Unit&) const { return A; }
    __device__ __forceinline__ void aoff(const pg8::Unit& u, const int (&R)[2], const int (&C)[2], unsigned (&vo)[2][2]) const {
#pragma unroll
        for (int h = 0; h < 2; ++h)
#pragma unroll
            for (int i = 0; i < 2; ++i) vo[h][i] = (unsigned)((M.TAB[u.tt * 256 + h * 128 + R[i]] & 0x7fff) * DM + C[i] * 2);
    }
    __device__ __forceinline__ const char* bptr(const pg8::Unit& u) const { return W + ((size_t)u.e * 2 * DFF + (size_t)u.pn * 256) * DM; }
    __device__ __forceinline__ float pre(const pg8::Unit& u, int tid) const { const int t = tid & 255; return ld_untracked(b1 + (size_t)u.e * 2 * DFF + u.pn * 128 + (t & 127) + ((t >> 7) ? DFF : 0)); }
    __device__ __forceinline__ void epi(f32x4 (&acc)[2][2][4][2], const pg8::Unit& u, int wr, int wc, int fr, int fq, float pf) const {
        asm volatile("s_nop 15\n\ts_nop 7" ::: "memory");
        const int rl0 = wr * 64 + fr, cj = u.pn * 128 + wc * 32 + 8 * fq;
        LAS float* pfx = (LAS float*)(lds + LDS_PFX);
        if (wr == 0) pfx[wc * 64 + fq * 16 + fr] = pf;
        asm volatile("s_waitcnt lgkmcnt(0)" ::: "memory"); __builtin_amdgcn_s_barrier(); asm volatile("" ::: "memory");
        const LAS float* bg = pfx + wc * 32 + 8 * fq; const LAS float* bu = bg + 128;
        constexpr float CS = -1.702f * LOG2E, KA = ASCALE / CS;
        f32x4 bg0 = *(const LAS f32x4*)bg, bg1 = *(const LAS f32x4*)(bg + 4); const f32x4 bu0 = *(const LAS f32x4*)bu, bu1 = *(const LAS f32x4*)(bu + 4);
        bg0 = bg0 * CS; bg1 = bg1 * CS;
#pragma unroll
        for (int ai = 0; ai < 2; ++ai)
#pragma unroll
            for (int m = 0; m < 4; ++m) { const int rl = rl0 + ai * 128 + m * 16; const float rs = bf2f((unsigned)M.TAB[u.tt * 256 + rl] >> 15) * (1.0f / WSCALE), rsc = rs * CS;
                float a[8];
#pragma unroll
                for (int n = 0; n < 2; ++n)
#pragma unroll
                    for (int jp = 0; jp < 2; ++jp) {
                        const f32x2 ag = {acc[ai][0][m][n][2 * jp], acc[ai][0][m][n][2 * jp + 1]}, au = {acc[ai][1][m][n][2 * jp], acc[ai][1][m][n][2 * jp + 1]};
                        const f32x2 bgp = n ? (f32x2){bg1[2 * jp], bg1[2 * jp + 1]} : (f32x2){bg0[2 * jp], bg0[2 * jp + 1]};
                        const f32x2 bup = n ? (f32x2){bu1[2 * jp], bu1[2 * jp + 1]} : (f32x2){bu0[2 * jp], bu0[2 * jp + 1]};
                        const f32x2 z = ag * (f32x2){rsc, rsc} + bgp, hu = au * (f32x2){rs, rs} + bup;
                        const f32x2 zc = {fmaxf(z.x, 7.0f * CS), fmaxf(z.y, 7.0f * CS)};
                        const f32x2 up = {__builtin_amdgcn_fmed3f(hu.x, -7.0f, 7.0f), __builtin_amdgcn_fmed3f(hu.y, -7.0f, 7.0f)};
                        const f32x2 den = (f32x2){__builtin_amdgcn_exp2f(zc.x), __builtin_amdgcn_exp2f(zc.y)} + (f32x2){1.0f, 1.0f};
                        const f32x2 sg = {__builtin_amdgcn_rcpf(den.x), __builtin_amdgcn_rcpf(den.y)};
                        const f32x2 r = (zc * sg) * (up * (f32x2){KA, KA} + (f32x2){KA, KA});
                        a[4 * n + 2 * jp] = r.x; a[4 * n + 2 * jp + 1] = r.y; }
                u32x2 w; w.x = pack_fp8x4(a[0], a[1], a[2], a[3]); w.y = pack_fp8x4(a[4], a[5], a[6], a[7]);
                *(u32x2*)(act + ((size_t)u.pm * 256 + rl) * DFF + cj) = w; }
    }
};
struct ProbMoe2 {
    static constexpr bool FP8 = true;
    MoeSched M; const char* A; const char* W; const float* b2; unsigned char* ys; LAS unsigned char* lds;
    __device__ __forceinline__ bool next(int s, pg8::Unit& u) const { const int t = __builtin_amdgcn_readfirstlane(M.tlo + s * M.mpb + M.mt); if (s >= MOE_MAXS || t >= __builtin_amdgcn_readfirstlane(M.thi)) return false; u.pn = M.pn; u.pm = t; u.tt = s;
        u.e = __builtin_amdgcn_readfirstlane(M.TE[s]); return true; }
    __device__ __forceinline__ const char* abase(const pg8::Unit& u) const { return A + (size_t)u.pm * 256 * DFF; }
    __device__ __forceinline__ void aoff(const pg8::Unit& u, const int (&R)[2], const int (&C)[2], unsigned (&vo)[2][2]) const {
#pragma unroll
        for (int h = 0; h < 2; ++h)
#pragma unroll
            for (int i = 0; i < 2; ++i) vo[h][i] = (unsigned)((h * 128 + R[i]) * DFF + C[i] * 2);
    }
    __device__ __forceinline__ const char* bptr(const pg8::Unit& u) const { return W + ((size_t)u.e * DM + (size_t)u.pn * 256) * DFF; }
    __device__ __forceinline__ float pre(const pg8::Unit& u, int tid) const { return ld_untracked(b2 + (size_t)u.e * DM + u.pn * 256 + (tid & 255)); }
    __device__ __forceinline__ void epi(f32x4 (&acc)[2][2][4][2], const pg8::Unit& u, int wr, int wc, int fr, int fq, float pf) const {
        asm volatile("s_nop 15\n\ts_nop 7" ::: "memory");
        const int rl0 = wr * 64 + fr, col0 = u.pn * 256 + wc * 32 + 8 * fq;
        LAS float* pfx = (LAS float*)(lds + LDS_PFX);
        if (wr == 0) pfx[wc * 64 + fq * 16 + fr] = pf;
        asm volatile("s_waitcnt lgkmcnt(0)" ::: "memory"); __builtin_amdgcn_s_barrier(); asm volatile("" ::: "memory");
        const LAS float* bp = pfx + wc * 32 + 8 * fq;
        f32x4 bv[2][2];
#pragma unroll
        for (int bj = 0; bj < 2; ++bj) { bv[bj][0] = *(const LAS f32x4*)(bp + bj * 128) * YSCALE; bv[bj][1] = *(const LAS f32x4*)(bp + bj * 128 + 4) * YSCALE; }
        constexpr float sc = YSCALE / (WSCALE * ASCALE);
        char* tbase = (char*)ys + ((size_t)u.pm * 256) * DM + u.pn * 256;
        const int tid = (wr * 4 + wc) * 64 + fq * 16 + fr;
#pragma unroll
        for (int ai = 0; ai < 2; ++ai)
#pragma unroll
            for (int mh = 0; mh < 2; ++mh) { const int c = ai * 2 + mh; LAS unsigned char* buf = lds + ((c & 1) ? STG_BUF1 : STG_BUF0);
#pragma unroll
                for (int ml = 0; ml < 2; ++ml) { const int m = mh * 2 + ml, rl = ml * 32 + wr * 16 + fr;
#pragma unroll
                    for (int bj = 0; bj < 2; ++bj) { const f32x4 v0 = acc[ai][bj][m][0] * sc + bv[bj][0], v1 = acc[ai][bj][m][1] * sc + bv[bj][1];
                        u32x2 w; w.x = pack_fp8x4(v0[0], v0[1], v0[2], v0[3]); w.y = pack_fp8x4(v1[0], v1[1], v1[2], v1[3]);
                        const int slot = bj * 16 + wc * 4 + fq;
                        *(LAS u32x2*)(buf + rl * 256 + ((slot ^ ((rl & 7) << 1)) << 3)) = w; } }
                asm volatile("s_waitcnt lgkmcnt(0)" ::: "memory"); __builtin_amdgcn_s_barrier(); asm volatile("" ::: "memory");
#pragma unroll
                for (int j = 0; j < 2; ++j) { const int p = tid + 512 * j, r2 = p >> 4, pi = p & 15;
                    const u32x4 v = *(const LAS u32x4*)(buf + r2 * 256 + (((2 * pi) ^ ((r2 & 7) << 1)) << 3));
                    const int trow = ai * 128 + ((r2 >> 4) & 1) * 64 + (mh * 2 + (r2 >> 5)) * 16 + (r2 & 15);
                    *(u32x4*)(tbase + (size_t)trow * DM + pi * 16) = v; } }
    }
};
static_assert(256 + MOE_MAXS * 256 * 4 <= 32768 - 512, "MoE tables fit the AUX region");

__device__ __forceinline__ void p8_combine(Frame& F) {
    const int gw = F.vcu * NWAVES + F.wave, NGW = F.G * NWAVES;
    LAS int* TB = (LAS int*)(F.lds + LDS_AUX);
    moe_prefix(F, TB);
    const unsigned char* YS = F.ws + WS_YB; const int* POSI = (const int*)(F.ws + WS_POSI); const float* GATES = (const float*)(F.ws + WS_GATES);
    const bf16_t* X1H = (const bf16_t*)(F.ws + WS_X1H);
    for (int m = gw; m < MTOK; m += NGW) {
        f32x4* op = (f32x4*)(F.out + (size_t)m * DM) + F.lane;
        const u32x2* xp = (const u32x2*)(X1H + (size_t)m * DM) + F.lane;
        const int pv = POSI[m * 4 + (F.lane & 3)]; const float gv = GATES[m * 4 + (F.lane & 3)] * (1.0f / YSCALE);
        f32x4 v[4];
#pragma unroll
        for (int j = 0; j < 4; ++j) { const u32x2 w = xp[64 * j]; v[j].x = bf2f(w.x & 0xffffu); v[j].y = bf2f(w.x >> 16); v[j].z = bf2f(w.y & 0xffffu); v[j].w = bf2f(w.y >> 16); }
#pragma unroll
        for (int k = 0; k < 4; ++k) { const int p = __builtin_amdgcn_readlane(pv, k); const float g = __builtin_bit_cast(float, __builtin_amdgcn_readlane(__builtin_bit_cast(int, gv), k));
            const int pos = TB[p >> 15] * 256 + (p & 32767);
            const unsigned* yp = (const unsigned*)(YS + (size_t)pos * DM) + F.lane;
#pragma unroll
            for (int j = 0; j < 4; ++j) { const unsigned w = yp[64 * j]; const f32x2 lo = __builtin_amdgcn_cvt_pk_f32_fp8(w, false), hi2 = __builtin_amdgcn_cvt_pk_f32_fp8(w, true);
                v[j].x += g * lo.x; v[j].y += g * lo.y; v[j].z += g * hi2.x; v[j].w += g * hi2.y; } }
#pragma unroll
        for (int j = 0; j < 4; ++j) op[64 * j] = v[j];
    }
}

typedef GAS unsigned gu32;
#define XB_TMO      128
#define XB_XCNT(j)  (256  + 64 * (j))
#define XB_XSUB(j)  (1280 + 64 * (j))
#define XB_XGEN(j)  (2304 + 64 * (j))
#define XB_TOP      3328
#define XB_TOPGEN   3392
#define XCD_BAR_WORDS 3456
#define XB_SPIN_CAP (1u << 20)
__device__ __forceinline__ unsigned xb_ld(unsigned* p)              { return __hip_atomic_load(p, __ATOMIC_RELAXED, __HIP_MEMORY_SCOPE_AGENT); }
__device__ __forceinline__ unsigned xb_add(unsigned* p, unsigned v) { return __hip_atomic_fetch_add(p, v, __ATOMIC_RELAXED, __HIP_MEMORY_SCOPE_AGENT); }
__device__ __forceinline__ unsigned xb_xcc_id() { return (unsigned)__builtin_amdgcn_s_getreg((3 << 11) | 20) & 0xFu; }
#define XB_SPIN(cond, bar) do { unsigned _sp = 0; while (cond) { __builtin_amdgcn_s_sleep(1); \
    if ((++_sp & 255u) == 0u) { if (xb_ld(&(bar)[XB_TMO])) break; if (_sp > XB_SPIN_CAP) { atomicAdd(&(bar)[XB_TMO], 1u); break; } } } } while (0)
struct XcdBarrier { unsigned* bar; unsigned x; volatile LAS unsigned* st; };
__device__ __forceinline__ XcdBarrier xcd_barrier_post(unsigned* bar, volatile LAS unsigned* st) {
    XcdBarrier b; b.bar = bar; b.x = xb_xcc_id(); b.st = st;
    if (threadIdx.x == 0) (void)xb_add(&bar[XB_XCNT(b.x)], 1u);
    return b;
}
__device__ __forceinline__ void xcd_barrier_complete(unsigned* bar, unsigned x, unsigned& nloc, unsigned& nx) {
    const unsigned G = gridDim.x * gridDim.y * gridDim.z;
    unsigned sum, cnt, mine, sp = 0u;
    for (;;) {
        sum = 0u; cnt = 0u; mine = 0u;
#pragma unroll
        for (unsigned j = 0; j < 16; ++j) { const unsigned c = xb_ld(&bar[XB_XCNT(j)]); sum += c; cnt += (c > 0u) ? 1u : 0u; mine = (j == x) ? c : mine; }
        if (sum == G) break;
        __builtin_amdgcn_s_sleep(1);
        if ((++sp & 255u) == 0u) { if (xb_ld(&bar[XB_TMO])) break; if (sp > XB_SPIN_CAP) { atomicAdd(&bar[XB_TMO], 1u); break; } }
    }
    nloc = mine > 0u ? mine : 1u; nx = cnt > 0u ? cnt : 1u;
}
template <bool FILL>
__device__ __forceinline__ void xcd_barrier(const XcdBarrier& b, Frame& F) {
    asm volatile("s_waitcnt vmcnt(0)" ::: "memory");
    __syncthreads();
    if (threadIdx.x == 0) {
        unsigned* bar = b.bar;
        __builtin_amdgcn_s_waitcnt(0);
        unsigned nloc = b.st[0], nx = b.st[1];
        if (nloc == 0u) { xcd_barrier_complete(bar, b.x, nloc, nx); b.st[0] = nloc; b.st[1] = nx; }
        const unsigned old = xb_add(&bar[XB_XSUB(b.x)], 1u);
        const unsigned gen = old / nloc;
        if (old + 1u == (gen + 1u) * nloc) {
            __builtin_amdgcn_fence(__ATOMIC_RELEASE, "agent");
            asm volatile("s_waitcnt vmcnt(0)" ::: "memory");
            const unsigned og = xb_add(&bar[XB_TOP], 1u);
            const unsigned tg = og / nx;
            if (og + 1u == (tg + 1u) * nx) xb_add(&bar[XB_TOPGEN], 1u);
            else XB_SPIN(xb_ld(&bar[XB_TOPGEN]) == tg, bar);
            __builtin_amdgcn_fence(__ATOMIC_ACQUIRE, "agent");
            xb_add(&bar[XB_XGEN(b.x)], 1u);
            asm volatile("s_waitcnt vmcnt(0)" ::: "memory");
            if (FILL) b.st[4] = 1u;
        } else if (!FILL) {
            XB_SPIN(xb_ld(&bar[XB_XGEN(b.x)]) == gen, bar);
            __builtin_amdgcn_fence(__ATOMIC_ACQUIRE, "agent");
            asm volatile("s_waitcnt vmcnt(0)" ::: "memory");
        } else { b.st[4] = 0u; b.st[5] = gen; }
    }
    __syncthreads();
    if (FILL) {
        if (__builtin_amdgcn_readfirstlane((int)b.st[4]) == 0) {
            const unsigned gen = (unsigned)__builtin_amdgcn_readfirstlane((int)b.st[5]);
            unsigned* fq = (unsigned*)(F.ws + WS_CTL) + CW_FILLQ;
            for (;;) {
                if (threadIdx.x == 0) { const unsigned done = (xb_ld(&b.bar[XB_XGEN(b.x)]) != gen) ? 1u : 0u; unsigned t = (unsigned)NFILL; if (!done) t = xb_add(fq, 1u); b.st[6] = done; b.st[7] = t; }
                LDS_BARRIER();
                const unsigned done = (unsigned)__builtin_amdgcn_readfirstlane((int)b.st[6]), t = (unsigned)__builtin_amdgcn_readfirstlane((int)b.st[7]);
                if (done) break;
                if (t < (unsigned)NFILL) filler_unit(F, t);
                else { if (threadIdx.x == 0) XB_SPIN(xb_ld(&b.bar[XB_XGEN(b.x)]) == gen, b.bar); __syncthreads(); break; }
                LDS_BARRIER();
            }
            if (threadIdx.x == 0) { __builtin_amdgcn_fence(__ATOMIC_ACQUIRE, "agent"); asm volatile("s_waitcnt vmcnt(0)" ::: "memory"); }
            __syncthreads();
        }
    }
}

struct Args { const float* in[25]; float* out; unsigned char* ws; int ph_lo, ph_hi; };
__global__ void __launch_bounds__(NTHR, 2) mk_fwd(Args args) {
    extern __shared__ __attribute__((aligned(16))) unsigned char lds_raw[];
    Frame F;
    F.lds = (LAS unsigned char*)lds_raw; F.ws = args.ws; F.out = args.out;
    F.kin = (karg_ptr_t)__builtin_amdgcn_kernarg_segment_ptr();
    F.tid = threadIdx.x; F.lane = F.tid & 63; F.wave = __builtin_amdgcn_readfirstlane(F.tid >> 6);
    F.G = gridDim.x; { const int bx = blockIdx.x; F.vcu = (F.G % 8 == 0) ? (bx % 8) * (F.G / 8) + bx / 8 : bx; }
    const int lo = args.ph_lo, hi = args.ph_hi;
    { volatile LAS unsigned* MISC = (volatile LAS unsigned*)(F.lds + LDS_MISC); if (F.tid < 64) MISC[F.tid] = 0u; }
    __syncthreads();
    XcdBarrier bar; bar.bar = (unsigned*)(F.ws + WS_CTL) + CW_BAR; bar.x = 0; bar.st = nullptr;
    if (hi - lo > 1) bar = xcd_barrier_post((unsigned*)(F.ws + WS_CTL) + CW_BAR, (volatile LAS unsigned*)(F.lds + LDS_MISC) + 8);
#define IN(k) (lo <= (k) && (k) < hi)
#define SEAM(k) do { if (IN(k) && ((k) == 2 ? IN(4) : IN((k) + 1))) xcd_barrier<((k) <= 2 || (k) == 4)>(bar, F); } while (0)

    if (IN(0)) { p0_prologue(F); }
    SEAM(0);
    if (IN(1)) {
        ProbInProj P; P.S.init(MTOK, DIN, F.G, (int)blockIdx.x); P.A = (const char*)(F.ws + WS_XB); P.Bt = (const char*)(F.ws + WS_WIN); P.rstd1 = (const float*)(F.ws + WS_RSTD1);
        P.dst0 = (bf16_t*)(F.ws + WS_XR); P.qg = F.in(10); P.kg = F.in(11); P.xs = (LAS float*)(F.lds + LDS_AUX); P.lds = F.lds;
        pg8::gemm_phase<decltype(P), true>(F.lds, P);
    }
    SEAM(1);
    if (IN(2)) { att::mixer_phase(F); }
    SEAM(2);
    if (IN(4)) {
        ProbOutProj P; P.S.init(MTOK, DM, F.G, (int)blockIdx.x); P.A = (const char*)(F.ws + WS_Y); P.Bt = (const char*)(F.ws + WS_WOUT); P.xb = (const bf16_t*)(F.ws + WS_XB); P.x1h = (bf16_t*)(F.ws + WS_X1H); P.x1q = F.ws + WS_X1B; P.lds = F.lds;
        pg8::gemm_phase<decltype(P), true>(F.lds, P);
    }
    SEAM(4);
    if (IN(5)) { p5_router(F); filler_drain(F); }
    SEAM(5);
    if (IN(6)) {
        ProbMoe1 P; P.M = moe_setup<8, true>(F); P.A = (const char*)(F.ws + WS_X1B); P.W = (const char*)(F.ws + WS_W1); P.b1 = F.in(22); P.act = F.ws + WS_ACT; P.lds = F.lds;
        pg8::gemm_phase<decltype(P), true>(F.lds, P);
    }
    SEAM(6);
    if (IN(7)) {
        ProbMoe2 P; P.M = moe_setup<4, false>(F); P.A = (const char*)(F.ws + WS_ACT); P.W = (const char*)(F.ws + WS_W2); P.b2 = F.in(24); P.ys = F.ws + WS_YB; P.lds = F.lds;
        pg8::gemm_phase<decltype(P), true>(F.lds, P);
    }
    SEAM(7);
    if (IN(8)) { p8_combine(F); }
#undef IN
#undef SEAM
}

extern "C" void kernel_launch(void* const* d_in, const int* in_sizes, int n_in, void* d_out, int out_size, void* d_ws, size_t ws_size, hipStream_t stream) {
    static int grid = 0;
    if (grid == 0) {
        if (n_in != 25 || in_sizes[0] != MTOK * DM || out_size != MTOK * DM || ws_size < WS_END) {
            fprintf(stderr, "kernel_launch: unexpected problem (n_in %d, in0 %d, out %d, ws %zu); nothing launched\n", n_in, n_in > 0 ? in_sizes[0] : -1, out_size, ws_size); grid = -1; return; }
        int dev = 0, cus = 0, per_cu = 0;
        if (hipGetDevice(&dev) != hipSuccess || hipDeviceGetAttribute(&cus, hipDeviceAttributeMultiprocessorCount, dev) != hipSuccess) { grid = -1; return; }
        if (hipFuncSetAttribute((const void*)mk_fwd, hipFuncAttributeMaxDynamicSharedMemorySize, LDS_BYTES) != hipSuccess) { fprintf(stderr, "kernel_launch: hipFuncSetAttribute failed\n"); grid = -1; return; }
        if (hipOccupancyMaxActiveBlocksPerMultiprocessor(&per_cu, (const void*)mk_fwd, NTHR, LDS_BYTES) != hipSuccess || per_cu < 1) { fprintf(stderr, "kernel_launch: occupancy query says %d blocks/CU for %d B of LDS: the grid barrier needs every workgroup resident; nothing launched\n", per_cu, LDS_BYTES); (void)hipGetLastError(); grid = -1; return; }
        (void)hipGetLastError();
        grid = cus;
        if (grid != 256) { fprintf(stderr, "kernel_launch: built for a 256-CU device (got %d)\n", cus); grid = -1; return; }
    }
    if (grid < 0) return;
    (void)hipMemsetAsync((char*)d_ws + WS_CTL, 0, CTL_BYTES, stream);
    Args a{};
    for (int i = 0; i < 25; ++i) a.in[i] = (const float*)d_in[i];
    a.out = (float*)d_out; a.ws = (unsigned char*)d_ws;
#if MK_N_LAUNCHES == 1
    a.ph_lo = 0; a.ph_hi = NPHASE;
    hipLaunchKernelGGL(mk_fwd, dim3(grid), dim3(NTHR), LDS_BYTES, stream, a);
#else
    for (int p = 0; p < NPHASE; ++p) { a.ph_lo = p; a.ph_hi = p + 1; hipLaunchKernelGGL(mk_fwd, dim3(grid), dim3(NTHR), LDS_BYTES, stream, a); }
#endif
}
```

```cpp
#include <hip/hip_runtime.h>
#include <cstdio>
#include <cstdint>

#define LAS __attribute__((address_space(3)))
#define GAS __attribute__((address_space(1)))
typedef unsigned short bf16_t;
typedef short bf16x8 __attribute__((ext_vector_type(8)));
typedef short s16x4 __attribute__((ext_vector_type(4)));
typedef float f32x4 __attribute__((ext_vector_type(4)));
typedef float f32x2 __attribute__((ext_vector_type(2)));
typedef float f32x16 __attribute__((ext_vector_type(16)));
typedef unsigned u32x4 __attribute__((ext_vector_type(4)));
typedef unsigned u32x2 __attribute__((ext_vector_type(2)));

#ifndef MK_N_LAUNCHES
#define MK_N_LAUNCHES 1
#endif
constexpr int NPHASE = 9;

constexpr int NB = 16, SEQ = 2048, DM = 1024, MTOK = NB * SEQ;
constexpr int DIN = 2560, DRNN = 512, NEXP = 32, TOPK = 4, DFF = 1024, NASG = MTOK * TOPK;
constexpr float EPS = 1e-5f;
constexpr float LOG2E = 1.4426950408889634f;
constexpr int NWAVES = 8, NTHR = 512;
constexpr float YSCALE = 8.0f;
constexpr float WSCALE = 32.0f, ASCALE = 4.0f;

constexpr size_t MiB = (size_t)1 << 20;
constexpr size_t WS_CTL = 0, CTL_BYTES = 64 * 1024;
constexpr size_t WS_WIN = 2 * MiB;
constexpr size_t WS_WOUT = 8 * MiB;
constexpr size_t WS_WRH = 10 * MiB, WS_WRL = WS_WRH + 65536;
constexpr size_t WS_WAT = WS_WRH + 2 * 65536, WS_WXT = WS_WAT + 65536;
constexpr size_t WS_RSTD1 = 11 * MiB, WS_RSTD2 = WS_RSTD1 + 131072 * 2;
constexpr size_t WS_GATES = 12 * MiB;
constexpr size_t WS_POSI = 13 * MiB;
constexpr size_t WS_LIST = 16 * MiB;
constexpr size_t WS_W1 = 32 * MiB;
constexpr size_t WS_W2 = 160 * MiB;
constexpr size_t WS_XB = 224 * MiB;
constexpr size_t WS_XR = 288 * MiB, WS_GG = 320 * MiB, WS_Q = 352 * MiB, WS_K = 384 * MiB, WS_V = 416 * MiB;
constexpr size_t WS_Y = 448 * MiB;
constexpr size_t WS_X1B = 512 * MiB;
constexpr size_t WS_X1H = 712 * MiB;
constexpr size_t WS_ACT = 576 * MiB;
constexpr size_t WS_YB = 224 * MiB;
constexpr size_t WS_END = 848 * MiB;
constexpr int MAXTILES = NASG / 256 + NEXP;
constexpr int CW_TMO = 0, CW_QUEUE = 512, CW_CNT = 1024  , CW_BAR = 8192;

constexpr int RING_BYTES = 131072;
constexpr int LDS_AUX = RING_BYTES;
constexpr int LDS_MISC = RING_BYTES + 32768 - 256;
constexpr int LDS_BYTES = 163840;

__device__ __forceinline__ unsigned f2bf(float f) { unsigned u = __builtin_bit_cast(unsigned, f); return (u + 0x7fffu + ((u >> 16) & 1u)) >> 16; }
__device__ __forceinline__ float bf2f(unsigned h) { return __builtin_bit_cast(float, h << 16); }
typedef __bf16 bf16x2_t __attribute__((ext_vector_type(2)));
__device__ __forceinline__ unsigned cvt_pk_bf16(float lo, float hi) { f32x2 v = {lo, hi}; bf16x2_t b = __builtin_convertvector(v, bf16x2_t); return __builtin_bit_cast(unsigned, b); }
__device__ __forceinline__ unsigned pk2(float lo, float hi) { return cvt_pk_bf16(lo, hi); }
__device__ __forceinline__ void swap_rows16(unsigned& a, unsigned& b) { asm("s_nop 1\n\tv_permlane16_swap_b32 %0, %1" : "+v"(a), "+v"(b)); }
__device__ __forceinline__ void swap_rows32(unsigned& a, unsigned& b) { asm("s_nop 1\n\tv_permlane32_swap_b32 %0, %1" : "+v"(a), "+v"(b)); }
__device__ __forceinline__ float add_xor16(float v) { unsigned a = __builtin_bit_cast(unsigned, v), b = a; swap_rows16(a, b); return __builtin_bit_cast(float, a) + __builtin_bit_cast(float, b); }
__device__ __forceinline__ float add_xor32(float v) { unsigned a = __builtin_bit_cast(unsigned, v), b = a; swap_rows32(a, b); return __builtin_bit_cast(float, a) + __builtin_bit_cast(float, b); }
__device__ __forceinline__ float wave_sum(float v) {
#pragma unroll
    for (int o = 1; o < 64; o <<= 1) v += __shfl_xor(v, o);
    return v;
}
__device__ __forceinline__ float fast_sigmoid(float x) { return __builtin_amdgcn_rcpf(1.0f + __builtin_amdgcn_exp2f(-x * LOG2E)); }
__device__ __forceinline__ f32x4 gelu_tanh4(f32x4 x) {
    constexpr float A = -2.0f * 0.7978845608028654f * LOG2E, B = A * 0.044715f;
    const f32x4 t = (x * x * B + A) * x;
    const f32x4 d = (f32x4){__builtin_amdgcn_exp2f(t[0]), __builtin_amdgcn_exp2f(t[1]), __builtin_amdgcn_exp2f(t[2]), __builtin_amdgcn_exp2f(t[3])} + 1.0f;
    return x * (f32x4){__builtin_amdgcn_rcpf(d[0]), __builtin_amdgcn_rcpf(d[1]), __builtin_amdgcn_rcpf(d[2]), __builtin_amdgcn_rcpf(d[3])};
}
__device__ __forceinline__ unsigned pack_fp8x4(float a, float b, float c, float d) { unsigned t = 0; t = __builtin_amdgcn_cvt_pk_fp8_f32(a, b, t, false); t = __builtin_amdgcn_cvt_pk_fp8_f32(c, d, t, true); return t; }
#define LDS_WAIT() asm volatile("s_waitcnt lgkmcnt(0)" ::: "memory")
#define LDS_BARRIER() do { asm volatile("s_waitcnt lgkmcnt(0)" ::: "memory"); __builtin_amdgcn_s_barrier(); asm volatile("" ::: "memory"); } while (0)
__device__ __forceinline__ float ld_untracked(const float* p) { float v; asm volatile("global_load_dword %0, %1, off" : "=v"(v) : "v"(p) : "memory"); return v; }
#define VM_WAIT() asm volatile("s_waitcnt vmcnt(0)" ::: "memory")

typedef const float* const volatile __attribute__((address_space(4))) * karg_ptr_t;
struct Frame {
    LAS unsigned char* lds;
    unsigned char* ws;
    int tid, lane, wave, vcu, G;
    karg_ptr_t kin;
    float* out;
    __device__ __forceinline__ const float* in(int i) const { return kin[i]; }
};

namespace pg8 {
constexpr int BM = 256, BK = 64, HALF = 128, HTB = HALF * BK * 2, KD = 1024, NT = KD / BK;
__device__ __forceinline__ int lds_byte(int r, int c) { const int st = (r >> 4) * 2 + (c >> 5), rr = r & 15, cc = c & 31, ob = rr * 64 + cc * 2; return st * 1024 + (ob ^ (((ob >> 9) & 1) << 5)); }
__device__ __forceinline__ void stage_rc(int b, int& R, int& C) { const int st = b / 1024, sb = b % 1024, swz = sb ^ (((sb >> 9) & 1) << 5); R = (st >> 1) * 16 + swz / 64; C = (st & 1) * 32 + (swz % 64) / 2; }
__device__ __forceinline__ int perm32(int rho) { const int n = rho >> 4, i = rho & 15; return 8 * (i >> 2) + 4 * n + (i & 3); }
struct Unit { int pm, pn, e, tt; };

typedef int v4i_t __attribute__((ext_vector_type(4)));
typedef int v8i_t __attribute__((ext_vector_type(8)));
__device__ __forceinline__ v8i_t cat8(bf16x8 a, bf16x8 b) { return __builtin_shufflevector(__builtin_bit_cast(v4i_t, a), __builtin_bit_cast(v4i_t, b), 0, 1, 2, 3, 4, 5, 6, 7); }
template <class Prob, bool ALIGN_EPI>
__device__ __forceinline__ void gemm_phase(LAS unsigned char* lds, const Prob& P) {
    const int tid = threadIdx.x, wid = __builtin_amdgcn_readfirstlane(tid >> 6), lane = tid & 63, wr = wid >> 2, wc = wid & 3, fr = lane & 15, fq = lane >> 4;
    constexpr int K = Prob::FP8 ? KD / 2 : KD, nt = Prob::FP8 ? NT / 2 : NT;
    unsigned voffB[2];
#pragma unroll
    for (int i = 0; i < 2; ++i) { int R_, C_; stage_rc(tid * 16 + i * 8192, R_, C_); const int Rb = (R_ & ~31) + perm32(R_ & 31); voffB[i] = (unsigned)(Rb * K + C_) * 2u; }
    constexpr size_t kstep = (size_t)(BK * 2);
    constexpr size_t hstepB = (size_t)HALF * K * 2;
    const unsigned ldsw = (unsigned)wid * 1024u;
    const int aoff = lds_byte(wr * 64 + fr, fq * 8), boff = lds_byte(wc * 32 + fr, fq * 8);
#define PG8_SA(b, h) (((b) * 2 + (h)) * HTB)
#define PG8_SB(b, h) ((4 + (b) * 2 + (h)) * HTB)
#define PG8_STAGE(bufoff, gbase, voff) do { _Pragma("unroll") for (int _i = 0; _i < 2; ++_i) \
        __builtin_amdgcn_global_load_lds((const unsigned*)((const char*)(gbase) + (voff)[_i]), (LAS unsigned*)(lds + (bufoff) + ldsw + _i * 8192), 16, 0, 0); } while (0)
#define PG8_RD(off) (*(const LAS bf16x8*)(lds + (off)))
#define PG8_LDA(dst, b, h) do { _Pragma("unroll") for (int m = 0; m < 4; ++m) { if constexpr (Prob::FP8) dst##8[m] = cat8(PG8_RD(PG8_SA(b, h) + aoff + m * 2048), PG8_RD(PG8_SA(b, h) + aoff + m * 2048 + 1024)); \
        else { _Pragma("unroll") for (int k = 0; k < 2; ++k) dst[m][k] = PG8_RD(PG8_SA(b, h) + aoff + m * 2048 + k * 1024); } } } while (0)
#define PG8_LDB(dst, b, h) do { _Pragma("unroll") for (int n = 0; n < 2; ++n) { if constexpr (Prob::FP8) dst##8[n] = cat8(PG8_RD(PG8_SB(b, h) + boff + n * 2048), PG8_RD(PG8_SB(b, h) + boff + n * 2048 + 1024)); \
        else { _Pragma("unroll") for (int k = 0; k < 2; ++k) dst[n][k] = PG8_RD(PG8_SB(b, h) + boff + n * 2048 + k * 1024); } } } while (0)
#define PG8_MMA(ai, bj, At, Bt) do { __builtin_amdgcn_s_setprio(1); _Pragma("unroll") for (int m = 0; m < 4; ++m) _Pragma("unroll") for (int n = 0; n < 2; ++n) { \
        if constexpr (Prob::FP8) asm volatile("s_nop 1\n\tv_mfma_f32_16x16x128_f8f6f4 %0, %1, %2, %0" : "+v"(acc[ai][bj][m][n]) : "v"(Bt##8[n]), "v"(At##8[m])); \
        else { _Pragma("unroll") for (int k = 0; k < 2; ++k) acc[ai][bj][m][n] = __builtin_amdgcn_mfma_f32_16x16x32_bf16(Bt[n][k], At[m][k], acc[ai][bj][m][n], 0, 0, 0); } } \
        __builtin_amdgcn_s_setprio(0); } while (0)
#define PG8_WAIT_V(n) asm volatile("s_waitcnt vmcnt(" #n ")" ::: "memory")
#define PG8_WAIT_L(n) asm volatile("s_waitcnt lgkmcnt(" #n ")" ::: "memory")
#define PG8_BAR __builtin_amdgcn_s_barrier()
#define PG8_SCHED __builtin_amdgcn_sched_barrier(0)
    Unit cur, nxt; int ui = 0;
    if (!P.next(0, cur)) return;
    f32x4 acc[2][2][4][2];
#pragma unroll
    for (int a = 0; a < 2; ++a)
#pragma unroll
        for (int b = 0; b < 2; ++b)
#pragma unroll
            for (int m = 0; m < 4; ++m)
#pragma unroll
                for (int n = 0; n < 2; ++n) acc[a][b][m][n] = (f32x4){0.f, 0.f, 0.f, 0.f};
    bf16x8 At[4][2], B0[2][2], B1[2][2]; v8i_t At8[4], B08[2], B18[2]; (void)At; (void)B0; (void)B1; (void)At8; (void)B08; (void)B18;
    unsigned vo[2][2];
    { int R[2], C[2]; stage_rc(tid * 16, R[0], C[0]); stage_rc(tid * 16 + 8192, R[1], C[1]); P.aoff(cur, R, C, vo); }
    const char* cA = P.abase(cur);
    const char* cB = P.bptr(cur);
    float pfc = P.pre(cur, tid), pfn = 0.f;
    PG8_STAGE(PG8_SB(0, 0), cB, voffB); PG8_STAGE(PG8_SB(0, 1), cB + hstepB, voffB); PG8_STAGE(PG8_SA(0, 0), cA, vo[0]); PG8_STAGE(PG8_SA(0, 1), cA, vo[1]);
    if (wr == 1) PG8_BAR;
    PG8_WAIT_V(2); PG8_BAR;
    PG8_STAGE(PG8_SB(1, 0), cB + kstep, voffB); PG8_STAGE(PG8_SA(1, 0), cA + kstep, vo[0]); PG8_STAGE(PG8_SB(1, 1), cB + hstepB + kstep, voffB);
    PG8_WAIT_V(6); PG8_BAR;
    for (;;) {
        const bool has_next = P.next(ui + 1, nxt);
        const char* nB = has_next ? P.bptr(nxt) : cB;
        const char* nA = has_next ? P.abase(nxt) : cA;
#pragma nounroll
        for (int t = 0; t < nt; t += 2) {
            const bool last = (t == nt - 2);
            const char* a1 = cA + (size_t)(t + 1) * kstep;
            const char* a2 = last ? nA : cA + (size_t)(t + 2) * kstep; const char* b2 = last ? nB : cB + (size_t)(t + 2) * kstep;
            const char* a3 = a2 + kstep; const char* b3 = b2 + kstep;
            unsigned w2[2][2];
#pragma unroll
            for (int h = 0; h < 2; ++h)
#pragma unroll
                for (int i = 0; i < 2; ++i) w2[h][i] = vo[h][i];
            if (last && has_next) { int R[2], C[2]; stage_rc(tid * 16, R[0], C[0]); stage_rc(tid * 16 + 8192, R[1], C[1]); P.aoff(nxt, R, C, w2); pfn = P.pre(nxt, tid); }
            PG8_LDB(B0, 0, 0); PG8_LDB(B1, 0, 1); PG8_SCHED; PG8_LDA(At, 0, 0); PG8_STAGE(PG8_SA(1, 1), a1, vo[1]);
            PG8_WAIT_V(8); PG8_WAIT_L(0); PG8_BAR; PG8_MMA(0, 0, At, B0); PG8_MMA(0, 1, At, B1); PG8_BAR; PG8_SCHED;
            PG8_LDA(At, 0, 1); PG8_STAGE(PG8_SB(0, 0), b2, voffB); PG8_STAGE(PG8_SB(0, 1), b2 + hstepB, voffB); PG8_STAGE(PG8_SA(0, 0), a2, w2[0]);
            PG8_WAIT_V(8); PG8_WAIT_L(0); PG8_BAR; PG8_MMA(1, 0, At, B0); PG8_MMA(1, 1, At, B1); PG8_BAR; PG8_SCHED;
            PG8_LDB(B0, 1, 0); PG8_LDB(B1, 1, 1); PG8_SCHED; PG8_LDA(At, 1, 0); PG8_STAGE(PG8_SA(0, 1), a2, w2[1]);
            PG8_WAIT_V(8); PG8_WAIT_L(0); PG8_BAR; PG8_MMA(0, 0, At, B0); PG8_MMA(0, 1, At, B1); PG8_BAR; PG8_SCHED;
            PG8_LDA(At, 1, 1); PG8_STAGE(PG8_SB(1, 0), b3, voffB); PG8_STAGE(PG8_SB(1, 1), b3 + hstepB, voffB); PG8_STAGE(PG8_SA(1, 0), a3, w2[0]);
            PG8_WAIT_V(8); PG8_WAIT_L(0); PG8_BAR; PG8_MMA(1, 0, At, B0); PG8_MMA(1, 1, At, B1); PG8_BAR; PG8_SCHED;
        }
        if constexpr (ALIGN_EPI) { if (wr == 0) PG8_BAR; }
        { int fr_ = fr, fq_ = fq; asm volatile("" : "+v"(fr_), "+v"(fq_)); P.epi(acc, cur, wr, wc, fr_, fq_, pfc); }
        if (!has_next) break;
#pragma unroll
        for (int a = 0; a < 2; ++a)
#pragma unroll
            for (int b = 0; b < 2; ++b)
#pragma unroll
                for (int m = 0; m < 4; ++m)
#pragma unroll
                    for (int n = 0; n < 2; ++n) acc[a][b][m][n] = (f32x4){0.f, 0.f, 0.f, 0.f};
        cur = nxt; cB = nB; cA = nA; ++ui; pfc = pfn;
        { int R[2], C[2]; stage_rc(tid * 16, R[0], C[0]); stage_rc(tid * 16 + 8192, R[1], C[1]); P.aoff(cur, R, C, vo); }
        if constexpr (ALIGN_EPI) { if (wr == 1) PG8_BAR; }
    }
    PG8_WAIT_V(0);
    if constexpr (!ALIGN_EPI) { if (wr == 0) PG8_BAR; }
    PG8_BAR;
#undef PG8_SA
#undef PG8_SB
#undef PG8_STAGE
#undef PG8_LDA
#undef PG8_RD
#undef PG8_LDB
#undef PG8_MMA
#undef PG8_SCHED
}
struct StaticOrder {
    int nM, nN, nwg, G, c;
    __device__ void init(int M, int N, int G_, int c_) { nM = M / BM; nN = N / BM; nwg = nM * nN; G = G_; c = c_; }
    __device__ bool next(int i, int& pm, int& pn) const {
        const long L = (long)i * G + c; if (L >= nwg) return false;
        int wgid = (int)L; { const int q = nwg / 8, r = nwg % 8, xcd = wgid % 8, off = wgid / 8; wgid = (xcd < r ? xcd * (q + 1) : r * (q + 1) + (xcd - r) * q) + off; }
        const int nig = 8 * nN, gid = wgid / nig, fm = gid * 8, gsz = (nM - fm) < 8 ? (nM - fm) : 8;
        pm = fm + ((wgid % nig) % gsz); pn = (wgid % nig) / gsz; return true;
    }
};
}

__device__ __forceinline__ void p0_transpose_item(const float* W, int K, int N, bf16_t* WT, int out_row0, const float* g, LAS float* scr, int kb, int nb, int lane) {
    const int k0 = 64 * kb, n0 = 32 * nb;
#pragma unroll
    for (int i = 0; i < 8; ++i) { const int kk = 8 * i + (lane >> 3), c4 = lane & 7;
        *(LAS f32x4*)(scr + kk * 36 + ((4 * c4 + 4 * (kk >> 3)) & 31)) = __builtin_nontemporal_load((const f32x4*)(W + (size_t)(k0 + kk) * N + n0 + 4 * c4)); }
    LDS_WAIT(); asm volatile("" ::: "memory");
    const int c = lane & 7;
    float gv[8];
#pragma unroll
    for (int q = 0; q < 8; ++q) gv[q] = g ? g[k0 + 8 * c + q] : 1.0f;
#pragma unroll
    for (int j = 0; j < 4; ++j) { const int n = (lane >> 3) + 8 * j; const LAS float* s = scr + (8 * c) * 36 + ((n + 4 * c) & 31);
        u32x4 o; o.x = pk2(s[0 * 36] * gv[0], s[1 * 36] * gv[1]); o.y = pk2(s[2 * 36] * gv[2], s[3 * 36] * gv[3]); o.z = pk2(s[4 * 36] * gv[4], s[5 * 36] * gv[5]); o.w = pk2(s[6 * 36] * gv[6], s[7 * 36] * gv[7]);
        *(u32x4*)(WT + (size_t)(out_row0 + n) * K + k0 + 8 * c) = o; }
    LDS_WAIT(); asm volatile("" ::: "memory");
}
__device__ __forceinline__ void p0_prologue(Frame& F) {
    LAS float* scr = (LAS float*)(F.lds + F.wave * 16384);
    const int gw = F.vcu * NWAVES + F.wave, NGW = F.G * NWAVES;
    const float* x = F.in(0); const float* g1 = F.in(1); const float* w_in = F.in(2); const float* w_out = F.in(17); const float* g2 = F.in(18);
    bf16_t* WIN = (bf16_t*)(F.ws + WS_WIN); bf16_t* WOUT = (bf16_t*)(F.ws + WS_WOUT);
    constexpr int I_IN = 16 * 80, I_OUT = 16 * 32;
    constexpr int NITEMS = I_IN + I_OUT;
    for (int it = gw; it < NITEMS; it += NGW) {
        int r = it;
        if (r < I_IN) { const int kb = r / 80, nb = r % 80; p0_transpose_item(w_in, DM, DIN, WIN, 32 * nb, g1, scr, kb, nb, F.lane); continue; } r -= I_IN;
        { const int kb = r / 32, nb = r % 32; p0_transpose_item(w_out, DM, DM, WOUT, 32 * nb, nullptr, scr, kb, nb, F.lane); }
    }
    {
        const float* rw = F.in(19); bf16_t* WRH = (bf16_t*)(F.ws + WS_WRH); bf16_t* WRL = (bf16_t*)(F.ws + WS_WRL);
        const float* wa = F.in(5); const float* wx = F.in(7); bf16_t* WAT = (bf16_t*)(F.ws + WS_WAT); bf16_t* WXT = (bf16_t*)(F.ws + WS_WXT);
        const int gt = F.vcu * NTHR + F.tid, NGT = F.G * NTHR;
        for (int i = gt; i < 32768; i += NGT) {
            { const int n = i >> 10, k = i & 1023; const float v = rw[k * NEXP + n] * g2[k]; const unsigned h = f2bf(v); WRH[i] = (bf16_t)h; WRL[i] = (bf16_t)f2bf(v - bf2f(h)); }
            { const int nblk = i >> 12, j = (i >> 6) & 63, ii = i & 63; WAT[i] = (bf16_t)f2bf(wa[(nblk * 64 + ii) * 64 + j]); WXT[i] = (bf16_t)f2bf(wx[(nblk * 64 + ii) * 64 + j]); }
        }
    }
    {
        bf16_t* XB = (bf16_t*)(F.ws + WS_XB); float* RS1 = (float*)(F.ws + WS_RSTD1);
        for (int m = gw; m < MTOK; m += NGW) {
            const f32x4* xr = (const f32x4*)(x + (size_t)m * DM) + F.lane;
            f32x4 v[4]; float s = 0.f;
#pragma unroll
            for (int j = 0; j < 4; ++j) { v[j] = __builtin_nontemporal_load(&xr[64 * j]); s += (v[j].x * v[j].x + v[j].y * v[j].y) + (v[j].z * v[j].z + v[j].w * v[j].w); }
            s = wave_sum(s);
            if (F.lane == 0) RS1[m] = 1.0f / sqrtf(s * (1.0f / DM) + EPS);
            u32x2* o8 = (u32x2*)(XB + (size_t)m * DM) + F.lane;
#pragma unroll
            for (int j = 0; j < 4; ++j) { u32x2 w; w.x = pk2(v[j].x, v[j].y); w.y = pk2(v[j].z, v[j].w); o8[64 * j] = w; }
        }
    }
}

constexpr int STG_BUF0 = 3 * pg8::HTB, STG_BUF1 = LDS_AUX + 8192;
constexpr int LDS_PFX = LDS_AUX + 26624;
struct RowStager {
    LAS unsigned char* lds; int wr, wc, fr, fq, tid;
    template <class RowPtr> __device__ __forceinline__ void chunk(int c, u32x4 w0, u32x4 w1, const RowPtr& rowp) const {
        LAS unsigned char* buf = lds + ((c & 1) ? STG_BUF1 : STG_BUF0);
        const int rl = wr * 16 + fr, p0 = wc * 4 + fq;
        *(LAS u32x4*)(buf + rl * 512 + ((p0 ^ (rl & 7)) << 4)) = w0;
        *(LAS u32x4*)(buf + rl * 512 + (((16 + p0) ^ (rl & 7)) << 4)) = w1;
        asm volatile("s_waitcnt lgkmcnt(0)" ::: "memory"); __builtin_amdgcn_s_barrier(); asm volatile("" ::: "memory");
        const int ai = c >> 2, m = c & 3;
#pragma unroll
        for (int j = 0; j < 2; ++j) { const int p = tid + 512 * j, r2 = p >> 5, pi = p & 31;
            const u32x4 v = *(const LAS u32x4*)(buf + r2 * 512 + ((pi ^ (r2 & 7)) << 4));
            *(u32x4*)(rowp(ai * 128 + (r2 >> 4) * 64 + m * 16 + (r2 & 15)) + pi * 16) = v; }
    }
};

struct ProbInProj {
    static constexpr bool FP8 = false;
    pg8::StaticOrder S; const char* A; const char* Bt; const float* rstd1; bf16_t* dst0; const float* qg; const float* kg; LAS float* xs; LAS unsigned char* lds;
    __device__ __forceinline__ bool next(int i, pg8::Unit& u) const { u.e = 0; u.tt = 0; return S.next(i, u.pm, u.pn); }
    __device__ __forceinline__ const char* abase(const pg8::Unit& u) const { return A + (size_t)u.pm * 256 * DM * 2; }
    __device__ __forceinline__ void aoff(const pg8::Unit& u, const int (&R)[2], const int (&C)[2], unsigned (&vo)[2][2]) const {
#pragma unroll
        for (int h = 0; h < 2; ++h)
#pragma unroll
            for (int i = 0; i < 2; ++i) vo[h][i] = (unsigned)((h * 128 + R[i]) * DM + C[i]) * 2u;
    }
    __device__ __forceinline__ const char* bptr(const pg8::Unit& u) const { return Bt + (size_t)u.pn * 256 * DM * 2; }
    __device__ __forceinline__ float pre(const pg8::Unit& u, int tid) const { return ld_untracked(rstd1 + u.pm * 256 + (tid & 255)); }
    __device__ __forceinline__ void epi(f32x4 (&acc)[2][2][4][2], const pg8::Unit& u, int wr, int wc, int fr, int fq, float pf) const {
        const int type = u.pn >> 1;
        bf16_t* dst = dst0 + (size_t)type * ((WS_GG - WS_XR) / 2);
        const int row0 = u.pm * 256 + wr * 64 + fr, col0 = (u.pn & 1) * 256 + wc * 32 + 8 * fq;
        LAS float* pfx = (LAS float*)(lds + LDS_PFX);
        if (wr == 0) pfx[wc * 64 + fq * 16 + fr] = pf;
        asm volatile("s_waitcnt lgkmcnt(0)" ::: "memory"); __builtin_amdgcn_s_barrier(); asm volatile("" ::: "memory");
        float rs[2][4];
#pragma unroll
        for (int ai = 0; ai < 2; ++ai)
#pragma unroll
            for (int m = 0; m < 4; ++m) rs[ai][m] = pfx[wr * 64 + fr + ai * 128 + m * 16];
#pragma unroll
        for (int ai = 0; ai < 2; ++ai)
#pragma unroll
            for (int bj = 0; bj < 2; ++bj)
#pragma unroll
                for (int m = 0; m < 4; ++m)
#pragma unroll
                    for (int n = 0; n < 2; ++n) acc[ai][bj][m][n] = acc[ai][bj][m][n] * rs[ai][m];
        if (type == 1) {
#pragma unroll
            for (int ai = 0; ai < 2; ++ai)
#pragma unroll
                for (int bj = 0; bj < 2; ++bj)
#pragma unroll
                    for (int m = 0; m < 4; ++m)
#pragma unroll
                        for (int n = 0; n < 2; ++n) acc[ai][bj][m][n] = gelu_tanh4(acc[ai][bj][m][n]);
        }
        if (type == 2 || type == 3) {
            const int lane = fq * 16 + fr; (void)lane;
            float ss[2][4][2];
#pragma unroll
            for (int ai = 0; ai < 2; ++ai)
#pragma unroll
                for (int m = 0; m < 4; ++m)
#pragma unroll
                    for (int bj = 0; bj < 2; ++bj) { const f32x4 a = acc[ai][bj][m][0], b = acc[ai][bj][m][1]; const f32x4 q = a * a + b * b;
                        float s = (q[0] + q[1]) + (q[2] + q[3]);
                        s = add_xor16(s); s = add_xor32(s); ss[ai][m][bj] = s; }
            LAS float* mine = xs + ((wr * 4 + wc) * 8) * 32; LAS float* other = xs + ((wr * 4 + (wc ^ 1)) * 8) * 32;
            if (fq == 0) {
#pragma unroll
                for (int ai = 0; ai < 2; ++ai)
#pragma unroll
                    for (int m = 0; m < 4; ++m) { f32x2 w; w.x = ss[ai][m][0]; w.y = ss[ai][m][1]; *(LAS f32x2*)(mine + ((ai * 4 + m) * 16 + fr) * 2) = w; }
            }
            asm volatile("s_waitcnt lgkmcnt(0)" ::: "memory"); __builtin_amdgcn_s_barrier(); asm volatile("" ::: "memory");
            const float* g = (type == 2) ? qg : kg; const float sc = (type == 2) ? 0.125f * LOG2E : 1.0f;
            f32x4 gv[2];
#pragma unroll
            for (int n = 0; n < 2; ++n) gv[n] = *(const f32x4*)(g + 32 * (wc & 1) + 8 * fq + 4 * n) * sc;
#pragma unroll
            for (int ai = 0; ai < 2; ++ai)
#pragma unroll
                for (int m = 0; m < 4; ++m) { const f32x2 o = *(const LAS f32x2*)(other + ((ai * 4 + m) * 16 + fr) * 2);
#pragma unroll
                    for (int bj = 0; bj < 2; ++bj) { const float tot = ss[ai][m][bj] + (bj == 0 ? o.x : o.y); const float r = __builtin_amdgcn_rsqf(tot * (1.0f / 64.0f) + EPS);
#pragma unroll
                        for (int n = 0; n < 2; ++n) acc[ai][bj][m][n] = acc[ai][bj][m][n] * (gv[n] * r); } }
        }
        { const RowStager ST{lds, wr, wc, fr, fq, (wr * 4 + wc) * 64 + fq * 16 + fr};
          char* tbase = (char*)(dst + (size_t)u.pm * 256 * 512 + (u.pn & 1) * 256);
          auto rowp = [tbase](int r) { return tbase + (size_t)r * 1024; };
#pragma unroll
          for (int ai = 0; ai < 2; ++ai)
#pragma unroll
              for (int m = 0; m < 4; ++m) { u32x4 w[2];
#pragma unroll
                  for (int bj = 0; bj < 2; ++bj) { const f32x4 v0 = acc[ai][bj][m][0], v1 = acc[ai][bj][m][1];
                      w[bj].x = cvt_pk_bf16(v0[0], v0[1]); w[bj].y = cvt_pk_bf16(v0[2], v0[3]); w[bj].z = cvt_pk_bf16(v1[0], v1[1]); w[bj].w = cvt_pk_bf16(v1[2], v1[3]); }
                  ST.chunk(ai * 4 + m, w[0], w[1], rowp); } }
    }
};

template <int NJ>
__device__ __forceinline__ void conv_unit(Frame& F, int cu, int j0) {
    int lane = F.lane; asm volatile("" : "+v"(lane));
    const int wave = F.wave;
    LAS float* scr = (LAS float*)(F.lds + wave * 16384);
    const bool first = cu < 512;
    const int e = first ? (cu >> 4) : ((cu - 512) >> 3);
    const float* W = first ? F.in(21) + (size_t)e * DM * 2 * DFF : F.in(23) + (size_t)e * DFF * DM;
    unsigned char* WT = first ? F.ws + WS_W1 + (size_t)e * 2 * DFF * DM : F.ws + WS_W2 + (size_t)e * DM * DFF;
    const int N = first ? 2 * DFF : DM;
    const int c = lane & 3;
    float gv[16];
    { const float* g2 = F.in(18);
#pragma unroll
      for (int q = 0; q < 16; ++q) gv[q] = first ? g2[64 * (cu & 15) + 16 * c + q] * WSCALE : WSCALE; }
#define CV_GEOM(j, k0_, n0_, or_) do { const int idx_ = 8 * (j) + wave; \
        if (first) { k0_ = 64 * (cu & 15); n0_ = 32 * idx_; const int j0_ = n0_ & 1023; or_ = 256 * (j0_ >> 7) + (j0_ & 127) + ((n0_ >= 1024) ? 128 : 0); } \
        else { k0_ = 64 * (2 * ((cu - 512) & 7) + (idx_ >> 5)); n0_ = 32 * (idx_ & 31); or_ = n0_; } } while (0)
#define CV_LOAD(LD, k0_, n0_) do { _Pragma("unroll") for (int i = 0; i < 8; ++i) { const int kk = 8 * i + (lane >> 3), c4 = lane & 7; \
        LD[i] = __builtin_nontemporal_load((const f32x4*)(W + (size_t)((k0_) + kk) * N + (n0_) + 4 * c4)); } } while (0)
#define CV_ITEM(LD, j) do { \
        _Pragma("unroll") for (int i = 0; i < 8; ++i) { const int kk = 8 * i + (lane >> 3), c4 = lane & 7; \
            *(LAS f32x4*)(scr + kk * 36 + ((4 * c4 + 4 * (kk >> 3)) & 31)) = LD[i]; }         \
        int k0c, n0c, orc; CV_GEOM(j0 + (j), k0c, n0c, orc); (void)n0c; \
        if ((j) + 2 < NJ) { int k0n, n0n, orn; CV_GEOM(j0 + (j) + 2, k0n, n0n, orn); (void)orn; CV_LOAD(LD, k0n, n0n); } \
        LDS_WAIT(); asm volatile("" ::: "memory"); \
        _Pragma("unroll") for (int j2 = 0; j2 < 2; ++j2) { const int n = (lane >> 2) + 16 * j2; const LAS float* sp = scr + (16 * c) * 36; \
            const int nc0 = (n + 8 * c) & 31, nc1 = (n + 8 * c + 4) & 31;           \
            unsigned w[4]; \
            _Pragma("unroll") for (int q = 0; q < 4; ++q) { unsigned t = 0; const int nc = (q < 2) ? nc0 : nc1; \
                t = __builtin_amdgcn_cvt_pk_fp8_f32(sp[(4 * q) * 36 + nc] * gv[4 * q], sp[(4 * q + 1) * 36 + nc] * gv[4 * q + 1], t, false); \
                t = __builtin_amdgcn_cvt_pk_fp8_f32(sp[(4 * q + 2) * 36 + nc] * gv[4 * q + 2], sp[(4 * q + 3) * 36 + nc] * gv[4 * q + 3], t, true); w[q] = t; } \
            *(u32x4*)(WT + (size_t)(orc + n) * 1024 + k0c + 16 * c) = (u32x4){w[0], w[1], w[2], w[3]}; } \
        LDS_WAIT(); asm volatile("" ::: "memory"); } while (0)
    f32x4 lda[8], ldb[8];
    { int k0, n0, orow; CV_GEOM(j0, k0, n0, orow); (void)orow; CV_LOAD(lda, k0, n0); CV_GEOM(j0 + 1, k0, n0, orow); CV_LOAD(ldb, k0, n0); }
    CV_ITEM(lda, 0); CV_ITEM(ldb, 1);
    if constexpr (NJ == 8) { CV_ITEM(lda, 2); CV_ITEM(ldb, 3); CV_ITEM(lda, 4); CV_ITEM(ldb, 5); CV_ITEM(lda, 6); CV_ITEM(ldb, 7); }
#undef CV_ITEM
#undef CV_GEOM
#undef CV_LOAD
}

constexpr int NCONV = 384, NCONV_ALL = 768, NFILL = (NCONV_ALL - NCONV) * 4, CW_FILLQ = 640;
__device__ __forceinline__ void filler_unit(Frame& F, unsigned t) { conv_unit<2>(F, NCONV + (int)(t >> 2), 2 * (int)(t & 3)); }
__device__ __forceinline__ void filler_drain(Frame& F) {
    unsigned* fq = (unsigned*)(F.ws + WS_CTL) + CW_FILLQ;
    volatile LAS unsigned* st = (volatile LAS unsigned*)(F.lds + LDS_MISC) + 8;
    for (;;) {
        if (F.tid == 0) st[7] = __hip_atomic_fetch_add(fq, 1u, __ATOMIC_RELAXED, __HIP_MEMORY_SCOPE_AGENT);
        __syncthreads();
        const unsigned t = (unsigned)__builtin_amdgcn_readfirstlane((int)st[7]);
        if (t >= (unsigned)NFILL) break;
        filler_unit(F, t);
        __syncthreads();
    }
    __syncthreads();
}

__device__ __forceinline__ void rglru_item(Frame& F, int item) {
    const int bb = item >> 3, nb = item & 7;
    int tid = F.tid; asm volatile("" : "+v"(tid));
    const int lane = tid & 63, wid = F.wave;
    const bf16_t* XR = (const bf16_t*)(F.ws + WS_XR); const bf16_t* GG = (const bf16_t*)(F.ws + WS_GG); bf16_t* Y = (bf16_t*)(F.ws + WS_Y);
    const float* conv_w = F.in(3); const float* conv_b = F.in(4); const float* ba = F.in(6); const float* bx = F.in(8); const float* lam = F.in(9);
    const bf16_t* WAT = (const bf16_t*)(F.ws + WS_WAT); const bf16_t* WXT = (const bf16_t*)(F.ws + WS_WXT);
    LAS bf16_t* XCb = (LAS bf16_t*)(F.lds);
    LAS float* XCf = (LAS float*)(F.lds + 9216);
    LAS float* RGl = (LAS float*)(F.lds + 9216 + 16384);
    LAS float* SEG = (LAS float*)(F.lds + 9216 + 16384 + 32768);
    LAS float* HC = (LAS float*)(F.lds + 9216 + 16384 + 32768 + 4096);
    const int ct = tid >> 3, cg = tid & 7, chb = nb * 64 + 8 * cg;
    float cw[4][8], cb[8];
#pragma unroll
    for (int j = 0; j < 4; ++j)
#pragma unroll
        for (int c = 0; c < 8; ++c) cw[j][c] = conv_w[j * DRNN + chb + c];
#pragma unroll
    for (int c = 0; c < 8; ++c) cb[c] = conv_b[chb + c];
    const int g = wid >> 2, mt = wid & 3, l15 = lane & 15, kq = lane >> 4;
    bf16x8 Bf[4][2];
    { const bf16_t* WT = (g == 0 ? WAT : WXT) + nb * 4096;
#pragma unroll
      for (int ntl = 0; ntl < 4; ++ntl)
#pragma unroll
          for (int ks = 0; ks < 2; ++ks) Bf[ntl][ks] = *(const bf16x8*)(WT + (16 * ntl + l15) * 64 + 32 * ks + 8 * kq); }
    float gbias[4];
#pragma unroll
    for (int ntl = 0; ntl < 4; ++ntl) gbias[ntl] = (g == 0 ? ba : bx)[nb * 64 + 16 * ntl + l15];
    const int sc = tid & 63, sg = tid >> 6;
    const float sp8 = 8.0f * log1pf(expf(-lam[nb * 64 + sc]));
    if (tid < 64) HC[tid] = 0.f;
    const size_t rowbase = (size_t)bb * SEQ;
    u32x4 xv[4];
#pragma unroll
    for (int j = 0; j < 4; ++j) { const int t = ct - 3 + j; xv[j] = (t >= 0) ? *(const u32x4*)(XR + (rowbase + t) * DRNN + chb) : (u32x4){0u, 0u, 0u, 0u}; }
    for (int c = 0; c < SEQ / 64; ++c) {
        const int t0 = 64 * c;
        {
            float xc[8];
#pragma unroll
            for (int q = 0; q < 8; ++q) xc[q] = cb[q];
#pragma unroll
            for (int j = 0; j < 4; ++j) { const unsigned w[4] = {xv[j].x, xv[j].y, xv[j].z, xv[j].w};
#pragma unroll
                for (int q = 0; q < 4; ++q) { xc[2 * q] += cw[j][2 * q] * bf2f(w[q] & 0xffffu); xc[2 * q + 1] += cw[j][2 * q + 1] * bf2f(w[q] >> 16); } }
            if (c + 1 < SEQ / 64) {
#pragma unroll
                for (int j = 0; j < 4; ++j) xv[j] = *(const u32x4*)(XR + (rowbase + t0 + 64 + ct - 3 + j) * DRNN + chb);
            }
            u32x4 pb; pb.x = pk2(xc[0], xc[1]); pb.y = pk2(xc[2], xc[3]); pb.z = pk2(xc[4], xc[5]); pb.w = pk2(xc[6], xc[7]);
            *(LAS u32x4*)(XCb + ct * 72 + 8 * cg) = pb;
            *(LAS f32x4*)(XCf + ct * 64 + 8 * cg) = (f32x4){xc[0], xc[1], xc[2], xc[3]};
            *(LAS f32x4*)(XCf + ct * 64 + 8 * cg + 4) = (f32x4){xc[4], xc[5], xc[6], xc[7]};
        }
        unsigned short gq[8];
#pragma unroll
        for (int s8 = 0; s8 < 8; ++s8) gq[s8] = GG[(rowbase + t0 + 8 * sg + s8) * DRNN + nb * 64 + sc];
        LDS_BARRIER();
        {
            bf16x8 Af[2];
#pragma unroll
            for (int ks = 0; ks < 2; ++ks) Af[ks] = *(const LAS bf16x8*)(XCb + (16 * mt + l15) * 72 + 32 * ks + 8 * kq);
#pragma unroll
            for (int ntl = 0; ntl < 4; ++ntl) {
                f32x4 d = (f32x4){0.f, 0.f, 0.f, 0.f};
#pragma unroll
                for (int ks = 0; ks < 2; ++ks) d = __builtin_amdgcn_mfma_f32_16x16x32_bf16(Af[ks], Bf[ntl][ks], d, 0, 0, 0);
#pragma unroll
                for (int r = 0; r < 4; ++r) RGl[g * 4096 + (16 * mt + 4 * kq + r) * 64 + 16 * ntl + l15] = fast_sigmoid(d[r] + gbias[ntl]);
            }
        }
        LDS_BARRIER();
        float av[8], uv[8]; float Aseg = 1.f, Hseg = 0.f;
#pragma unroll
        for (int s8 = 0; s8 < 8; ++s8) { const int tok = 8 * sg + s8;
            const float r = RGl[tok * 64 + sc], ig = RGl[4096 + tok * 64 + sc], xcv = XCf[tok * 64 + sc];
            const float la = -sp8 * r, y2 = 2.0f * la;
            const float a = __expf(la);
            const float om_s = -y2 * (1.0f + y2 * (0.5f + y2 * (0.16666667f + y2 * 0.041666668f))), om_e = 1.0f - a * a;
            const float om = (y2 > -0.1f) ? om_s : om_e;
            const float u = __builtin_amdgcn_sqrtf(om) * (ig * xcv);
            av[s8] = a; uv[s8] = u; Aseg *= a; Hseg = a * Hseg + u; }
        SEG[(sg * 64 + sc) * 2] = Aseg; SEG[(sg * 64 + sc) * 2 + 1] = Hseg;
        LDS_BARRIER();
        float h = HC[(c & 1) * 64 + sc];
        { f32x2 sgv[7];
#pragma unroll
          for (int s2 = 0; s2 < 7; ++s2) sgv[s2] = *(const LAS f32x2*)(SEG + (s2 * 64 + sc) * 2);
#pragma unroll
          for (int s2 = 0; s2 < 7; ++s2) h = (s2 < sg) ? sgv[s2].x * h + sgv[s2].y : h; }
#pragma unroll
        for (int s8 = 0; s8 < 8; ++s8) { h = av[s8] * h + uv[s8]; Y[(rowbase + t0 + 8 * sg + s8) * DM + nb * 64 + sc] = (bf16_t)f2bf(h * bf2f(gq[s8])); }
        if (sg == 7) HC[((c + 1) & 1) * 64 + sc] = h;
    }
    __syncthreads();
}

namespace att {
constexpr float ATT_THR = 8.0f;
constexpr int LK0 = 0, LK1 = 8192, LV = 16384, LBUF = 32768  , LWS = 98304, LOX = 0;
__device__ __forceinline__ int crow(int r, int hi) { return (r & 3) + 8 * (r >> 2) + 4 * hi; }
__device__ __forceinline__ void glds16(const void* gsrc, unsigned lds_dst) { unsigned keep;
    asm volatile("s_mov_b32 %0, m0\n\ts_mov_b32 m0, %2\n\ts_nop 0\n\tglobal_load_lds_dwordx4 %1, off\n\ts_mov_b32 m0, %0" : "=&s"(keep) : "v"(gsrc), "s"(lds_dst) : "memory"); }
typedef __attribute__((address_space(3))) const char* lds_cptr;
typedef short v4i16_t __attribute__((ext_vector_type(4)));
__device__ __forceinline__ s16x4 vtr(lds_cptr p) { return __builtin_bit_cast(s16x4, __builtin_amdgcn_ds_read_tr16_b64_v4i16((__attribute__((address_space(3))) v4i16_t*)p)); }
template <int CTRL> __device__ __forceinline__ float dpp_f(float x) { return __int_as_float(__builtin_amdgcn_update_dpp(0, __float_as_int(x), CTRL, 0xf, 0xf, true)); }
__device__ __forceinline__ float rowmax_pos(const f32x16& p0, const f32x16& p1) {
    int a = 0, b = 0;
#pragma unroll
    for (int r = 0; r < 16; r += 2) { a = max(max(a, __float_as_int(p0[r])), __float_as_int(p0[r + 1])); b = max(max(b, __float_as_int(p1[r])), __float_as_int(p1[r + 1])); }
    a = max(a, b);
    unsigned ua = (unsigned)a, ub = ua; swap_rows32(ua, ub);
    return __int_as_float(max((int)ua, (int)ub));
}
__device__ __forceinline__ void attn_unit(Frame& F, int b, int h, int qb, float lam) {
    int lane = F.lane; asm volatile("" : "+v"(lane));
    const int r32 = lane & 31, hi = lane >> 5, wid = F.wave, mp = wid >> 2, wq = wid & 3;
    const bf16_t* Q = (const bf16_t*)(F.ws + WS_Q); const bf16_t* K = (const bf16_t*)(F.ws + WS_K); const bf16_t* V = (const bf16_t*)(F.ws + WS_V); bf16_t* Y = (bf16_t*)(F.ws + WS_Y);
    const float* subg = F.in(16);
    char* shm = (char*)F.lds;
    const unsigned lds0 = (unsigned)(uintptr_t)shm;
    const size_t rowbase = (size_t)b * SEQ; const int q0 = qb * 128;
    const int NT = 2 * (qb + 1);
    float* wsf = (float*)(shm + LWS) + wid * 64;
    bf16x8 qr[4];
    { const bf16_t* Qw = Q + (rowbase + q0 + wq * 32 + r32) * 512 + h * 128 + mp * 64;
#pragma unroll
      for (int d0 = 0; d0 < 4; ++d0) qr[d0] = *(const bf16x8*)(Qw + d0 * 16 + hi * 8); }
    const bf16_t* ks0 = K + (rowbase + lane) * 512 + h * 128 + wid * 8;
    const bf16_t* ks1 = ks0 + 64;
    const bf16_t* vs0 = V + (rowbase + 16 * (wid & 3) + (lane >> 2)) * 512 + h * 128 + (wid >> 2) * 32 + (lane & 3) * 8;
    const bf16_t* vs1 = vs0 + 64;
    const unsigned kd0 = (unsigned)__builtin_amdgcn_readfirstlane(lds0 + LK0 + wid * 1024), kd1 = (unsigned)__builtin_amdgcn_readfirstlane(lds0 + LK1 + wid * 1024);
    const unsigned vd0 = (unsigned)__builtin_amdgcn_readfirstlane(lds0 + LV + wid * 1024), vd1 = (unsigned)__builtin_amdgcn_readfirstlane(lds0 + LV + (wid + 8) * 1024);
    const lds_cptr shm3 = (lds_cptr)(F.lds);
    const lds_cptr kp0 = shm3 + (mp ? LK1 : LK0) + hi * 1024 + r32 * 16;
    const lds_cptr vp0 = shm3 + LV + ((lane >> 4) & 1) * 32 + (lane & 3) * 8 + (4 * hi + ((lane & 15) >> 2)) * 64;
    f32x16 negm = f32x16{}; asm volatile("" : "+v"(negm));
    float m_run = 0.f, l_run = 0.f;
    f32x16 o[4];
#pragma unroll
    for (int d = 0; d < 4; ++d) o[d] = f32x16{};
    const int qrel = wq * 32 + r32;
    glds16(ks0, kd0); glds16(ks1, kd1); glds16(vs0, vd0); glds16(vs1, vd1);
    asm volatile("" : "+v"(qr[0]), "+v"(qr[1]), "+v"(qr[2]), "+v"(qr[3]));
    f32x16 p0, p1;
    u32x4 pw[4];
    int bcur = 0, bprev = 0, bnext = LBUF;
#define ATT_QK(P0, P1, slot) do { _Pragma("unroll") for (int d0 = 0; d0 < 4; ++d0) { \
        const bf16x8 k0f = *(const __attribute__((address_space(3))) bf16x8*)(kp0 + (slot) + d0 * 2048); \
        const bf16x8 k1f = *(const __attribute__((address_space(3))) bf16x8*)(kp0 + (slot) + d0 * 2048 + 512); \
        if (d0 == 0) { P0 = __builtin_amdgcn_mfma_f32_32x32x16_bf16(k0f, qr[0], negm, 0, 0, 0); P1 = __builtin_amdgcn_mfma_f32_32x32x16_bf16(k1f, qr[0], negm, 0, 0, 0); } \
        else { P0 = __builtin_amdgcn_mfma_f32_32x32x16_bf16(k0f, qr[d0], P0, 0, 0, 0); P1 = __builtin_amdgcn_mfma_f32_32x32x16_bf16(k1f, qr[d0], P1, 0, 0, 0); } } } while (0)
#define ATT_MASK(P0, P1, t) do { if ((t) >= NT - 2) { const int kb_ = 64 * ((t) - (NT - 2)) + 4 * hi; \
        _Pragma("unroll") for (int r = 0; r < 16; ++r) { const int kv = kb_ + (r & 3) + 8 * (r >> 2); if (kv > qrel) P0[r] = -INFINITY; if (kv + 32 > qrel) P1[r] = -INFINITY; } } } while (0)
#define ATT_SUMPACK(P0, P1) do { float sacc = 0.f; _Pragma("unroll") for (int r = 0; r < 16; ++r) sacc += P0[r] + P1[r]; l_run += sacc; \
        pw[0] = (u32x4){cvt_pk_bf16(P0[0], P0[1]), cvt_pk_bf16(P0[2], P0[3]), cvt_pk_bf16(P0[4], P0[5]), cvt_pk_bf16(P0[6], P0[7])}; \
        pw[1] = (u32x4){cvt_pk_bf16(P0[8], P0[9]), cvt_pk_bf16(P0[10], P0[11]), cvt_pk_bf16(P0[12], P0[13]), cvt_pk_bf16(P0[14], P0[15])}; \
        pw[2] = (u32x4){cvt_pk_bf16(P1[0], P1[1]), cvt_pk_bf16(P1[2], P1[3]), cvt_pk_bf16(P1[4], P1[5]), cvt_pk_bf16(P1[6], P1[7])}; \
        pw[3] = (u32x4){cvt_pk_bf16(P1[8], P1[9]), cvt_pk_bf16(P1[10], P1[11]), cvt_pk_bf16(P1[12], P1[13]), cvt_pk_bf16(P1[14], P1[15])}; } while (0)
#define ATT_PV(slot) do { _Pragma("unroll") for (int db = 0; db < 4; ++db) { _Pragma("unroll") for (int ks = 0; ks < 4; ++ks) { \
        const s16x4 lo = vtr(vp0 + (slot) + db * 4096 + ks * 1024), hh = vtr(vp0 + (slot) + db * 4096 + ks * 1024 + 512); \
        const bf16x8 vf = (bf16x8){lo[0], lo[1], lo[2], lo[3], hh[0], hh[1], hh[2], hh[3]}; \
        o[db] = __builtin_amdgcn_mfma_f32_32x32x16_bf16(__builtin_bit_cast(bf16x8, pw[ks]), vf, o[db], 0, 0, 0); } } } while (0)
#define ATT_DECIDE(P0, P1, moved) do { const float rm = rowmax_pos(P0, P1); moved = false; \
        if (__any(rm > ATT_THR)) { const float dl = rm; m_run += dl; \
            _Pragma("unroll") for (int r = 0; r < 16; ++r) { P0[r] -= dl; P1[r] -= dl; negm[r] = -m_run; } \
            asm volatile("" : "+v"(negm)); \
            const float f = __builtin_amdgcn_exp2f(-dl); l_run *= f; if (hi == 0) wsf[r32] = f; moved = true; } } while (0)
#define ATT_RESCALE_O() do { asm volatile("s_waitcnt lgkmcnt(0)" ::: "memory"); _Pragma("unroll") for (int r = 0; r < 16; ++r) { const float fr_ = wsf[crow(r, hi)]; \
        _Pragma("unroll") for (int d = 0; d < 4; ++d) o[d][r] *= fr_; } } while (0)
    asm volatile("s_waitcnt vmcnt(0) lgkmcnt(0)" ::: "memory"); __builtin_amdgcn_s_barrier(); asm volatile("" ::: "memory");
    { const size_t go = (size_t)1 * 64 * 512; glds16(ks0 + go, kd0 + LBUF); glds16(ks1 + go, kd1 + LBUF); glds16(vs0 + go, vd0 + LBUF); glds16(vs1 + go, vd1 + LBUF); }
    ATT_QK(p0, p1, 0); ATT_MASK(p0, p1, 0);
    { bool moved; ATT_DECIDE(p0, p1, moved); (void)moved; }
#pragma unroll
    for (int r = 0; r < 16; ++r) { p0[r] = __builtin_amdgcn_exp2f(p0[r]); p1[r] = __builtin_amdgcn_exp2f(p1[r]); }
    bprev = 0; bcur = LBUF; bnext = 2 * LBUF;
#define SBAR() __builtin_amdgcn_sched_barrier(0)
#define PIN1(x) asm volatile("" : "+v"(x))
#define KRD(j, slot) (*(const __attribute__((address_space(3))) bf16x8*)(kp0 + (slot) + ((j) >> 1) * 2048 + ((j) & 1) * 512))
#define VRDF(i, slot) do { vlo[(i) % 3] = vtr(vp0 + (slot) + ((i) >> 2) * 4096 + ((i) & 3) * 1024); vhi[(i) % 3] = vtr(vp0 + (slot) + ((i) >> 2) * 4096 + ((i) & 3) * 1024 + 512); } while (0)
#define VFRG(i) (bf16x8){vlo[(i) % 3][0], vlo[(i) % 3][1], vlo[(i) % 3][2], vlo[(i) % 3][3], vhi[(i) % 3][0], vhi[(i) % 3][1], vhi[(i) % 3][2], vhi[(i) % 3][3]}
#define GAPA(j, N0, N1, slot, PA, B, PWW, W0, W1) do { \
        if ((j) == 0) N0 = __builtin_amdgcn_mfma_f32_32x32x16_bf16(kf[0], qr[0], negm, 0, 0, 0); \
        else if ((j) == 1) N1 = __builtin_amdgcn_mfma_f32_32x32x16_bf16(kf[1], qr[0], negm, 0, 0, 0); \
        else if (((j) & 1) == 0) N0 = __builtin_amdgcn_mfma_f32_32x32x16_bf16(kf[(j) % 3], qr[(j) >> 1], N0, 0, 0, 0); \
        else N1 = __builtin_amdgcn_mfma_f32_32x32x16_bf16(kf[(j) % 3], qr[(j) >> 1], N1, 0, 0, 0); \
        if ((j) + 2 < 8) kf[((j) + 2) % 3] = KRD((j) + 2, slot); \
        sacc += PA[B]; sacc += PA[B + 1]; sacc += PA[B + 2]; sacc += PA[B + 3]; PIN1(sacc); \
        PWW[W0] = cvt_pk_bf16(PA[B], PA[B + 1]); PWW[W1] = cvt_pk_bf16(PA[B + 2], PA[B + 3]); PIN1(PWW); SBAR(); } while (0)
#define GAPB(i, slot, X, NX, B) do { \
        o[(i) >> 2] = __builtin_amdgcn_mfma_f32_32x32x16_bf16(__builtin_bit_cast(bf16x8, pw[(i) & 3]), VFRG(i), o[(i) >> 2], 0, 0, 0); \
        if ((i) + 2 < 16) VRDF((i) + 2, slot); \
        X[B] = __builtin_amdgcn_exp2f(NX[B]); X[B + 1] = __builtin_amdgcn_exp2f(NX[B + 1]); PIN1(X); SBAR(); } while (0)
#define ATT_STEP(t, MASKED) do { \
        asm volatile("s_waitcnt vmcnt(0) lgkmcnt(0)" ::: "memory"); \
        __builtin_amdgcn_s_barrier(); \
        asm volatile("" ::: "memory"); \
        if ((t) + 1 < NT) { const size_t go = (size_t)((t) + 1) * 64 * 512; const unsigned b1 = (unsigned)bnext; \
            glds16(ks0 + go, kd0 + b1); glds16(ks1 + go, kd1 + b1); glds16(vs0 + go, vd0 + b1); glds16(vs1 + go, vd1 + b1); } \
        SBAR(); \
        f32x16 n0, n1; bf16x8 kf[3]; s16x4 vlo[3], vhi[3]; float sacc = 0.f; u32x4 q0_, q1_, q2_, q3_; \
        kf[0] = KRD(0, bcur); kf[1] = KRD(1, bcur); SBAR(); \
        GAPA(0, n0, n1, bcur, p0, 0, q0_, 0, 1); GAPA(1, n0, n1, bcur, p0, 4, q0_, 2, 3); GAPA(2, n0, n1, bcur, p0, 8, q1_, 0, 1); GAPA(3, n0, n1, bcur, p0, 12, q1_, 2, 3); \
        GAPA(4, n0, n1, bcur, p1, 0, q2_, 0, 1); GAPA(5, n0, n1, bcur, p1, 4, q2_, 2, 3); GAPA(6, n0, n1, bcur, p1, 8, q3_, 0, 1); GAPA(7, n0, n1, bcur, p1, 12, q3_, 2, 3); \
        l_run += sacc; pw[0] = q0_; pw[1] = q1_; pw[2] = q2_; pw[3] = q3_; \
        VRDF(0, bprev); VRDF(1, bprev); SBAR();                         \
        if (MASKED) ATT_MASK(n0, n1, t); \
        bool moved; ATT_DECIDE(n0, n1, moved); \
        SBAR(); \
        GAPB(0, bprev, p0, n0, 0); GAPB(1, bprev, p0, n0, 2); GAPB(2, bprev, p0, n0, 4); GAPB(3, bprev, p0, n0, 6); \
        GAPB(4, bprev, p0, n0, 8); GAPB(5, bprev, p0, n0, 10); GAPB(6, bprev, p0, n0, 12); GAPB(7, bprev, p0, n0, 14); \
        GAPB(8, bprev, p1, n1, 0); GAPB(9, bprev, p1, n1, 2); GAPB(10, bprev, p1, n1, 4); GAPB(11, bprev, p1, n1, 6); \
        GAPB(12, bprev, p1, n1, 8); GAPB(13, bprev, p1, n1, 10); GAPB(14, bprev, p1, n1, 12); GAPB(15, bprev, p1, n1, 14); \
        if (moved) ATT_RESCALE_O(); \
        bprev = bcur; bcur = bnext; bnext = (bnext == 2 * LBUF) ? 0 : bnext + LBUF; } while (0)
    { int t = 1;
      for (; t < NT - 2; ++t) ATT_STEP(t, false);
      for (; t < NT; ++t) ATT_STEP(t, true); }
#undef ATT_STEP
#undef GAPA
#undef GAPB
#undef KRD
#undef VRDF
#undef VFRG
#undef SBAR
#undef PIN1
    ATT_SUMPACK(p0, p1);
    ATT_PV(bprev);
#undef ATT_QK
#undef ATT_MASK
#undef ATT_SUMPACK
#undef ATT_PV
#undef ATT_DECIDE
#undef ATT_RESCALE_O
    l_run = add_xor32(l_run);
    if (hi == 0) wsf[32 + r32] = l_run;
    asm volatile("s_waitcnt lgkmcnt(0)" ::: "memory");
    f32x16 rliv;
#pragma unroll
    for (int g = 0; g < 4; ++g) { const f32x4 lv = *(const f32x4*)(wsf + 32 + 8 * g + 4 * hi);
#pragma unroll
        for (int j = 0; j < 4; ++j) rliv[4 * g + j] = __builtin_amdgcn_rcpf(lv[j]); }
    __syncthreads();
    float* ox = (float*)(shm + LOX) + wq * 4096;
    if (mp == 1) {
#pragma unroll
        for (int db = 0; db < 4; ++db) { const f32x16 t = o[db] * rliv;
#pragma unroll
            for (int g = 0; g < 4; ++g) *(f32x4*)(ox + ((db * 4 + g) * 64 + lane) * 4) = (f32x4){t[4 * g], t[4 * g + 1], t[4 * g + 2], t[4 * g + 3]}; }
    }
    __syncthreads();
    if (mp == 0) {
        f32x16 ssv = f32x16{};
#pragma unroll
        for (int db = 0; db < 4; ++db) { f32x16 x1;
#pragma unroll
            for (int g = 0; g < 4; ++g) { const f32x4 t = *(const f32x4*)(ox + ((db * 4 + g) * 64 + lane) * 4); x1[4 * g] = t[0]; x1[4 * g + 1] = t[1]; x1[4 * g + 2] = t[2]; x1[4 * g + 3] = t[3]; }
            const f32x16 v = o[db] * rliv - x1 * lam; o[db] = v; ssv = v * v + ssv; }
#pragma unroll
        for (int r = 0; r < 16; ++r) { float sv = ssv[r];
            sv += dpp_f<0xB1>(sv); sv += dpp_f<0x4E>(sv); sv += dpp_f<0x141>(sv); sv += dpp_f<0x140>(sv);
            sv = add_xor16(sv);
            ssv[r] = 0.8f * __builtin_amdgcn_rsqf(sv * (1.0f / 128.0f) + EPS); }
        float sg[4];
#pragma unroll
        for (int db = 0; db < 4; ++db) sg[db] = subg[32 * db + r32];
        bf16_t* stg = (bf16_t*)ox;
#pragma unroll
        for (int db = 0; db < 4; ++db) { const f32x16 t = o[db] * (ssv * sg[db]);
#pragma unroll
            for (int r = 0; r < 16; r += 2) { const unsigned w = cvt_pk_bf16(t[r], t[r + 1]);
                stg[crow(r, hi) * 128 + 32 * db + r32] = (bf16_t)(w & 0xffffu); stg[crow(r + 1, hi) * 128 + 32 * db + r32] = (bf16_t)(w >> 16); } }
        asm volatile("s_waitcnt lgkmcnt(0)" ::: "memory");
        bf16_t* yb = Y + (rowbase + q0 + wq * 32) * DM + 512 + h * 128;
#pragma unroll
        for (int i = 0; i < 8; ++i) { const int q = lane + 64 * i, row = q >> 4, pc = q & 15;
            const u32x4 v = *(const u32x4*)(stg + row * 128 + pc * 8);
            *(u32x4*)(yb + (size_t)row * DM + pc * 8) = v; }
    }
}
constexpr int NQUEUE = 128 + 1024 + NCONV;
__device__ __forceinline__ void mixer_phase(Frame& F) {
    const float* lq1 = F.in(12); const float* lk1 = F.in(13); const float* lq2 = F.in(14); const float* lk2 = F.in(15);
    float a1 = lq1[F.lane] * lk1[F.lane], a2 = lq2[F.lane] * lk2[F.lane];
    a1 = wave_sum(a1); a2 = wave_sum(a2);
    const float lam = expf(a1) - expf(a2) + 0.2f;
    unsigned* qhead = (unsigned*)(F.ws + WS_CTL) + CW_QUEUE;
    volatile LAS unsigned* slot = (volatile LAS unsigned*)(F.lds + LDS_MISC) + 16;
    for (;;) {
        if (F.tid == 0) slot[0] = __hip_atomic_fetch_add(qhead, 1u, __ATOMIC_RELAXED, __HIP_MEMORY_SCOPE_AGENT);
        __syncthreads();
        const int u = (int)__builtin_amdgcn_readfirstlane(slot[0]);
        if (u >= NQUEUE) break;
        if (u < 128) { rglru_item(F, u); continue; }
        const int v = u - 128;
        if (v < 2 * NCONV && (v & 1)) { conv_unit<8>(F, v >> 1, 0); __syncthreads(); continue; }
        const int idx = (v < 2 * NCONV) ? (v >> 1) : v - NCONV, qb = 15 - (idx >> 6), bh = idx & 63;
        attn_unit(F, bh >> 2, bh & 3, qb, lam); __syncthreads();
    }
    __syncthreads();
}
}

struct ProbOutProj {
    static constexpr bool FP8 = false;
    pg8::StaticOrder S; const char* A; const char* Bt; const bf16_t* xb; bf16_t* x1h; unsigned char* x1q; LAS unsigned char* lds;
    __device__ __forceinline__ bool next(int i, pg8::Unit& u) const { u.e = 0; u.tt = 0; return S.next(i, u.pm, u.pn); }
    __device__ __forceinline__ const char* abase(const pg8::Unit& u) const { return A + (size_t)u.pm * 256 * DM * 2; }
    __device__ __forceinline__ void aoff(const pg8::Unit& u, const int (&R)[2], const int (&C)[2], unsigned (&vo)[2][2]) const {
#pragma unroll
        for (int h = 0; h < 2; ++h)
#pragma unroll
            for (int i = 0; i < 2; ++i) vo[h][i] = (unsigned)((h * 128 + R[i]) * DM + C[i]) * 2u;
    }
    __device__ __forceinline__ const char* bptr(const pg8::Unit& u) const { return Bt + (size_t)u.pn * 256 * DM * 2; }
    __device__ __forceinline__ float pre(const pg8::Unit&, int) const { return 0.f; }
    __device__ __forceinline__ void epi(f32x4 (&acc)[2][2][4][2], const pg8::Unit& u, int wr, int wc, int fr, int fq, float) const {
        const int tid = (wr * 4 + wc) * 64 + fq * 16 + fr;
        const size_t tile0 = (size_t)u.pm * 256 * DM + (size_t)u.pn * 256;
        u32x4 xres[8][2];
#pragma unroll
        for (int c = 0; c < 8; ++c)
#pragma unroll
            for (int j = 0; j < 2; ++j) { const int p = tid + 512 * j, r2 = p >> 5, pi = p & 31;
                xres[c][j] = *(const u32x4*)(xb + tile0 + (size_t)((c >> 2) * 128 + (r2 >> 4) * 64 + (c & 3) * 16 + (r2 & 15)) * DM + pi * 8); }
#pragma unroll
        for (int ai = 0; ai < 2; ++ai)
#pragma unroll
            for (int m = 0; m < 4; ++m) { const int c = ai * 4 + m;
                LAS unsigned char* buf = lds + ((c & 1) ? STG_BUF1 : STG_BUF0);
                const int rl = wr * 16 + fr, p0 = wc * 4 + fq;
#pragma unroll
                for (int bj = 0; bj < 2; ++bj) { const f32x4 v0 = acc[ai][bj][m][0], v1 = acc[ai][bj][m][1];
                    u32x4 w; w.x = cvt_pk_bf16(v0[0], v0[1]); w.y = cvt_pk_bf16(v0[2], v0[3]); w.z = cvt_pk_bf16(v1[0], v1[1]); w.w = cvt_pk_bf16(v1[2], v1[3]);
                    *(LAS u32x4*)(buf + rl * 512 + (((bj * 16 + p0) ^ (rl & 7)) << 4)) = w; }
                asm volatile("s_waitcnt lgkmcnt(0)" ::: "memory"); __builtin_amdgcn_s_barrier(); asm volatile("" ::: "memory");
#pragma unroll
                for (int j = 0; j < 2; ++j) { const int p = tid + 512 * j, r2 = p >> 5, pi = p & 31;
                    const u32x4 a = *(const LAS u32x4*)(buf + r2 * 512 + ((pi ^ (r2 & 7)) << 4));
                    const size_t off = tile0 + (size_t)(ai * 128 + (r2 >> 4) * 64 + m * 16 + (r2 & 15)) * DM + pi * 8;
                    const u32x4 xv = xres[c][j];
                    const unsigned aw[4] = {a.x, a.y, a.z, a.w}, xw[4] = {xv.x, xv.y, xv.z, xv.w};
                    float v[8];
#pragma unroll
                    for (int q = 0; q < 4; ++q) { v[2 * q] = bf2f(aw[q] & 0xffffu) + bf2f(xw[q] & 0xffffu); v[2 * q + 1] = bf2f(aw[q] >> 16) + bf2f(xw[q] >> 16); }
                    u32x4 hb; hb.x = cvt_pk_bf16(v[0], v[1]); hb.y = cvt_pk_bf16(v[2], v[3]); hb.z = cvt_pk_bf16(v[4], v[5]); hb.w = cvt_pk_bf16(v[6], v[7]);
                    *(u32x4*)(x1h + off) = hb;
                    u32x2 w8; w8.x = pack_fp8x4(v[0], v[1], v[2], v[3]); w8.y = pack_fp8x4(v[4], v[5], v[6], v[7]);
                    *(u32x2*)(x1q + off) = w8; } }
    }
};

__device__ __forceinline__ void p5_router(Frame& F) {
    const int lane = F.lane, r32 = lane & 31, hi = lane >> 5, wid = F.wave, tl = wid & 3, kh = wid >> 2, tid = F.tid;
    const bf16_t* x1 = (const bf16_t*)(F.ws + WS_X1H); const bf16_t* WRH = (const bf16_t*)(F.ws + WS_WRH); const bf16_t* WRL = (const bf16_t*)(F.ws + WS_WRL);
    const float* rb = F.in(20);
    unsigned* ctl = (unsigned*)(F.ws + WS_CTL);
    int* LIST = (int*)(F.ws + WS_LIST); float* GATES = (float*)(F.ws + WS_GATES); float* RS2 = (float*)(F.ws + WS_RSTD2); int* POSI = (int*)(F.ws + WS_POSI);
    LAS float* T = (LAS float*)(F.lds);
    LAS float* SS = (LAS float*)(F.lds + 2 * 4 * 32 * 33 * 4);
    LAS unsigned* CNTL = (LAS unsigned*)(F.lds + 2 * 4 * 32 * 33 * 4 + 1024);
    float rbv[8];
#pragma unroll
    for (int j = 0; j < 8; ++j) rbv[j] = rb[8 * (tid & 3) + j];
    for (int blk = F.vcu; blk < MTOK / 128; blk += F.G) {
        const int R0 = blk * 128;
        if (tid < 32) CNTL[tid] = 0u;
        f32x16 acc = f32x16{}; float ssq = 0.f;
        const bf16_t* xrow = x1 + (size_t)(R0 + tl * 32 + r32) * DM + kh * 512 + hi * 8;
        const bf16_t* wh = WRH + r32 * DM + kh * 512 + hi * 8; const bf16_t* wl = WRL + r32 * DM + kh * 512 + hi * 8;
#pragma unroll 8
        for (int s = 0; s < 32; ++s) {
            const u32x4 xa = *(const u32x4*)(xrow + 16 * s);
            const unsigned xw[4] = {xa.x, xa.y, xa.z, xa.w};
#pragma unroll
            for (int j = 0; j < 4; ++j) { const float a = bf2f(xw[j] & 0xffffu), b = bf2f(xw[j] >> 16); ssq += a * a + b * b; }
            const bf16x8 bh = *(const bf16x8*)(wh + 16 * s), bl = *(const bf16x8*)(wl + 16 * s);
            acc = __builtin_amdgcn_mfma_f32_32x32x16_bf16(__builtin_bit_cast(bf16x8, xa), bh, acc, 0, 0, 0);
            acc = __builtin_amdgcn_mfma_f32_32x32x16_bf16(__builtin_bit_cast(bf16x8, xa), bl, acc, 0, 0, 0);
        }
        ssq = add_xor32(ssq);
#pragma unroll
        for (int r = 0; r < 16; ++r) T[((kh * 4 + tl) * 32 + att::crow(r, hi)) * 33 + r32] = acc[r];
        if (hi == 0) SS[(kh * 4 + tl) * 32 + r32] = ssq;
        __syncthreads();
        int ek[4]; float gk[4]; unsigned rk[4] = {0u, 0u, 0u, 0u}; float rstd2;
        const int srow = tid >> 2, sq = tid & 3;
        {
            const int tile = srow >> 5, rr = srow & 31;
            rstd2 = __builtin_amdgcn_rsqf((SS[tile * 32 + rr] + SS[(4 + tile) * 32 + rr]) * (1.0f / DM) + EPS);
            const LAS float* ta = T + (tile * 32 + rr) * 33 + 8 * sq; const LAS float* tb = T + ((4 + tile) * 32 + rr) * 33 + 8 * sq;
            float v[8];
#pragma unroll
            for (int j = 0; j < 8; ++j) v[j] = (ta[j] + tb[j]) * rstd2 + rbv[j];
            float vk[4];
#pragma unroll
            for (int k = 0; k < 4; ++k) { float best = -INFINITY; int be = 8 * sq;
#pragma unroll
                for (int j = 0; j < 8; ++j) if (v[j] > best) { best = v[j]; be = 8 * sq + j; }
                { const float ob = att::dpp_f<0xB1>(best); const int oe = __builtin_amdgcn_update_dpp(0, be, 0xB1, 0xf, 0xf, true); if (ob > best || (ob == best && oe < be)) { best = ob; be = oe; } }
                { const float ob = att::dpp_f<0x4E>(best); const int oe = __builtin_amdgcn_update_dpp(0, be, 0x4E, 0xf, 0xf, true); if (ob > best || (ob == best && oe < be)) { best = ob; be = oe; } }
                ek[k] = be; vk[k] = best;
#pragma unroll
                for (int j = 0; j < 8; ++j) if (be == 8 * sq + j) v[j] = -INFINITY; }
            float den = 0.f;
#pragma unroll
            for (int k = 0; k < 4; ++k) { gk[k] = __expf(vk[k] - vk[0]); den += gk[k]; }
            const float rden = 1.0f / den;
#pragma unroll
            for (int k = 0; k < 4; ++k) { gk[k] *= rden; if (sq == 0) rk[k] = __hip_atomic_fetch_add(CNTL + ek[k], 1u, __ATOMIC_RELAXED, __HIP_MEMORY_SCOPE_WORKGROUP); }
        }
        __syncthreads();
        if (tid < 32) { const unsigned n = CNTL[tid]; CNTL[32 + tid] = n ? atomicAdd(ctl + CW_CNT + 64 * tid, n) : 0u; }
        __syncthreads();
        if (sq == 0) {
            const int tok = R0 + srow;
            RS2[tok] = rstd2;
#pragma unroll
            for (int k = 0; k < 4; ++k) { const int li = (int)(CNTL[32 + ek[k]] + rk[k]); LIST[(size_t)ek[k] * MTOK + li] = tok * 4 + k; GATES[tok * 4 + k] = gk[k]; POSI[tok * 4 + k] = (ek[k] << 15) | li; }
        }
        __syncthreads();
    }
}

constexpr int MOE_MAXS = 24;
struct MoeSched { LAS int* TB; LAS int* TE; LAS int* TAB; int tlo, thi, mt, pn, mpb; };
constexpr int MOE_CNTS = 25600 / 4;
__device__ __forceinline__ void moe_prefix(Frame& F, LAS int* TB) {
    const unsigned* ctl = (const unsigned*)(F.ws + WS_CTL);
    if (F.tid < 64) {
        const int e = F.tid; const int c = (e < NEXP) ? (int)__hip_atomic_load(ctl + CW_CNT + 64 * (e & 31), __ATOMIC_RELAXED, __HIP_MEMORY_SCOPE_AGENT) : 0;
        const int tiles = (c + 255) >> 8; int incl = tiles;
#pragma unroll
        for (int o = 1; o < 32; o <<= 1) { const int y = __shfl_up(incl, o); if (e >= o) incl += y; }
        if (e < NEXP) { TB[e] = incl - tiles; TB[MOE_CNTS + e] = c; }
        if (e == NEXP - 1) TB[NEXP] = incl;
    }
    __syncthreads();
}
template <int NPN, bool TABLE>
__device__ __forceinline__ MoeSched moe_setup(Frame& F) {
    MoeSched M;
    M.TB = (LAS int*)(F.lds + LDS_AUX); M.TE = M.TB + 40; M.TAB = M.TB + 64;
    moe_prefix(F, M.TB);
    const int T = __builtin_amdgcn_readfirstlane(M.TB[NEXP]), x = F.vcu >> 5, i = F.vcu & 31;
    M.mpb = 32 / NPN; M.mt = __builtin_amdgcn_readfirstlane(i / NPN); M.pn = __builtin_amdgcn_readfirstlane(i % NPN);
    M.tlo = __builtin_amdgcn_readfirstlane((x * T) >> 3); M.thi = __builtin_amdgcn_readfirstlane(((x + 1) * T) >> 3);
    const int* LIST = (const int*)(F.ws + WS_LIST); const float* RS2 = (const float*)(F.ws + WS_RSTD2);
    if (F.tid < MOE_MAXS) { const int t = M.tlo + F.tid * M.mpb + M.mt; int e = 0; if (t < M.thi) { for (int q = 0; q < NEXP; ++q) if (M.TB[q + 1] <= t) e = q + 1; } M.TE[F.tid] = e; }
    __syncthreads();
    if (TABLE) {
        constexpr int NIT = MOE_MAXS * 256 / NTHR;
        int lst[NIT];
#pragma unroll
        for (int it = 0; it < NIT; ++it) { const int idx = F.tid + NTHR * it, s = idx >> 8, r = idx & 255, t = M.tlo + s * M.mpb + M.mt;
            const int e = M.TE[s]; const int li = (t - M.TB[e]) * 256 + r;
            lst[it] = (t < M.thi && li < M.TB[MOE_CNTS + e]) ? LIST[(size_t)e * MTOK + li] : -1; }
        float rsv[NIT];
#pragma unroll
        for (int it = 0; it < NIT; ++it) rsv[it] = (lst[it] >= 0) ? RS2[lst[it] >> 2] : 0.f;
#pragma unroll
        for (int it = 0; it < NIT; ++it) M.TAB[F.tid + NTHR * it] = (lst[it] >= 0) ? ((lst[it] >> 2) | (int)((f2bf(rsv[it]) & 0x7fffu) << 15)) : 0;
    }
    __syncthreads();
    return M;
}
struct ProbMoe1 {
    static constexpr bool FP8 = true;
    MoeSched M; const char* A; const char* W; const float* b1; unsigned char* act; LAS unsigned char* lds;
    __device__ __forceinline__ bool next(int s, pg8::Unit& u) const { const int t = __builtin_amdgcn_readfirstlane(M.tlo + s * M.mpb + M.mt); if (s >= MOE_MAXS || t >= __builtin_amdgcn_readfirstlane(M.thi)) return false; u.pn = M.pn; u.pm = t; u.tt = s;
        u.e = __builtin_amdgcn_readfirstlane(M.TE[s]); return true; }
    __device__ __forceinline__ const char* abase(const pg8::Unit&) const { return A; }
    __device__ __forceinline__ void aoff(const pg8::Unit& u, const int (&R)[2], const int (&C)[2], unsigned (&vo)[2][2]) const {
#pragma unroll
        for (int h = 0; h < 2; ++h)
#pragma unroll
            for (int i = 0; i < 2; ++i) vo[h][i] = (unsigned)((M.TAB[u.tt * 256 + h * 128 + R[i]] & 0x7fff) * DM + C[i] * 2);
    }
    __device__ __forceinline__ const char* bptr(const pg8::Unit& u) const { return W + ((size_t)u.e * 2 * DFF + (size_t)u.pn * 256) * DM; }
    __device__ __forceinline__ float pre(const pg8::Unit& u, int tid) const { const int t = tid & 255; return ld_untracked(b1 + (size_t)u.e * 2 * DFF + u.pn * 128 + (t & 127) + ((t >> 7) ? DFF : 0)); }
    __device__ __forceinline__ void epi(f32x4 (&acc)[2][2][4][2], const pg8::Unit& u, int wr, int wc, int fr, int fq, float pf) const {
        asm volatile("s_nop 15\n\ts_nop 7" ::: "memory");
        const int rl0 = wr * 64 + fr, cj = u.pn * 128 + wc * 32 + 8 * fq;
        LAS float* pfx = (LAS float*)(lds + LDS_PFX);
        if (wr == 0) pfx[wc * 64 + fq * 16 + fr] = pf;
        asm volatile("s_waitcnt lgkmcnt(0)" ::: "memory"); __builtin_amdgcn_s_barrier(); asm volatile("" ::: "memory");
        const LAS float* bg = pfx + wc * 32 + 8 * fq; const LAS float* bu = bg + 128;
        constexpr float CS = -1.702f * LOG2E, KA = ASCALE / CS;
        f32x4 bg0 = *(const LAS f32x4*)bg, bg1 = *(const LAS f32x4*)(bg + 4); const f32x4 bu0 = *(const LAS f32x4*)bu, bu1 = *(const LAS f32x4*)(bu + 4);
        bg0 = bg0 * CS; bg1 = bg1 * CS;
#pragma unroll
        for (int ai = 0; ai < 2; ++ai)
#pragma unroll
            for (int m = 0; m < 4; ++m) { const int rl = rl0 + ai * 128 + m * 16; const float rs = bf2f((unsigned)M.TAB[u.tt * 256 + rl] >> 15) * (1.0f / WSCALE), rsc = rs * CS;
                float a[8];
#pragma unroll
                for (int n = 0; n < 2; ++n)
#pragma unroll
                    for (int jp = 0; jp < 2; ++jp) {
                        const f32x2 ag = {acc[ai][0][m][n][2 * jp], acc[ai][0][m][n][2 * jp + 1]}, au = {acc[ai][1][m][n][2 * jp], acc[ai][1][m][n][2 * jp + 1]};
                        const f32x2 bgp = n ? (f32x2){bg1[2 * jp], bg1[2 * jp + 1]} : (f32x2){bg0[2 * jp], bg0[2 * jp + 1]};
                        const f32x2 bup = n ? (f32x2){bu1[2 * jp], bu1[2 * jp + 1]} : (f32x2){bu0[2 * jp], bu0[2 * jp + 1]};
                        const f32x2 z = ag * (f32x2){rsc, rsc} + bgp, hu = au * (f32x2){rs, rs} + bup;
                        const f32x2 zc = {fmaxf(z.x, 7.0f * CS), fmaxf(z.y, 7.0f * CS)};
                        const f32x2 up = {__builtin_amdgcn_fmed3f(hu.x, -7.0f, 7.0f), __builtin_amdgcn_fmed3f(hu.y, -7.0f, 7.0f)};
                        const f32x2 den = (f32x2){__builtin_amdgcn_exp2f(zc.x), __builtin_amdgcn_exp2f(zc.y)} + (f32x2){1.0f, 1.0f};
                        const f32x2 sg = {__builtin_amdgcn_rcpf(den.x), __builtin_amdgcn_rcpf(den.y)};
                        const f32x2 r = (zc * sg) * (up * (f32x2){KA, KA} + (f32x2){KA, KA});
                        a[4 * n + 2 * jp] = r.x; a[4 * n + 2 * jp + 1] = r.y; }
                u32x2 w; w.x = pack_fp8x4(a[0], a[1], a[2], a[3]); w.y = pack_fp8x4(a[4], a[5], a[6], a[7]);
                *(u32x2*)(act + ((size_t)u.pm * 256 + rl) * DFF + cj) = w; }
    }
};
struct ProbMoe2 {
    static constexpr bool FP8 = true;
    MoeSched M; const char* A; const char* W; const float* b2; unsigned char* ys; LAS unsigned char* lds;
    __device__ __forceinline__ bool next(int s, pg8::Unit& u) const { const int t = __builtin_amdgcn_readfirstlane(M.tlo + s * M.mpb + M.mt); if (s >= MOE_MAXS || t >= __builtin_amdgcn_readfirstlane(M.thi)) return false; u.pn = M.pn; u.pm = t; u.tt = s;
        u.e = __builtin_amdgcn_readfirstlane(M.TE[s]); return true; }
    __device__ __forceinline__ const char* abase(const pg8::Unit& u) const { return A + (size_t)u.pm * 256 * DFF; }
    __device__ __forceinline__ void aoff(const pg8::Unit& u, const int (&R)[2], const int (&C)[2], unsigned (&vo)[2][2]) const {
#pragma unroll
        for (int h = 0; h < 2; ++h)
#pragma unroll
            for (int i = 0; i < 2; ++i) vo[h][i] = (unsigned)((h * 128 + R[i]) * DFF + C[i] * 2);
    }
    __device__ __forceinline__ const char* bptr(const pg8::Unit& u) const { return W + ((size_t)u.e * DM + (size_t)u.pn * 256) * DFF; }
    __device__ __forceinline__ float pre(const pg8::Unit& u, int tid) const { return ld_untracked(b2 + (size_t)u.e * DM + u.pn * 256 + (tid & 255)); }
    __device__ __forceinline__ void epi(f32x4 (&acc)[2][2][4][2], const pg8::Unit& u, int wr, int wc, int fr, int fq, float pf) const {
        asm volatile("s_nop 15\n\ts_nop 7" ::: "memory");
        const int rl0 = wr * 64 + fr, col0 = u.pn * 256 + wc * 32 + 8 * fq;
        LAS float* pfx = (LAS float*)(lds + LDS_PFX);
        if (wr == 0) pfx[wc * 64 + fq * 16 + fr] = pf;
        asm volatile("s_waitcnt lgkmcnt(0)" ::: "memory"); __builtin_amdgcn_s_barrier(); asm volatile("" ::: "memory");
        const LAS float* bp = pfx + wc * 32 + 8 * fq;
        f32x4 bv[2][2];
#pragma unroll
        for (int bj = 0; bj < 2; ++bj) { bv[bj][0] = *(const LAS f32x4*)(bp + bj * 128) * YSCALE; bv[bj][1] = *(const LAS f32x4*)(bp + bj * 128 + 4) * YSCALE; }
        constexpr float sc = YSCALE / (WSCALE * ASCALE);
        char* tbase = (char*)ys + ((size_t)u.pm * 256) * DM + u.pn * 256;
        const int tid = (wr * 4 + wc) * 64 + fq * 16 + fr;
#pragma unroll
        for (int ai = 0; ai < 2; ++ai)
#pragma unroll
            for (int mh = 0; mh < 2; ++mh) { const int c = ai * 2 + mh; LAS unsigned char* buf = lds + ((c & 1) ? STG_BUF1 : STG_BUF0);
#pragma unroll
                for (int ml = 0; ml < 2; ++ml) { const int m = mh * 2 + ml, rl = ml * 32 + wr * 16 + fr;
#pragma unroll
                    for (int bj = 0; bj < 2; ++bj) { const f32x4 v0 = acc[ai][bj][m][0] * sc + bv[bj][0], v1 = acc[ai][bj][m][1] * sc + bv[bj][1];
                        u32x2 w; w.x = pack_fp8x4(v0[0], v0[1], v0[2], v0[3]); w.y = pack_fp8x4(v1[0], v1[1], v1[2], v1[3]);
                        const int slot = bj * 16 + wc * 4 + fq;
                        *(LAS u32x2*)(buf + rl * 256 + ((slot ^ ((rl & 7) << 1)) << 3)) = w; } }
                asm volatile("s_waitcnt lgkmcnt(0)" ::: "memory"); __builtin_amdgcn_s_barrier(); asm volatile("" ::: "memory");
#pragma unroll
                for (int j = 0; j < 2; ++j) { const int p = tid + 512 * j, r2 = p >> 4, pi = p & 15;
                    const u32x4 v = *(const LAS u32x4*)(buf + r2 * 256 + (((2 * pi) ^ ((r2 & 7) << 1)) << 3));
                    const int trow = ai * 128 + ((r2 >> 4) & 1) * 64 + (mh * 2 + (r2 >> 5)) * 16 + (r2 & 15);
                    *(u32x4*)(tbase + (size_t)trow * DM + pi * 16) = v; } }
    }
};
static_assert(256 + MOE_MAXS * 256 * 4 <= 32768 - 512, "MoE tables fit the AUX region");

__device__ __forceinline__ void p8_combine(Frame& F) {
    const int gw = F.vcu * NWAVES + F.wave, NGW = F.G * NWAVES;
    LAS int* TB = (LAS int*)(F.lds + LDS_AUX);
    moe_prefix(F, TB);
    const unsigned char* YS = F.ws + WS_YB; const int* POSI = (const int*)(F.ws + WS_POSI); const float* GATES = (const float*)(F.ws + WS_GATES);
    const bf16_t* X1H = (const bf16_t*)(F.ws + WS_X1H);
    for (int m = gw; m < MTOK; m += NGW) {
        f32x4* op = (f32x4*)(F.out + (size_t)m * DM) + F.lane;
        const u32x2* xp = (const u32x2*)(X1H + (size_t)m * DM) + F.lane;
        const int pv = POSI[m * 4 + (F.lane & 3)]; const float gv = GATES[m * 4 + (F.lane & 3)] * (1.0f / YSCALE);
        f32x4 v[4];
#pragma unroll
        for (int j = 0; j < 4; ++j) { const u32x2 w = xp[64 * j]; v[j].x = bf2f(w.x & 0xffffu); v[j].y = bf2f(w.x >> 16); v[j].z = bf2f(w.y & 0xffffu); v[j].w = bf2f(w.y >> 16); }
#pragma unroll
        for (int k = 0; k < 4; ++k) { const int p = __builtin_amdgcn_readlane(pv, k); const float g = __builtin_bit_cast(float, __builtin_amdgcn_readlane(__builtin_bit_cast(int, gv), k));
            const int pos = TB[p >> 15] * 256 + (p & 32767);
            const unsigned* yp = (const unsigned*)(YS + (size_t)pos * DM) + F.lane;
#pragma unroll
            for (int j = 0; j < 4; ++j) { const unsigned w = yp[64 * j]; const f32x2 lo = __builtin_amdgcn_cvt_pk_f32_fp8(w, false), hi2 = __builtin_amdgcn_cvt_pk_f32_fp8(w, true);
                v[j].x += g * lo.x; v[j].y += g * lo.y; v[j].z += g * hi2.x; v[j].w += g * hi2.y; } }
#pragma unroll
        for (int j = 0; j < 4; ++j) op[64 * j] = v[j];
    }
}

typedef GAS unsigned gu32;
#define XB_TMO      128
#define XB_XCNT(j)  (256  + 64 * (j))
#define XB_XSUB(j)  (1280 + 64 * (j))
#define XB_XGEN(j)  (2304 + 64 * (j))
#define XB_TOP      3328
#define XB_TOPGEN   3392
#define XCD_BAR_WORDS 3456
#define XB_SPIN_CAP (1u << 20)
__device__ __forceinline__ unsigned xb_ld(unsigned* p)              { return __hip_atomic_load(p, __ATOMIC_RELAXED, __HIP_MEMORY_SCOPE_AGENT); }
__device__ __forceinline__ unsigned xb_add(unsigned* p, unsigned v) { return __hip_atomic_fetch_add(p, v, __ATOMIC_RELAXED, __HIP_MEMORY_SCOPE_AGENT); }
__device__ __forceinline__ unsigned xb_xcc_id() { return (unsigned)__builtin_amdgcn_s_getreg((3 << 11) | 20) & 0xFu; }
#define XB_SPIN(cond, bar) do { unsigned _sp = 0; while (cond) { __builtin_amdgcn_s_sleep(1); \
    if ((++_sp & 255u) == 0u) { if (xb_ld(&(bar)[XB_TMO])) break; if (_sp > XB_SPIN_CAP) { atomicAdd(&(bar)[XB_TMO], 1u); break; } } } } while (0)
struct XcdBarrier { unsigned* bar; unsigned x; volatile LAS unsigned* st; };
__device__ __forceinline__ XcdBarrier xcd_barrier_post(unsigned* bar, volatile LAS unsigned* st) {
    XcdBarrier b; b.bar = bar; b.x = xb_xcc_id(); b.st = st;
    if (threadIdx.x == 0) (void)xb_add(&bar[XB_XCNT(b.x)], 1u);
    return b;
}
__device__ __forceinline__ void xcd_barrier_complete(unsigned* bar, unsigned x, unsigned& nloc, unsigned& nx) {
    const unsigned G = gridDim.x * gridDim.y * gridDim.z;
    unsigned sum, cnt, mine, sp = 0u;
    for (;;) {
        sum = 0u; cnt = 0u; mine = 0u;
#pragma unroll
        for (unsigned j = 0; j < 16; ++j) { const unsigned c = xb_ld(&bar[XB_XCNT(j)]); sum += c; cnt += (c > 0u) ? 1u : 0u; mine = (j == x) ? c : mine; }
        if (sum == G) break;
        __builtin_amdgcn_s_sleep(1);
        if ((++sp & 255u) == 0u) { if (xb_ld(&bar[XB_TMO])) break; if (sp > XB_SPIN_CAP) { atomicAdd(&bar[XB_TMO], 1u); break; } }
    }
    nloc = mine > 0u ? mine : 1u; nx = cnt > 0u ? cnt : 1u;
}
template <bool FILL>
__device__ __forceinline__ void xcd_barrier(const XcdBarrier& b, Frame& F) {
    asm volatile("s_waitcnt vmcnt(0)" ::: "memory");
    __syncthreads();
    if (threadIdx.x == 0) {
        unsigned* bar = b.bar;
        __builtin_amdgcn_s_waitcnt(0);
        unsigned nloc = b.st[0], nx = b.st[1];
        if (nloc == 0u) { xcd_barrier_complete(bar, b.x, nloc, nx); b.st[0] = nloc; b.st[1] = nx; }
        const unsigned old = xb_add(&bar[XB_XSUB(b.x)], 1u);
        const unsigned gen = old / nloc;
        if (old + 1u == (gen + 1u) * nloc) {
            __builtin_amdgcn_fence(__ATOMIC_RELEASE, "agent");
            asm volatile("s_waitcnt vmcnt(0)" ::: "memory");
            const unsigned og = xb_add(&bar[XB_TOP], 1u);
            const unsigned tg = og / nx;
            if (og + 1u == (tg + 1u) * nx) xb_add(&bar[XB_TOPGEN], 1u);
            else XB_SPIN(xb_ld(&bar[XB_TOPGEN]) == tg, bar);
            __builtin_amdgcn_fence(__ATOMIC_ACQUIRE, "agent");
            xb_add(&bar[XB_XGEN(b.x)], 1u);
            asm volatile("s_waitcnt vmcnt(0)" ::: "memory");
            if (FILL) b.st[4] = 1u;
        } else if (!FILL) {
            XB_SPIN(xb_ld(&bar[XB_XGEN(b.x)]) == gen, bar);
            __builtin_amdgcn_fence(__ATOMIC_ACQUIRE, "agent");
            asm volatile("s_waitcnt vmcnt(0)" ::: "memory");
        } else { b.st[4] = 0u; b.st[5] = gen; }
    }
    __syncthreads();
    if (FILL) {
        if (__builtin_amdgcn_readfirstlane((int)b.st[4]) == 0) {
            const unsigned gen = (unsigned)__builtin_amdgcn_readfirstlane((int)b.st[5]);
            unsigned* fq = (unsigned*)(F.ws + WS_CTL) + CW_FILLQ;
            for (;;) {
                if (threadIdx.x == 0) { const unsigned done = (xb_ld(&b.bar[XB_XGEN(b.x)]) != gen) ? 1u : 0u; unsigned t = (unsigned)NFILL; if (!done) t = xb_add(fq, 1u); b.st[6] = done; b.st[7] = t; }
                LDS_BARRIER();
                const unsigned done = (unsigned)__builtin_amdgcn_readfirstlane((int)b.st[6]), t = (unsigned)__builtin_amdgcn_readfirstlane((int)b.st[7]);
                if (done) break;
                if (t < (unsigned)NFILL) filler_unit(F, t);
                else { if (threadIdx.x == 0) XB_SPIN(xb_ld(&b.bar[XB_XGEN(b.x)]) == gen, b.bar); __syncthreads(); break; }
                LDS_BARRIER();
            }
            if (threadIdx.x == 0) { __builtin_amdgcn_fence(__ATOMIC_ACQUIRE, "agent"); asm volatile("s_waitcnt vmcnt(0)" ::: "memory"); }
            __syncthreads();
        }
    }
}

struct Args { const float* in[25]; float* out; unsigned char* ws; int ph_lo, ph_hi; };
__global__ void __launch_bounds__(NTHR, 2) mk_fwd(Args args) {
    extern __shared__ __attribute__((aligned(16))) unsigned char lds_raw[];
    Frame F;
    F.lds = (LAS unsigned char*)lds_raw; F.ws = args.ws; F.out = args.out;
    F.kin = (karg_ptr_t)__builtin_amdgcn_kernarg_segment_ptr();
    F.tid = threadIdx.x; F.lane = F.tid & 63; F.wave = __builtin_amdgcn_readfirstlane(F.tid >> 6);
    F.G = gridDim.x; { const int bx = blockIdx.x; F.vcu = (F.G % 8 == 0) ? (bx % 8) * (F.G / 8) + bx / 8 : bx; }
    const int lo = args.ph_lo, hi = args.ph_hi;
    { volatile LAS unsigned* MISC = (volatile LAS unsigned*)(F.lds + LDS_MISC); if (F.tid < 64) MISC[F.tid] = 0u; }
    __syncthreads();
    XcdBarrier bar; bar.bar = (unsigned*)(F.ws + WS_CTL) + CW_BAR; bar.x = 0; bar.st = nullptr;
    if (hi - lo > 1) bar = xcd_barrier_post((unsigned*)(F.ws + WS_CTL) + CW_BAR, (volatile LAS unsigned*)(F.lds + LDS_MISC) + 8);
#define IN(k) (lo <= (k) && (k) < hi)
#define SEAM(k) do { if (IN(k) && ((k) == 2 ? IN(4) : IN((k) + 1))) xcd_barrier<((k) <= 2 || (k) == 4)>(bar, F); } while (0)

    if (IN(0)) { p0_prologue(F); }
    SEAM(0);
    if (IN(1)) {
        ProbInProj P; P.S.init(MTOK, DIN, F.G, (int)blockIdx.x); P.A = (const char*)(F.ws + WS_XB); P.Bt = (const char*)(F.ws + WS_WIN); P.rstd1 = (const float*)(F.ws + WS_RSTD1);
        P.dst0 = (bf16_t*)(F.ws + WS_XR); P.qg = F.in(10); P.kg = F.in(11); P.xs = (LAS float*)(F.lds + LDS_AUX); P.lds = F.lds;
        pg8::gemm_phase<decltype(P), true>(F.lds, P);
    }
    SEAM(1);
    if (IN(2)) { att::mixer_phase(F); }
    SEAM(2);
    if (IN(4)) {
        ProbOutProj P; P.S.init(MTOK, DM, F.G, (int)blockIdx.x); P.A = (const char*)(F.ws + WS_Y); P.Bt = (const char*)(F.ws + WS_WOUT); P.xb = (const bf16_t*)(F.ws + WS_XB); P.x1h = (bf16_t*)(F.ws + WS_X1H); P.x1q = F.ws + WS_X1B; P.lds = F.lds;
        pg8::gemm_phase<decltype(P), true>(F.lds, P);
    }
    SEAM(4);
    if (IN(5)) { p5_router(F); filler_drain(F); }
    SEAM(5);
    if (IN(6)) {
        ProbMoe1 P; P.M = moe_setup<8, true>(F); P.A = (const char*)(F.ws + WS_X1B); P.W = (const char*)(F.ws + WS_W1); P.b1 = F.in(22); P.act = F.ws + WS_ACT; P.lds = F.lds;
        pg8::gemm_phase<decltype(P), true>(F.lds, P);
    }
    SEAM(6);
    if (IN(7)) {
        ProbMoe2 P; P.M = moe_setup<4, false>(F); P.A = (const char*)(F.ws + WS_ACT); P.W = (const char*)(F.ws + WS_W2); P.b2 = F.in(24); P.ys = F.ws + WS_YB; P.lds = F.lds;
        pg8::gemm_phase<decltype(P), true>(F.lds, P);
    }
    SEAM(7);
    if (IN(8)) { p8_combine(F); }
#undef IN
#undef SEAM
}

extern "C" void kernel_launch(void* const* d_in, const int* in_sizes, int n_in, void* d_out, int out_size, void* d_ws, size_t ws_size, hipStream_t stream) {
    static int grid = 0;
    if (grid == 0) {
        if (n_in != 25 || in_sizes[0] != MTOK * DM || out_size != MTOK * DM || ws_size < WS_END) {
            fprintf(stderr, "kernel_launch: unexpected problem (n_in %d, in0 %d, out %d, ws %zu); nothing launched\n", n_in, n_in > 0 ? in_sizes[0] : -1, out_size, ws_size); grid = -1; return; }
        int dev = 0, cus = 0, per_cu = 0;
        if (hipGetDevice(&dev) != hipSuccess || hipDeviceGetAttribute(&cus, hipDeviceAttributeMultiprocessorCount, dev) != hipSuccess) { grid = -1; return; }
        if (hipFuncSetAttribute((const void*)mk_fwd, hipFuncAttributeMaxDynamicSharedMemorySize, LDS_BYTES) != hipSuccess) { fprintf(stderr, "kernel_launch: hipFuncSetAttribute failed\n"); grid = -1; return; }
        if (hipOccupancyMaxActiveBlocksPerMultiprocessor(&per_cu, (const void*)mk_fwd, NTHR, LDS_BYTES) != hipSuccess || per_cu < 1) { fprintf(stderr, "kernel_launch: occupancy query says %d blocks/CU for %d B of LDS: the grid barrier needs every workgroup resident; nothing launched\n", per_cu, LDS_BYTES); (void)hipGetLastError(); grid = -1; return; }
        (void)hipGetLastError();
        grid = cus;
        if (grid != 256) { fprintf(stderr, "kernel_launch: built for a 256-CU device (got %d)\n", cus); grid = -1; return; }
    }
    if (grid < 0) return;
    (void)hipMemsetAsync((char*)d_ws + WS_CTL, 0, CTL_BYTES, stream);
    Args a{};
    for (int i = 0; i < 25; ++i) a.in[i] = (const float*)d_in[i];
    a.out = (float*)d_out; a.ws = (unsigned char*)d_ws;
#if MK_N_LAUNCHES == 1
    a.ph_lo = 0; a.ph_hi = NPHASE;
    hipLaunchKernelGGL(mk_fwd, dim3(grid), dim3(NTHR), LDS_BYTES, stream, a);
#else
    for (int p = 0; p < NPHASE; ++p) { a.ph_lo = p; a.ph_hi = p + 1; hipLaunchKernelGGL(mk_fwd, dim3(grid), dim3(NTHR), LDS_BYTES, stream, a); }
#endif
}
```

```cpp
#include <hip/hip_runtime.h>
#include <cstdio>
#include <cstdint>

#define LAS __attribute__((address_space(3)))
#define GAS __attribute__((address_space(1)))
typedef unsigned short bf16_t;
typedef short bf16x8 __attribute__((ext_vector_type(8)));
typedef short s16x4 __attribute__((ext_vector_type(4)));
typedef float f32x4 __attribute__((ext_vector_type(4)));
typedef float f32x2 __attribute__((ext_vector_type(2)));
typedef float f32x16 __attribute__((ext_vector_type(16)));
typedef unsigned u32x4 __attribute__((ext_vector_type(4)));
typedef unsigned u32x2 __attribute__((ext_vector_type(2)));

#ifndef MK_N_LAUNCHES
#define MK_N_LAUNCHES 1
#endif
constexpr int NPHASE = 9;

constexpr int NB = 16, SEQ = 2048, DM = 1024, MTOK = NB * SEQ;
constexpr int DIN = 2560, DRNN = 512, NEXP = 32, TOPK = 4, DFF = 1024, NASG = MTOK * TOPK;
constexpr float EPS = 1e-5f;
constexpr float LOG2E = 1.4426950408889634f;
constexpr int NWAVES = 8, NTHR = 512;
constexpr float YSCALE = 8.0f;
constexpr float WSCALE = 32.0f, ASCALE = 4.0f;

constexpr size_t MiB = (size_t)1 << 20;
constexpr size_t WS_CTL = 0, CTL_BYTES = 64 * 1024;
constexpr size_t WS_WIN = 2 * MiB;
constexpr size_t WS_WOUT = 8 * MiB;
constexpr size_t WS_WRH = 10 * MiB, WS_WRL = WS_WRH + 65536;
constexpr size_t WS_WAT = WS_WRH + 2 * 65536, WS_WXT = WS_WAT + 65536;
constexpr size_t WS_RSTD1 = 11 * MiB, WS_RSTD2 = WS_RSTD1 + 131072 * 2;
constexpr size_t WS_GATES = 12 * MiB;
constexpr size_t WS_POSI = 13 * MiB;
constexpr size_t WS_LIST = 16 * MiB;
constexpr size_t WS_W1 = 32 * MiB;
constexpr size_t WS_W2 = 160 * MiB;
constexpr size_t WS_XB = 224 * MiB;
constexpr size_t WS_XR = 288 * MiB, WS_GG = 320 * MiB, WS_Q = 352 * MiB, WS_K = 384 * MiB, WS_V = 416 * MiB;
constexpr size_t WS_Y = 448 * MiB;
constexpr size_t WS_X1B = 512 * MiB;
constexpr size_t WS_X1H = 712 * MiB;
constexpr size_t WS_ACT = 576 * MiB;
constexpr size_t WS_YB = 224 * MiB;
constexpr size_t WS_END = 848 * MiB;
constexpr int MAXTILES = NASG / 256 + NEXP;
constexpr int CW_TMO = 0, CW_QUEUE = 512, CW_CNT = 1024  , CW_BAR = 8192;

constexpr int RING_BYTES = 131072;
constexpr int LDS_AUX = RING_BYTES;
constexpr int LDS_MISC = RING_BYTES + 32768 - 256;
constexpr int LDS_BYTES = 163840;

__device__ __forceinline__ unsigned f2bf(float f) { unsigned u = __builtin_bit_cast(unsigned, f); return (u + 0x7fffu + ((u >> 16) & 1u)) >> 16; }
__device__ __forceinline__ float bf2f(unsigned h) { return __builtin_bit_cast(float, h << 16); }
typedef __bf16 bf16x2_t __attribute__((ext_vector_type(2)));
__device__ __forceinline__ unsigned cvt_pk_bf16(float lo, float hi) { f32x2 v = {lo, hi}; bf16x2_t b = __builtin_convertvector(v, bf16x2_t); return __builtin_bit_cast(unsigned, b); }
__device__ __forceinline__ unsigned pk2(float lo, float hi) { return cvt_pk_bf16(lo, hi); }
__device__ __forceinline__ void swap_rows16(unsigned& a, unsigned& b) { asm("s_nop 1\n\tv_permlane16_swap_b32 %0, %1" : "+v"(a), "+v"(b)); }
__device__ __forceinline__ void swap_rows32(unsigned& a, unsigned& b) { asm("s_nop 1\n\tv_permlane32_swap_b32 %0, %1" : "+v"(a), "+v"(b)); }
__device__ __forceinline__ float add_xor16(float v) { unsigned a = __builtin_bit_cast(unsigned, v), b = a; swap_rows16(a, b); return __builtin_bit_cast(float, a) + __builtin_bit_cast(float, b); }
__device__ __forceinline__ float add_xor32(float v) { unsigned a = __builtin_bit_cast(unsigned, v), b = a; swap_rows32(a, b); return __builtin_bit_cast(float, a) + __builtin_bit_cast(float, b); }
__device__ __forceinline__ float wave_sum(float v) {
#pragma unroll
    for (int o = 1; o < 64; o <<= 1) v += __shfl_xor(v, o);
    return v;
}
__device__ __forceinline__ float fast_sigmoid(float x) { return __builtin_amdgcn_rcpf(1.0f + __builtin_amdgcn_exp2f(-x * LOG2E)); }
__device__ __forceinline__ f32x4 gelu_tanh4(f32x4 x) {
    constexpr float A = -2.0f * 0.7978845608028654f * LOG2E, B = A * 0.044715f;
    const f32x4 t = (x * x * B + A) * x;
    const f32x4 d = (f32x4){__builtin_amdgcn_exp2f(t[0]), __builtin_amdgcn_exp2f(t[1]), __builtin_amdgcn_exp2f(t[2]), __builtin_amdgcn_exp2f(t[3])} + 1.0f;
    return x * (f32x4){__builtin_amdgcn_rcpf(d[0]), __builtin_amdgcn_rcpf(d[1]), __builtin_amdgcn_rcpf(d[2]), __builtin_amdgcn_rcpf(d[3])};
}
__device__ __forceinline__ unsigned pack_fp8x4(float a, float b, float c, float d) { unsigned t = 0; t = __builtin_amdgcn_cvt_pk_fp8_f32(a, b, t, false); t = __builtin_amdgcn_cvt_pk_fp8_f32(c, d, t, true); return t; }
#define LDS_WAIT() asm volatile("s_waitcnt lgkmcnt(0)" ::: "memory")
#define LDS_BARRIER() do { asm volatile("s_waitcnt lgkmcnt(0)" ::: "memory"); __builtin_amdgcn_s_barrier(); asm volatile("" ::: "memory"); } while (0)
__device__ __forceinline__ float ld_untracked(const float* p) { float v; asm volatile("global_load_dword %0, %1, off" : "=v"(v) : "v"(p) : "memory"); return v; }
#define VM_WAIT() asm volatile("s_waitcnt vmcnt(0)" ::: "memory")

typedef const float* const volatile __attribute__((address_space(4))) * karg_ptr_t;
struct Frame {
    LAS unsigned char* lds;
    unsigned char* ws;
    int tid, lane, wave, vcu, G;
    karg_ptr_t kin;
    float* out;
    __device__ __forceinline__ const float* in(int i) const { return kin[i]; }
};

namespace pg8 {
constexpr int BM = 256, BK = 64, HALF = 128, HTB = HALF * BK * 2, KD = 1024, NT = KD / BK;
__device__ __forceinline__ int lds_byte(int r, int c) { const int st = (r >> 4) * 2 + (c >> 5), rr = r & 15, cc = c & 31, ob = rr * 64 + cc * 2; return st * 1024 + (ob ^ (((ob >> 9) & 1) << 5)); }
__device__ __forceinline__ void stage_rc(int b, int& R, int& C) { const int st = b / 1024, sb = b % 1024, swz = sb ^ (((sb >> 9) & 1) << 5); R = (st >> 1) * 16 + swz / 64; C = (st & 1) * 32 + (swz % 64) / 2; }
__device__ __forceinline__ int perm32(int rho) { const int n = rho >> 4, i = rho & 15; return 8 * (i >> 2) + 4 * n + (i & 3); }
struct Unit { int pm, pn, e, tt; };

typedef int v4i_t __attribute__((ext_vector_type(4)));
typedef int v8i_t __attribute__((ext_vector_type(8)));
__device__ __forceinline__ v8i_t cat8(bf16x8 a, bf16x8 b) { return __builtin_shufflevector(__builtin_bit_cast(v4i_t, a), __builtin_bit_cast(v4i_t, b), 0, 1, 2, 3, 4, 5, 6, 7); }
template <class Prob, bool ALIGN_EPI>
__device__ __forceinline__ void gemm_phase(LAS unsigned char* lds, const Prob& P) {
    const int tid = threadIdx.x, wid = __builtin_amdgcn_readfirstlane(tid >> 6), lane = tid & 63, wr = wid >> 2, wc = wid & 3, fr = lane & 15, fq = lane >> 4;
    constexpr int K = Prob::FP8 ? KD / 2 : KD, nt = Prob::FP8 ? NT / 2 : NT;
    unsigned voffB[2];
#pragma unroll
    for (int i = 0; i < 2; ++i) { int R_, C_; stage_rc(tid * 16 + i * 8192, R_, C_); const int Rb = (R_ & ~31) + perm32(R_ & 31); voffB[i] = (unsigned)(Rb * K + C_) * 2u; }
    constexpr size_t kstep = (size_t)(BK * 2);
    constexpr size_t hstepB = (size_t)HALF * K * 2;
    const unsigned ldsw = (unsigned)wid * 1024u;
    const int aoff = lds_byte(wr * 64 + fr, fq * 8), boff = lds_byte(wc * 32 + fr, fq * 8);
#define PG8_SA(b, h) (((b) * 2 + (h)) * HTB)
#define PG8_SB(b, h) ((4 + (b) * 2 + (h)) * HTB)
#define PG8_STAGE(bufoff, gbase, voff) do { _Pragma("unroll") for (int _i = 0; _i < 2; ++_i) \
        __builtin_amdgcn_global_load_lds((const unsigned*)((const char*)(gbase) + (voff)[_i]), (LAS unsigned*)(lds + (bufoff) + ldsw + _i * 8192), 16, 0, 0); } while (0)
#define PG8_RD(off) (*(const LAS bf16x8*)(lds + (off)))
#define PG8_LDA(dst, b, h) do { _Pragma("unroll") for (int m = 0; m < 4; ++m) { if constexpr (Prob::FP8) dst##8[m] = cat8(PG8_RD(PG8_SA(b, h) + aoff + m * 2048), PG8_RD(PG8_SA(b, h) + aoff + m * 2048 + 1024)); \
        else { _Pragma("unroll") for (int k = 0; k < 2; ++k) dst[m][k] = PG8_RD(PG8_SA(b, h) + aoff + m * 2048 + k * 1024); } } } while (0)
#define PG8_LDB(dst, b, h) do { _Pragma("unroll") for (int n = 0; n < 2; ++n) { if constexpr (Prob::FP8) dst##8[n] = cat8(PG8_RD(PG8_SB(b, h) + boff + n * 2048), PG8_RD(PG8_SB(b, h) + boff + n * 2048 + 1024)); \
        else { _Pragma("unroll") for (int k = 0; k < 2; ++k) dst[n][k] = PG8_RD(PG8_SB(b, h) + boff + n * 2048 + k * 1024); } } } while (0)
#define PG8_MMA(ai, bj, At, Bt) do { __builtin_amdgcn_s_setprio(1); _Pragma("unroll") for (int m = 0; m < 4; ++m) _Pragma("unroll") for (int n = 0; n < 2; ++n) { \
        if constexpr (Prob::FP8) asm volatile("s_nop 1\n\tv_mfma_f32_16x16x128_f8f6f4 %0, %1, %2, %0" : "+v"(acc[ai][bj][m][n]) : "v"(Bt##8[n]), "v"(At##8[m])); \
        else { _Pragma("unroll") for (int k = 0; k < 2; ++k) acc[ai][bj][m][n] = __builtin_amdgcn_mfma_f32_16x16x32_bf16(Bt[n][k], At[m][k], acc[ai][bj][m][n], 0, 0, 0); } } \
        __builtin_amdgcn_s_setprio(0); } while (0)
#define PG8_WAIT_V(n) asm volatile("s_waitcnt vmcnt(" #n ")" ::: "memory")
#define PG8_WAIT_L(n) asm volatile("s_waitcnt lgkmcnt(" #n ")" ::: "memory")
#define PG8_BAR __builtin_amdgcn_s_barrier()
#define PG8_SCHED __builtin_amdgcn_sched_barrier(0)
    Unit cur, nxt; int ui = 0;
    if (!P.next(0, cur)) return;
    f32x4 acc[2][2][4][2];
#pragma unroll
    for (int a = 0; a < 2; ++a)
#pragma unroll
        for (int b = 0; b < 2; ++b)
#pragma unroll
            for (int m = 0; m < 4; ++m)
#pragma unroll
                for (int n = 0; n < 2; ++n) acc[a][b][m][n] = (f32x4){0.f, 0.f, 0.f, 0.f};
    bf16x8 At[4][2], B0[2][2], B1[2][2]; v8i_t At8[4], B08[2], B18[2]; (void)At; (void)B0; (void)B1; (void)At8; (void)B08; (void)B18;
    unsigned vo[2][2];
    { int R[2], C[2]; stage_rc(tid * 16, R[0], C[0]); stage_rc(tid * 16 + 8192, R[1], C[1]); P.aoff(cur, R, C, vo); }
    const char* cA = P.abase(cur);
    const char* cB = P.bptr(cur);
    float pfc = P.pre(cur, tid), pfn = 0.f;
    PG8_STAGE(PG8_SB(0, 0), cB, voffB); PG8_STAGE(PG8_SB(0, 1), cB + hstepB, voffB); PG8_STAGE(PG8_SA(0, 0), cA, vo[0]); PG8_STAGE(PG8_SA(0, 1), cA, vo[1]);
    if (wr == 1) PG8_BAR;
    PG8_WAIT_V(2); PG8_BAR;
    PG8_STAGE(PG8_SB(1, 0), cB + kstep, voffB); PG8_STAGE(PG8_SA(1, 0), cA + kstep, vo[0]); PG8_STAGE(PG8_SB(1, 1), cB + hstepB + kstep, voffB);
    PG8_WAIT_V(6); PG8_BAR;
    for (;;) {
        const bool has_next = P.next(ui + 1, nxt);
        const char* nB = has_next ? P.bptr(nxt) : cB;
        const char* nA = has_next ? P.abase(nxt) : cA;
#pragma nounroll
        for (int t = 0; t < nt; t += 2) {
            const bool last = (t == nt - 2);
            const char* a1 = cA + (size_t)(t + 1) * kstep;
            const char* a2 = last ? nA : cA + (size_t)(t + 2) * kstep; const char* b2 = last ? nB : cB + (size_t)(t + 2) * kstep;
            const char* a3 = a2 + kstep; const char* b3 = b2 + kstep;
            unsigned w2[2][2];
#pragma unroll
            for (int h = 0; h < 2; ++h)
#pragma unroll
                for (int i = 0; i < 2; ++i) w2[h][i] = vo[h][i];
            if (last && has_next) { int R[2], C[2]; stage_rc(tid * 16, R[0], C[0]); stage_rc(tid * 16 + 8192, R[1], C[1]); P.aoff(nxt, R, C, w2); pfn = P.pre(nxt, tid); }
            PG8_LDB(B0, 0, 0); PG8_LDB(B1, 0, 1); PG8_SCHED; PG8_LDA(At, 0, 0); PG8_STAGE(PG8_SA(1, 1), a1, vo[1]);
            PG8_WAIT_V(8); PG8_WAIT_L(0); PG8_BAR; PG8_MMA(0, 0, At, B0); PG8_MMA(0, 1, At, B1); PG8_BAR; PG8_SCHED;
            PG8_LDA(At, 0, 1); PG8_STAGE(PG8_SB(0, 0), b2, voffB); PG8_STAGE(PG8_SB(0, 1), b2 + hstepB, voffB); PG8_STAGE(PG8_SA(0, 0), a2, w2[0]);
            PG8_WAIT_V(8); PG8_WAIT_L(0); PG8_BAR; PG8_MMA(1, 0, At, B0); PG8_MMA(1, 1, At, B1); PG8_BAR; PG8_SCHED;
            PG8_LDB(B0, 1, 0); PG8_LDB(B1, 1, 1); PG8_SCHED; PG8_LDA(At, 1, 0); PG8_STAGE(PG8_SA(0, 1), a2, w2[1]);
            PG8_WAIT_V(8); PG8_WAIT_L(0); PG8_BAR; PG8_MMA(0, 0, At, B0); PG8_MMA(0, 1, At, B1); PG8_BAR; PG8_SCHED;
            PG8_LDA(At, 1, 1); PG8_STAGE(PG8_SB(1, 0), b3, voffB); PG8_STAGE(PG8_SB(1, 1), b3 + hstepB, voffB); PG8_STAGE(PG8_SA(1, 0), a3, w2[0]);
            PG8_WAIT_V(8); PG8_WAIT_L(0); PG8_BAR; PG8_MMA(1, 0, At, B0); PG8_MMA(1, 1, At, B1); PG8_BAR; PG8_SCHED;
        }
        if constexpr (ALIGN_EPI) { if (wr == 0) PG8_BAR; }
        { int fr_ = fr, fq_ = fq; asm volatile("" : "+v"(fr_), "+v"(fq_)); P.epi(acc, cur, wr, wc, fr_, fq_, pfc); }
        if (!has_next) break;
#pragma unroll
        for (int a = 0; a < 2; ++a)
#pragma unroll
            for (int b = 0; b < 2; ++b)
#pragma unroll
                for (int m = 0; m < 4; ++m)
#pragma unroll
                    for (int n = 0; n < 2; ++n) acc[a][b][m][n] = (f32x4){0.f, 0.f, 0.f, 0.f};
        cur = nxt; cB = nB; cA = nA; ++ui; pfc = pfn;
        { int R[2], C[2]; stage_rc(tid * 16, R[0], C[0]); stage_rc(tid * 16 + 8192, R[1], C[1]); P.aoff(cur, R, C, vo); }
        if constexpr (ALIGN_EPI) { if (wr == 1) PG8_BAR; }
    }
    PG8_WAIT_V(0);
    if constexpr (!ALIGN_EPI) { if (wr == 0) PG8_BAR; }
    PG8_BAR;
#undef PG8_SA
#undef PG8_SB
#undef PG8_STAGE
#undef PG8_LDA
#undef PG8_RD
#undef PG8_LDB
#undef PG8_MMA
#undef PG8_SCHED
}
struct StaticOrder {
    int nM, nN, nwg, G, c;
    __device__ void init(int M, int N, int G_, int c_) { nM = M / BM; nN = N / BM; nwg = nM * nN; G = G_; c = c_; }
    __device__ bool next(int i, int& pm, int& pn) const {
        const long L = (long)i * G + c; if (L >= nwg) return false;
        int wgid = (int)L; { const int q = nwg / 8, r = nwg % 8, xcd = wgid % 8, off = wgid / 8; wgid = (xcd < r ? xcd * (q + 1) : r * (q + 1) + (xcd - r) * q) + off; }
        const int nig = 8 * nN, gid = wgid / nig, fm = gid * 8, gsz = (nM - fm) < 8 ? (nM - fm) : 8;
        pm = fm + ((wgid % nig) % gsz); pn = (wgid % nig) / gsz; return true;
    }
};
}

__device__ __forceinline__ void p0_transpose_item(const float* W, int K, int N, bf16_t* WT, int out_row0, const float* g, LAS float* scr, int kb, int nb, int lane) {
    const int k0 = 64 * kb, n0 = 32 * nb;
#pragma unroll
    for (int i = 0; i < 8; ++i) { const int kk = 8 * i + (lane >> 3), c4 = lane & 7;
        *(LAS f32x4*)(scr + kk * 36 + ((4 * c4 + 4 * (kk >> 3)) & 31)) = __builtin_nontemporal_load((const f32x4*)(W + (size_t)(k0 + kk) * N + n0 + 4 * c4)); }
    LDS_WAIT(); asm volatile("" ::: "memory");
    const int c = lane & 7;
    float gv[8];
#pragma unroll
    for (int q = 0; q < 8; ++q) gv[q] = g ? g[k0 + 8 * c + q] : 1.0f;
#pragma unroll
    for (int j = 0; j < 4; ++j) { const int n = (lane >> 3) + 8 * j; const LAS float* s = scr + (8 * c) * 36 + ((n + 4 * c) & 31);
        u32x4 o; o.x = pk2(s[0 * 36] * gv[0], s[1 * 36] * gv[1]); o.y = pk2(s[2 * 36] * gv[2], s[3 * 36] * gv[3]); o.z = pk2(s[4 * 36] * gv[4], s[5 * 36] * gv[5]); o.w = pk2(s[6 * 36] * gv[6], s[7 * 36] * gv[7]);
        *(u32x4*)(WT + (size_t)(out_row0 + n) * K + k0 + 8 * c) = o; }
    LDS_WAIT(); asm volatile("" ::: "memory");
}
__device__ __forceinline__ void p0_prologue(Frame& F) {
    LAS float* scr = (LAS float*)(F.lds + F.wave * 16384);
    const int gw = F.vcu * NWAVES + F.wave, NGW = F.G * NWAVES;
    const float* x = F.in(0); const float* g1 = F.in(1); const float* w_in = F.in(2); const float* w_out = F.in(17); const float* g2 = F.in(18);
    bf16_t* WIN = (bf16_t*)(F.ws + WS_WIN); bf16_t* WOUT = (bf16_t*)(F.ws + WS_WOUT);
    constexpr int I_IN = 16 * 80, I_OUT = 16 * 32;
    constexpr int NITEMS = I_IN + I_OUT;
    for (int it = gw; it < NITEMS; it += NGW) {
        int r = it;
        if (r < I_IN) { const int kb = r / 80, nb = r % 80; p0_transpose_item(w_in, DM, DIN, WIN, 32 * nb, g1, scr, kb, nb, F.lane); continue; } r -= I_IN;
        { const int kb = r / 32, nb = r % 32; p0_transpose_item(w_out, DM, DM, WOUT, 32 * nb, nullptr, scr, kb, nb, F.lane); }
    }
    {
        const float* rw = F.in(19); bf16_t* WRH = (bf16_t*)(F.ws + WS_WRH); bf16_t* WRL = (bf16_t*)(F.ws + WS_WRL);
        const float* wa = F.in(5); const float* wx = F.in(7); bf16_t* WAT = (bf16_t*)(F.ws + WS_WAT); bf16_t* WXT = (bf16_t*)(F.ws + WS_WXT);
        const int gt = F.vcu * NTHR + F.tid, NGT = F.G * NTHR;
        for (int i = gt; i < 32768; i += NGT) {
            { const int n = i >> 10, k = i & 1023; const float v = rw[k * NEXP + n] * g2[k]; const unsigned h = f2bf(v); WRH[i] = (bf16_t)h; WRL[i] = (bf16_t)f2bf(v - bf2f(h)); }
            { const int nblk = i >> 12, j = (i >> 6) & 63, ii = i & 63; WAT[i] = (bf16_t)f2bf(wa[(nblk * 64 + ii) * 64 + j]); WXT[i] = (bf16_t)f2bf(wx[(nblk * 64 + ii) * 64 + j]); }
        }
    }
    {
        bf16_t* XB = (bf16_t*)(F.ws + WS_XB); float* RS1 = (float*)(F.ws + WS_RSTD1);
        constexpr int NROW = MTOK / (256 * NWAVES);
#define P0_LOAD(V, it) do { const f32x4* xr_ = (const f32x4*)(x + (size_t)(gw + NGW * (it)) * DM) + F.lane; _Pragma("unroll") for (int j = 0; j < 4; ++j) V[j] = __builtin_nontemporal_load(&xr_[64 * j]); } while (0)
#define P0_ROW(V, VN, it) do { if ((it) + 1 < NROW) P0_LOAD(VN, (it) + 1); \
            const int m_ = gw + NGW * (it); float s_ = 0.f; \
            _Pragma("unroll") for (int j = 0; j < 4; ++j) s_ += (V[j].x * V[j].x + V[j].y * V[j].y) + (V[j].z * V[j].z + V[j].w * V[j].w); \
            s_ = wave_sum(s_); \
            if (F.lane == 0) RS1[m_] = __builtin_amdgcn_rsqf(s_ * (1.0f / DM) + EPS); \
            u32x2* o8_ = (u32x2*)(XB + (size_t)m_ * DM) + F.lane; \
            _Pragma("unroll") for (int j = 0; j < 4; ++j) { u32x2 w_; w_.x = pk2(V[j].x, V[j].y); w_.y = pk2(V[j].z, V[j].w); o8_[64 * j] = w_; } } while (0)
        if (NGW == 256 * NWAVES) {
            f32x4 va[4], vb[4];
            P0_LOAD(va, 0);
#pragma unroll
            for (int it = 0; it < NROW; it += 2) { P0_ROW(va, vb, it); P0_ROW(vb, va, it + 1); }
        }
#undef P0_LOAD
#undef P0_ROW
    }
}

constexpr int STG_BUF0 = 3 * pg8::HTB, STG_BUF1 = LDS_AUX + 8192;
constexpr int LDS_PFX = LDS_AUX + 26624;
struct RowStager {
    LAS unsigned char* lds; int wr, wc, fr, fq, tid;
    template <class RowPtr> __device__ __forceinline__ void chunk(int c, u32x4 w0, u32x4 w1, const RowPtr& rowp) const {
        LAS unsigned char* buf = lds + ((c & 1) ? STG_BUF1 : STG_BUF0);
        const int rl = wr * 16 + fr, p0 = wc * 4 + fq;
        *(LAS u32x4*)(buf + rl * 512 + ((p0 ^ (rl & 7)) << 4)) = w0;
        *(LAS u32x4*)(buf + rl * 512 + (((16 + p0) ^ (rl & 7)) << 4)) = w1;
        asm volatile("s_waitcnt lgkmcnt(0)" ::: "memory"); __builtin_amdgcn_s_barrier(); asm volatile("" ::: "memory");
        const int ai = c >> 2, m = c & 3;
#pragma unroll
        for (int j = 0; j < 2; ++j) { const int p = tid + 512 * j, r2 = p >> 5, pi = p & 31;
            const u32x4 v = *(const LAS u32x4*)(buf + r2 * 512 + ((pi ^ (r2 & 7)) << 4));
            *(u32x4*)(rowp(ai * 128 + (r2 >> 4) * 64 + m * 16 + (r2 & 15)) + pi * 16) = v; }
    }
};

struct ProbInProj {
    static constexpr bool FP8 = false;
    pg8::StaticOrder S; const char* A; const char* Bt; const float* rstd1; bf16_t* dst0; const float* qg; const float* kg; LAS float* xs; LAS unsigned char* lds;
    __device__ __forceinline__ bool next(int i, pg8::Unit& u) const { u.e = 0; u.tt = 0; return S.next(i, u.pm, u.pn); }
    __device__ __forceinline__ const char* abase(const pg8::Unit& u) const { return A + (size_t)u.pm * 256 * DM * 2; }
    __device__ __forceinline__ void aoff(const pg8::Unit& u, const int (&R)[2], const int (&C)[2], unsigned (&vo)[2][2]) const {
#pragma unroll
        for (int h = 0; h < 2; ++h)
#pragma unroll
            for (int i = 0; i < 2; ++i) vo[h][i] = (unsigned)((h * 128 + R[i]) * DM + C[i]) * 2u;
    }
    __device__ __forceinline__ const char* bptr(const pg8::Unit& u) const { return Bt + (size_t)u.pn * 256 * DM * 2; }
    __device__ __forceinline__ float pre(const pg8::Unit& u, int tid) const { return ld_untracked(rstd1 + u.pm * 256 + (tid & 255)); }
    __device__ __forceinline__ void epi(f32x4 (&acc)[2][2][4][2], const pg8::Unit& u, int wr, int wc, int fr, int fq, float pf) const {
        const int type = u.pn >> 1;
        bf16_t* dst = dst0 + (size_t)type * ((WS_GG - WS_XR) / 2);
        const int row0 = u.pm * 256 + wr * 64 + fr, col0 = (u.pn & 1) * 256 + wc * 32 + 8 * fq;
        LAS float* pfx = (LAS float*)(lds + LDS_PFX);
        if (wr == 0) pfx[wc * 64 + fq * 16 + fr] = pf;
        asm volatile("s_waitcnt lgkmcnt(0)" ::: "memory"); __builtin_amdgcn_s_barrier(); asm volatile("" ::: "memory");
        float rs[2][4];
#pragma unroll
        for (int ai = 0; ai < 2; ++ai)
#pragma unroll
            for (int m = 0; m < 4; ++m) rs[ai][m] = pfx[wr * 64 + fr + ai * 128 + m * 16];
#pragma unroll
        for (int ai = 0; ai < 2; ++ai)
#pragma unroll
            for (int bj = 0; bj < 2; ++bj)
#pragma unroll
                for (int m = 0; m < 4; ++m)
#pragma unroll
                    for (int n = 0; n < 2; ++n) acc[ai][bj][m][n] = acc[ai][bj][m][n] * rs[ai][m];
        if (type == 1) {
#pragma unroll
            for (int ai = 0; ai < 2; ++ai)
#pragma unroll
                for (int bj = 0; bj < 2; ++bj)
#pragma unroll
                    for (int m = 0; m < 4; ++m)
#pragma unroll
                        for (int n = 0; n < 2; ++n) acc[ai][bj][m][n] = gelu_tanh4(acc[ai][bj][m][n]);
        }
        if (type == 2 || type == 3) {
            const int lane = fq * 16 + fr; (void)lane;
            float ss[2][4][2];
#pragma unroll
            for (int ai = 0; ai < 2; ++ai)
#pragma unroll
                for (int m = 0; m < 4; ++m)
#pragma unroll
                    for (int bj = 0; bj < 2; ++bj) { const f32x4 a = acc[ai][bj][m][0], b = acc[ai][bj][m][1]; const f32x4 q = a * a + b * b;
                        float s = (q[0] + q[1]) + (q[2] + q[3]);
                        s = add_xor16(s); s = add_xor32(s); ss[ai][m][bj] = s; }
            LAS float* mine = xs + ((wr * 4 + wc) * 8) * 32; LAS float* other = xs + ((wr * 4 + (wc ^ 1)) * 8) * 32;
            if (fq == 0) {
#pragma unroll
                for (int ai = 0; ai < 2; ++ai)
#pragma unroll
                    for (int m = 0; m < 4; ++m) { f32x2 w; w.x = ss[ai][m][0]; w.y = ss[ai][m][1]; *(LAS f32x2*)(mine + ((ai * 4 + m) * 16 + fr) * 2) = w; }
            }
            asm volatile("s_waitcnt lgkmcnt(0)" ::: "memory"); __builtin_amdgcn_s_barrier(); asm volatile("" ::: "memory");
            const float* g = (type == 2) ? qg : kg; const float sc = (type == 2) ? 0.125f * LOG2E : 1.0f;
            f32x4 gv[2];
#pragma unroll
            for (int n = 0; n < 2; ++n) gv[n] = *(const f32x4*)(g + 32 * (wc & 1) + 8 * fq + 4 * n) * sc;
#pragma unroll
            for (int ai = 0; ai < 2; ++ai)
#pragma unroll
                for (int m = 0; m < 4; ++m) { const f32x2 o = *(const LAS f32x2*)(other + ((ai * 4 + m) * 16 + fr) * 2);
#pragma unroll
                    for (int bj = 0; bj < 2; ++bj) { const float tot = ss[ai][m][bj] + (bj == 0 ? o.x : o.y); const float r = __builtin_amdgcn_rsqf(tot * (1.0f / 64.0f) + EPS);
#pragma unroll
                        for (int n = 0; n < 2; ++n) acc[ai][bj][m][n] = acc[ai][bj][m][n] * (gv[n] * r); } }
        }
        { const RowStager ST{lds, wr, wc, fr, fq, (wr * 4 + wc) * 64 + fq * 16 + fr};
          char* tbase = (char*)(dst + (size_t)u.pm * 256 * 512 + (u.pn & 1) * 256);
          auto rowp = [tbase](int r) { return tbase + (size_t)r * 1024; };
#pragma unroll
          for (int ai = 0; ai < 2; ++ai)
#pragma unroll
              for (int m = 0; m < 4; ++m) { u32x4 w[2];
#pragma unroll
                  for (int bj = 0; bj < 2; ++bj) { const f32x4 v0 = acc[ai][bj][m][0], v1 = acc[ai][bj][m][1];
                      w[bj].x = cvt_pk_bf16(v0[0], v0[1]); w[bj].y = cvt_pk_bf16(v0[2], v0[3]); w[bj].z = cvt_pk_bf16(v1[0], v1[1]); w[bj].w = cvt_pk_bf16(v1[2], v1[3]); }
                  ST.chunk(ai * 4 + m, w[0], w[1], rowp); } }
    }
};

template <int NJ>
__device__ __forceinline__ void conv_unit(Frame& F, int cu, int j0) {
    int lane = F.lane; asm volatile("" : "+v"(lane));
    const int wave = F.wave;
    LAS float* scr = (LAS float*)(F.lds + wave * 16384);
    const bool first = cu < 512;
    const int e = first ? (cu >> 4) : ((cu - 512) >> 3);
    const float* W = first ? F.in(21) + (size_t)e * DM * 2 * DFF : F.in(23) + (size_t)e * DFF * DM;
    unsigned char* WT = first ? F.ws + WS_W1 + (size_t)e * 2 * DFF * DM : F.ws + WS_W2 + (size_t)e * DM * DFF;
    const int N = first ? 2 * DFF : DM;
    const int c = lane & 3;
    float gv[16];
    { const float* g2 = F.in(18);
#pragma unroll
      for (int q = 0; q < 16; ++q) gv[q] = first ? g2[64 * (cu & 15) + 16 * c + q] * WSCALE : WSCALE; }
#define CV_GEOM(j, k0_, n0_, or_) do { const int idx_ = 8 * (j) + wave; \
        if (first) { k0_ = 64 * (cu & 15); n0_ = 32 * idx_; const int j0_ = n0_ & 1023; or_ = 256 * (j0_ >> 7) + (j0_ & 127) + ((n0_ >= 1024) ? 128 : 0); } \
        else { k0_ = 64 * (2 * ((cu - 512) & 7) + (idx_ >> 5)); n0_ = 32 * (idx_ & 31); or_ = n0_; } } while (0)
#define CV_LOAD(LD, k0_, n0_) do { _Pragma("unroll") for (int i = 0; i < 8; ++i) { const int kk = 8 * i + (lane >> 3), c4 = lane & 7; \
        LD[i] = __builtin_nontemporal_load((const f32x4*)(W + (size_t)((k0_) + kk) * N + (n0_) + 4 * c4)); } } while (0)
#define CV_ITEM(LD, j) do { \
        _Pragma("unroll") for (int i = 0; i < 8; ++i) { const int kk = 8 * i + (lane >> 3), c4 = lane & 7; \
            *(LAS f32x4*)(scr + kk * 36 + ((4 * c4 + 4 * (kk >> 3)) & 31)) = LD[i]; }         \
        int k0c, n0c, orc; CV_GEOM(j0 + (j), k0c, n0c, orc); (void)n0c; \
        if ((j) + 2 < NJ) { int k0n, n0n, orn; CV_GEOM(j0 + (j) + 2, k0n, n0n, orn); (void)orn; CV_LOAD(LD, k0n, n0n); } \
        LDS_WAIT(); asm volatile("" ::: "memory"); \
        _Pragma("unroll") for (int j2 = 0; j2 < 2; ++j2) { const int n = (lane >> 2) + 16 * j2; const LAS float* sp = scr + (16 * c) * 36; \
            const int nc0 = (n + 8 * c) & 31, nc1 = (n + 8 * c + 4) & 31;           \
            unsigned w[4]; \
            _Pragma("unroll") for (int q = 0; q < 4; ++q) { unsigned t = 0; const int nc = (q < 2) ? nc0 : nc1; \
                t = __builtin_amdgcn_cvt_pk_fp8_f32(sp[(4 * q) * 36 + nc] * gv[4 * q], sp[(4 * q + 1) * 36 + nc] * gv[4 * q + 1], t, false); \
                t = __builtin_amdgcn_cvt_pk_fp8_f32(sp[(4 * q + 2) * 36 + nc] * gv[4 * q + 2], sp[(4 * q + 3) * 36 + nc] * gv[4 * q + 3], t, true); w[q] = t; } \
            *(u32x4*)(WT + (size_t)(orc + n) * 1024 + k0c + 16 * c) = (u32x4){w[0], w[1], w[2], w[3]}; } \
        LDS_WAIT(); asm volatile("" ::: "memory"); } while (0)
    f32x4 lda[8], ldb[8];
    { int k0, n0, orow; CV_GEOM(j0, k0, n0, orow); (void)orow; CV_LOAD(lda, k0, n0); CV_GEOM(j0 + 1, k0, n0, orow); CV_LOAD(ldb, k0, n0); }
    CV_ITEM(lda, 0); CV_ITEM(ldb, 1);
    if constexpr (NJ == 8) { CV_ITEM(lda, 2); CV_ITEM(ldb, 3); CV_ITEM(lda, 4); CV_ITEM(ldb, 5); CV_ITEM(lda, 6); CV_ITEM(ldb, 7); }
#undef CV_ITEM
#undef CV_GEOM
#undef CV_LOAD
}

constexpr int NCONV = 384, NCONV_ALL = 768, NFILL = (NCONV_ALL - NCONV) * 4, CW_FILLQ = 640;
__device__ __forceinline__ void filler_unit(Frame& F, unsigned t) { conv_unit<2>(F, NCONV + (int)(t >> 2), 2 * (int)(t & 3)); }
__device__ __forceinline__ void filler_drain(Frame& F) {
    unsigned* fq = (unsigned*)(F.ws + WS_CTL) + CW_FILLQ;
    volatile LAS unsigned* st = (volatile LAS unsigned*)(F.lds + LDS_MISC) + 8;
    for (;;) {
        if (F.tid == 0) st[7] = __hip_atomic_fetch_add(fq, 1u, __ATOMIC_RELAXED, __HIP_MEMORY_SCOPE_AGENT);
        __syncthreads();
        const unsigned t = (unsigned)__builtin_amdgcn_readfirstlane((int)st[7]);
        if (t >= (unsigned)NFILL) break;
        filler_unit(F, t);
        __syncthreads();
    }
    __syncthreads();
}

__device__ __forceinline__ void rglru_item(Frame& F, int item) {
    const int bb = item >> 3, nb = item & 7;
    int tid = F.tid; asm volatile("" : "+v"(tid));
    const int lane = tid & 63, wid = F.wave;
    const bf16_t* XR = (const bf16_t*)(F.ws + WS_XR); const bf16_t* GG = (const bf16_t*)(F.ws + WS_GG); bf16_t* Y = (bf16_t*)(F.ws + WS_Y);
    const float* conv_w = F.in(3); const float* conv_b = F.in(4); const float* ba = F.in(6); const float* bx = F.in(8); const float* lam = F.in(9);
    const bf16_t* WAT = (const bf16_t*)(F.ws + WS_WAT); const bf16_t* WXT = (const bf16_t*)(F.ws + WS_WXT);
    LAS bf16_t* XCb = (LAS bf16_t*)(F.lds);
    LAS float* XCf = (LAS float*)(F.lds + 9216);
    LAS float* RGl = (LAS float*)(F.lds + 9216 + 16384);
    LAS float* SEG = (LAS float*)(F.lds + 9216 + 16384 + 32768);
    LAS float* HC = (LAS float*)(F.lds + 9216 + 16384 + 32768 + 4096);
    const int ct = tid >> 3, cg = tid & 7, chb = nb * 64 + 8 * cg;
    float cw[4][8], cb[8];
#pragma unroll
    for (int j = 0; j < 4; ++j)
#pragma unroll
        for (int c = 0; c < 8; ++c) cw[j][c] = conv_w[j * DRNN + chb + c];
#pragma unroll
    for (int c = 0; c < 8; ++c) cb[c] = conv_b[chb + c];
    const int g = wid >> 2, mt = wid & 3, l15 = lane & 15, kq = lane >> 4;
    bf16x8 Bf[4][2];
    { const bf16_t* WT = (g == 0 ? WAT : WXT) + nb * 4096;
#pragma unroll
      for (int ntl = 0; ntl < 4; ++ntl)
#pragma unroll
          for (int ks = 0; ks < 2; ++ks) Bf[ntl][ks] = *(const bf16x8*)(WT + (16 * ntl + l15) * 64 + 32 * ks + 8 * kq); }
    float gbias[4];
#pragma unroll
    for (int ntl = 0; ntl < 4; ++ntl) gbias[ntl] = (g == 0 ? ba : bx)[nb * 64 + 16 * ntl + l15];
    const int sc = tid & 63, sg = tid >> 6;
    const float sp8 = 8.0f * log1pf(expf(-lam[nb * 64 + sc]));
    if (tid < 64) HC[tid] = 0.f;
    const size_t rowbase = (size_t)bb * SEQ;
    u32x4 xv[4];
#pragma unroll
    for (int j = 0; j < 4; ++j) { const int t = ct - 3 + j; xv[j] = (t >= 0) ? *(const u32x4*)(XR + (rowbase + t) * DRNN + chb) : (u32x4){0u, 0u, 0u, 0u}; }
    for (int c = 0; c < SEQ / 64; ++c) {
        const int t0 = 64 * c;
        {
            float xc[8];
#pragma unroll
            for (int q = 0; q < 8; ++q) xc[q] = cb[q];
#pragma unroll
            for (int j = 0; j < 4; ++j) { const unsigned w[4] = {xv[j].x, xv[j].y, xv[j].z, xv[j].w};
#pragma unroll
                for (int q = 0; q < 4; ++q) { xc[2 * q] += cw[j][2 * q] * bf2f(w[q] & 0xffffu); xc[2 * q + 1] += cw[j][2 * q + 1] * bf2f(w[q] >> 16); } }
            if (c + 1 < SEQ / 64) {
#pragma unroll
                for (int j = 0; j < 4; ++j) xv[j] = *(const u32x4*)(XR + (rowbase + t0 + 64 + ct - 3 + j) * DRNN + chb);
            }
            u32x4 pb; pb.x = pk2(xc[0], xc[1]); pb.y = pk2(xc[2], xc[3]); pb.z = pk2(xc[4], xc[5]); pb.w = pk2(xc[6], xc[7]);
            *(LAS u32x4*)(XCb + ct * 72 + 8 * cg) = pb;
            *(LAS f32x4*)(XCf + ct * 64 + 8 * cg) = (f32x4){xc[0], xc[1], xc[2], xc[3]};
            *(LAS f32x4*)(XCf + ct * 64 + 8 * cg + 4) = (f32x4){xc[4], xc[5], xc[6], xc[7]};
        }
        unsigned short gq[8];
#pragma unroll
        for (int s8 = 0; s8 < 8; ++s8) gq[s8] = GG[(rowbase + t0 + 8 * sg + s8) * DRNN + nb * 64 + sc];
        LDS_BARRIER();
        {
            bf16x8 Af[2];
#pragma unroll
            for (int ks = 0; ks < 2; ++ks) Af[ks] = *(const LAS bf16x8*)(XCb + (16 * mt + l15) * 72 + 32 * ks + 8 * kq);
#pragma unroll
            for (int ntl = 0; ntl < 4; ++ntl) {
                f32x4 d = (f32x4){0.f, 0.f, 0.f, 0.f};
#pragma unroll
                for (int ks = 0; ks < 2; ++ks) d = __builtin_amdgcn_mfma_f32_16x16x32_bf16(Af[ks], Bf[ntl][ks], d, 0, 0, 0);
#pragma unroll
                for (int r = 0; r < 4; ++r) RGl[g * 4096 + (16 * mt + 4 * kq + r) * 64 + 16 * ntl + l15] = fast_sigmoid(d[r] + gbias[ntl]);
            }
        }
        LDS_BARRIER();
        float av[8], uv[8]; float Aseg = 1.f, Hseg = 0.f;
#pragma unroll
        for (int s8 = 0; s8 < 8; ++s8) { const int tok = 8 * sg + s8;
            const float r = RGl[tok * 64 + sc], ig = RGl[4096 + tok * 64 + sc], xcv = XCf[tok * 64 + sc];
            const float la = -sp8 * r, y2 = 2.0f * la;
            const float a = __expf(la);
            const float om_s = -y2 * (1.0f + y2 * (0.5f + y2 * (0.16666667f + y2 * 0.041666668f))), om_e = 1.0f - a * a;
            const float om = (y2 > -0.1f) ? om_s : om_e;
            const float u = __builtin_amdgcn_sqrtf(om) * (ig * xcv);
            av[s8] = a; uv[s8] = u; Aseg *= a; Hseg = a * Hseg + u; }
        SEG[(sg * 64 + sc) * 2] = Aseg; SEG[(sg * 64 + sc) * 2 + 1] = Hseg;
        LDS_BARRIER();
        float h = HC[(c & 1) * 64 + sc];
        { f32x2 sgv[7];
#pragma unroll
          for (int s2 = 0; s2 < 7; ++s2) sgv[s2] = *(const LAS f32x2*)(SEG + (s2 * 64 + sc) * 2);
#pragma unroll
          for (int s2 = 0; s2 < 7; ++s2) h = (s2 < sg) ? sgv[s2].x * h + sgv[s2].y : h; }
#pragma unroll
        for (int s8 = 0; s8 < 8; ++s8) { h = av[s8] * h + uv[s8]; Y[(rowbase + t0 + 8 * sg + s8) * DM + nb * 64 + sc] = (bf16_t)f2bf(h * bf2f(gq[s8])); }
        if (sg == 7) HC[((c + 1) & 1) * 64 + sc] = h;
    }
    __syncthreads();
}

namespace att {
constexpr float ATT_THR = 8.0f;
constexpr int LK0 = 0, LK1 = 8192, LV = 16384, LBUF = 32768  , LWS = 98304, LOX = 0;
__device__ __forceinline__ int crow(int r, int hi) { return (r & 3) + 8 * (r >> 2) + 4 * hi; }
__device__ __forceinline__ void glds16(const void* gsrc, unsigned lds_dst) { unsigned keep;
    asm volatile("s_mov_b32 %0, m0\n\ts_mov_b32 m0, %2\n\ts_nop 0\n\tglobal_load_lds_dwordx4 %1, off\n\ts_mov_b32 m0, %0" : "=&s"(keep) : "v"(gsrc), "s"(lds_dst) : "memory"); }
typedef __attribute__((address_space(3))) const char* lds_cptr;
typedef short v4i16_t __attribute__((ext_vector_type(4)));
__device__ __forceinline__ s16x4 vtr(lds_cptr p) { return __builtin_bit_cast(s16x4, __builtin_amdgcn_ds_read_tr16_b64_v4i16((__attribute__((address_space(3))) v4i16_t*)p)); }
template <int CTRL> __device__ __forceinline__ float dpp_f(float x) { return __int_as_float(__builtin_amdgcn_update_dpp(0, __float_as_int(x), CTRL, 0xf, 0xf, true)); }
__device__ __forceinline__ float rowmax_pos(const f32x16& p0, const f32x16& p1) {
    int a = 0, b = 0;
#pragma unroll
    for (int r = 0; r < 16; r += 2) { a = max(max(a, __float_as_int(p0[r])), __float_as_int(p0[r + 1])); b = max(max(b, __float_as_int(p1[r])), __float_as_int(p1[r + 1])); }
    a = max(a, b);
    unsigned ua = (unsigned)a, ub = ua; swap_rows32(ua, ub);
    return __int_as_float(max((int)ua, (int)ub));
}
__device__ __forceinline__ void attn_unit(Frame& F, int b, int h, int qb, float lam) {
    int lane = F.lane; asm volatile("" : "+v"(lane));
    const int r32 = lane & 31, hi = lane >> 5, wid = F.wave, mp = wid >> 2, wq = wid & 3;
    const bf16_t* Q = (const bf16_t*)(F.ws + WS_Q); const bf16_t* K = (const bf16_t*)(F.ws + WS_K); const bf16_t* V = (const bf16_t*)(F.ws + WS_V); bf16_t* Y = (bf16_t*)(F.ws + WS_Y);
    const float* subg = F.in(16);
    char* shm = (char*)F.lds;
    const unsigned lds0 = (unsigned)(uintptr_t)shm;
    const size_t rowbase = (size_t)b * SEQ; const int q0 = qb * 128;
    const int NT = 2 * (qb + 1);
    float* wsf = (float*)(shm + LWS) + wid * 64;
    bf16x8 qr[4];
    { const bf16_t* Qw = Q + (rowbase + q0 + wq * 32 + r32) * 512 + h * 128 + mp * 64;
#pragma unroll
      for (int d0 = 0; d0 < 4; ++d0) qr[d0] = *(const bf16x8*)(Qw + d0 * 16 + hi * 8); }
    const bf16_t* ks0 = K + (rowbase + lane) * 512 + h * 128 + wid * 8;
    const bf16_t* ks1 = ks0 + 64;
    const bf16_t* vs0 = V + (rowbase + 16 * (wid & 3) + (lane >> 2)) * 512 + h * 128 + (wid >> 2) * 32 + (lane & 3) * 8;
    const bf16_t* vs1 = vs0 + 64;
    const unsigned kd0 = (unsigned)__builtin_amdgcn_readfirstlane(lds0 + LK0 + wid * 1024), kd1 = (unsigned)__builtin_amdgcn_readfirstlane(lds0 + LK1 + wid * 1024);
    const unsigned vd0 = (unsigned)__builtin_amdgcn_readfirstlane(lds0 + LV + wid * 1024), vd1 = (unsigned)__builtin_amdgcn_readfirstlane(lds0 + LV + (wid + 8) * 1024);
    const lds_cptr shm3 = (lds_cptr)(F.lds);
    const lds_cptr kp0 = shm3 + (mp ? LK1 : LK0) + hi * 1024 + r32 * 16;
    const lds_cptr vp0 = shm3 + LV + ((lane >> 4) & 1) * 32 + (lane & 3) * 8 + (4 * hi + ((lane & 15) >> 2)) * 64;
    f32x16 negm = f32x16{}; asm volatile("" : "+v"(negm));
    float m_run = 0.f, l_run = 0.f;
    f32x16 o[4];
#pragma unroll
    for (int d = 0; d < 4; ++d) o[d] = f32x16{};
    const int qrel = wq * 32 + r32;
    glds16(ks0, kd0); glds16(ks1, kd1); glds16(vs0, vd0); glds16(vs1, vd1);
    asm volatile("" : "+v"(qr[0]), "+v"(qr[1]), "+v"(qr[2]), "+v"(qr[3]));
    f32x16 p0, p1;
    u32x4 pw[4];
    int bcur = 0, bprev = 0, bnext = LBUF;
#define ATT_QK(P0, P1, slot) do { _Pragma("unroll") for (int d0 = 0; d0 < 4; ++d0) { \
        const bf16x8 k0f = *(const __attribute__((address_space(3))) bf16x8*)(kp0 + (slot) + d0 * 2048); \
        const bf16x8 k1f = *(const __attribute__((address_space(3))) bf16x8*)(kp0 + (slot) + d0 * 2048 + 512); \
        if (d0 == 0) { P0 = __builtin_amdgcn_mfma_f32_32x32x16_bf16(k0f, qr[0], negm, 0, 0, 0); P1 = __builtin_amdgcn_mfma_f32_32x32x16_bf16(k1f, qr[0], negm, 0, 0, 0); } \
        else { P0 = __builtin_amdgcn_mfma_f32_32x32x16_bf16(k0f, qr[d0], P0, 0, 0, 0); P1 = __builtin_amdgcn_mfma_f32_32x32x16_bf16(k1f, qr[d0], P1, 0, 0, 0); } } } while (0)
#define ATT_MASK(P0, P1, t) do { if ((t) >= NT - 2) { const int kb_ = 64 * ((t) - (NT - 2)) + 4 * hi; \
        _Pragma("unroll") for (int r = 0; r < 16; ++r) { const int kv = kb_ + (r & 3) + 8 * (r >> 2); if (kv > qrel) P0[r] = -INFINITY; if (kv + 32 > qrel) P1[r] = -INFINITY; } } } while (0)
#define ATT_SUMPACK(P0, P1) do { float sacc = 0.f; _Pragma("unroll") for (int r = 0; r < 16; ++r) sacc += P0[r] + P1[r]; l_run += sacc; \
        pw[0] = (u32x4){cvt_pk_bf16(P0[0], P0[1]), cvt_pk_bf16(P0[2], P0[3]), cvt_pk_bf16(P0[4], P0[5]), cvt_pk_bf16(P0[6], P0[7])}; \
        pw[1] = (u32x4){cvt_pk_bf16(P0[8], P0[9]), cvt_pk_bf16(P0[10], P0[11]), cvt_pk_bf16(P0[12], P0[13]), cvt_pk_bf16(P0[14], P0[15])}; \
        pw[2] = (u32x4){cvt_pk_bf16(P1[0], P1[1]), cvt_pk_bf16(P1[2], P1[3]), cvt_pk_bf16(P1[4], P1[5]), cvt_pk_bf16(P1[6], P1[7])}; \
        pw[3] = (u32x4){cvt_pk_bf16(P1[8], P1[9]), cvt_pk_bf16(P1[10], P1[11]), cvt_pk_bf16(P1[12], P1[13]), cvt_pk_bf16(P1[14], P1[15])}; } while (0)
#define ATT_PV(slot) do { _Pragma("unroll") for (int db = 0; db < 4; ++db) { _Pragma("unroll") for (int ks = 0; ks < 4; ++ks) { \
        const s16x4 lo = vtr(vp0 + (slot) + db * 4096 + ks * 1024), hh = vtr(vp0 + (slot) + db * 4096 + ks * 1024 + 512); \
        const bf16x8 vf = (bf16x8){lo[0], lo[1], lo[2], lo[3], hh[0], hh[1], hh[2], hh[3]}; \
        o[db] = __builtin_amdgcn_mfma_f32_32x32x16_bf16(__builtin_bit_cast(bf16x8, pw[ks]), vf, o[db], 0, 0, 0); } } } while (0)
#define ATT_DECIDE(P0, P1, moved) do { const float rm = rowmax_pos(P0, P1); moved = false; \
        if (__any(rm > ATT_THR)) { const float dl = rm; m_run += dl; \
            _Pragma("unroll") for (int r = 0; r < 16; ++r) { P0[r] -= dl; P1[r] -= dl; negm[r] = -m_run; } \
            asm volatile("" : "+v"(negm)); \
            const float f = __builtin_amdgcn_exp2f(-dl); l_run *= f; if (hi == 0) wsf[r32] = f; moved = true; } } while (0)
#define ATT_RESCALE_O() do { asm volatile("s_waitcnt lgkmcnt(0)" ::: "memory"); _Pragma("unroll") for (int r = 0; r < 16; ++r) { const float fr_ = wsf[crow(r, hi)]; \
        _Pragma("unroll") for (int d = 0; d < 4; ++d) o[d][r] *= fr_; } } while (0)
    asm volatile("s_waitcnt vmcnt(0) lgkmcnt(0)" ::: "memory"); __builtin_amdgcn_s_barrier(); asm volatile("" ::: "memory");
    { const size_t go = (size_t)1 * 64 * 512; glds16(ks0 + go, kd0 + LBUF); glds16(ks1 + go, kd1 + LBUF); glds16(vs0 + go, vd0 + LBUF); glds16(vs1 + go, vd1 + LBUF); }
    ATT_QK(p0, p1, 0); ATT_MASK(p0, p1, 0);
    { bool moved; ATT_DECIDE(p0, p1, moved); (void)moved; }
#pragma unroll
    for (int r = 0; r < 16; ++r) { p0[r] = __builtin_amdgcn_exp2f(p0[r]); p1[r] = __builtin_amdgcn_exp2f(p1[r]); }
    bprev = 0; bcur = LBUF; bnext = 2 * LBUF;
#define SBAR() __builtin_amdgcn_sched_barrier(0)
#define PIN1(x) asm volatile("" : "+v"(x))
#define KRD(j, slot) (*(const __attribute__((address_space(3))) bf16x8*)(kp0 + (slot) + ((j) >> 1) * 2048 + ((j) & 1) * 512))
#define VRDF(i, slot) do { vlo[(i) % 3] = vtr(vp0 + (slot) + ((i) >> 2) * 4096 + ((i) & 3) * 1024); vhi[(i) % 3] = vtr(vp0 + (slot) + ((i) >> 2) * 4096 + ((i) & 3) * 1024 + 512); } while (0)
#define VFRG(i) (bf16x8){vlo[(i) % 3][0], vlo[(i) % 3][1], vlo[(i) % 3][2], vlo[(i) % 3][3], vhi[(i) % 3][0], vhi[(i) % 3][1], vhi[(i) % 3][2], vhi[(i) % 3][3]}
#define GAPA(j, N0, N1, slot, PA, B, PWW, W0, W1) do { \
        if ((j) == 0) N0 = __builtin_amdgcn_mfma_f32_32x32x16_bf16(kf[0], qr[0], negm, 0, 0, 0); \
        else if ((j) == 1) N1 = __builtin_amdgcn_mfma_f32_32x32x16_bf16(kf[1], qr[0], negm, 0, 0, 0); \
        else if (((j) & 1) == 0) N0 = __builtin_amdgcn_mfma_f32_32x32x16_bf16(kf[(j) % 3], qr[(j) >> 1], N0, 0, 0, 0); \
        else N1 = __builtin_amdgcn_mfma_f32_32x32x16_bf16(kf[(j) % 3], qr[(j) >> 1], N1, 0, 0, 0); \
        if ((j) + 2 < 8) kf[((j) + 2) % 3] = KRD((j) + 2, slot); \
        sacc += PA[B]; sacc += PA[B + 1]; sacc += PA[B + 2]; sacc += PA[B + 3]; PIN1(sacc); \
        PWW[W0] = cvt_pk_bf16(PA[B], PA[B + 1]); PWW[W1] = cvt_pk_bf16(PA[B + 2], PA[B + 3]); PIN1(PWW); SBAR(); } while (0)
#define GAPB(i, slot, X, NX, B) do { \
        o[(i) >> 2] = __builtin_amdgcn_mfma_f32_32x32x16_bf16(__builtin_bit_cast(bf16x8, pw[(i) & 3]), VFRG(i), o[(i) >> 2], 0, 0, 0); \
        if ((i) + 2 < 16) VRDF((i) + 2, slot); \
        X[B] = __builtin_amdgcn_exp2f(NX[B]); X[B + 1] = __builtin_amdgcn_exp2f(NX[B + 1]); PIN1(X); SBAR(); } while (0)
#define ATT_STEP(t, MASKED) do { \
        asm volatile("s_waitcnt vmcnt(0) lgkmcnt(0)" ::: "memory"); \
        __builtin_amdgcn_s_barrier(); \
        asm volatile("" ::: "memory"); \
        if ((t) + 1 < NT) { const size_t go = (size_t)((t) + 1) * 64 * 512; const unsigned b1 = (unsigned)bnext; \
            glds16(ks0 + go, kd0 + b1); glds16(ks1 + go, kd1 + b1); glds16(vs0 + go, vd0 + b1); glds16(vs1 + go, vd1 + b1); } \
        SBAR(); \
        f32x16 n0, n1; bf16x8 kf[3]; s16x4 vlo[3], vhi[3]; float sacc = 0.f; u32x4 q0_, q1_, q2_, q3_; \
        kf[0] = KRD(0, bcur); kf[1] = KRD(1, bcur); SBAR(); \
        GAPA(0, n0, n1, bcur, p0, 0, q0_, 0, 1); GAPA(1, n0, n1, bcur, p0, 4, q0_, 2, 3); GAPA(2, n0, n1, bcur, p0, 8, q1_, 0, 1); GAPA(3, n0, n1, bcur, p0, 12, q1_, 2, 3); \
        GAPA(4, n0, n1, bcur, p1, 0, q2_, 0, 1); GAPA(5, n0, n1, bcur, p1, 4, q2_, 2, 3); GAPA(6, n0, n1, bcur, p1, 8, q3_, 0, 1); GAPA(7, n0, n1, bcur, p1, 12, q3_, 2, 3); \
        l_run += sacc; pw[0] = q0_; pw[1] = q1_; pw[2] = q2_; pw[3] = q3_; \
        VRDF(0, bprev); VRDF(1, bprev); SBAR();                         \
        if (MASKED) ATT_MASK(n0, n1, t); \
        bool moved; ATT_DECIDE(n0, n1, moved); \
        SBAR(); \
        GAPB(0, bprev, p0, n0, 0); GAPB(1, bprev, p0, n0, 2); GAPB(2, bprev, p0, n0, 4); GAPB(3, bprev, p0, n0, 6); \
        GAPB(4, bprev, p0, n0, 8); GAPB(5, bprev, p0, n0, 10); GAPB(6, bprev, p0, n0, 12); GAPB(7, bprev, p0, n0, 14); \
        GAPB(8, bprev, p1, n1, 0); GAPB(9, bprev, p1, n1, 2); GAPB(10, bprev, p1, n1, 4); GAPB(11, bprev, p1, n1, 6); \
        GAPB(12, bprev, p1, n1, 8); GAPB(13, bprev, p1, n1, 10); GAPB(14, bprev, p1, n1, 12); GAPB(15, bprev, p1, n1, 14); \
        if (moved) ATT_RESCALE_O(); \
        bprev = bcur; bcur = bnext; bnext = (bnext == 2 * LBUF) ? 0 : bnext + LBUF; } while (0)
    { int t = 1;
      for (; t < NT - 2; ++t) ATT_STEP(t, false);
      for (; t < NT; ++t) ATT_STEP(t, true); }
#undef ATT_STEP
#undef GAPA
#undef GAPB
#undef KRD
#undef VRDF
#undef VFRG
#undef SBAR
#undef PIN1
    ATT_SUMPACK(p0, p1);
    ATT_PV(bprev);
#undef ATT_QK
#undef ATT_MASK
#undef ATT_SUMPACK
#undef ATT_PV
#undef ATT_DECIDE
#undef ATT_RESCALE_O
    l_run = add_xor32(l_run);
    if (hi == 0) wsf[32 + r32] = l_run;
    asm volatile("s_waitcnt lgkmcnt(0)" ::: "memory");
    f32x16 rliv;
#pragma unroll
    for (int g = 0; g < 4; ++g) { const f32x4 lv = *(const f32x4*)(wsf + 32 + 8 * g + 4 * hi);
#pragma unroll
        for (int j = 0; j < 4; ++j) rliv[4 * g + j] = __builtin_amdgcn_rcpf(lv[j]); }
    __syncthreads();
    float* ox = (float*)(shm + LOX) + wq * 4096;
    if (mp == 1) {
#pragma unroll
        for (int db = 0; db < 4; ++db) { const f32x16 t = o[db] * rliv;
#pragma unroll
            for (int g = 0; g < 4; ++g) *(f32x4*)(ox + ((db * 4 + g) * 64 + lane) * 4) = (f32x4){t[4 * g], t[4 * g + 1], t[4 * g + 2], t[4 * g + 3]}; }
    }
    __syncthreads();
    if (mp == 0) {
        f32x16 ssv = f32x16{};
#pragma unroll
        for (int db = 0; db < 4; ++db) { f32x16 x1;
#pragma unroll
            for (int g = 0; g < 4; ++g) { const f32x4 t = *(const f32x4*)(ox + ((db * 4 + g) * 64 + lane) * 4); x1[4 * g] = t[0]; x1[4 * g + 1] = t[1]; x1[4 * g + 2] = t[2]; x1[4 * g + 3] = t[3]; }
            const f32x16 v = o[db] * rliv - x1 * lam; o[db] = v; ssv = v * v + ssv; }
#pragma unroll
        for (int r = 0; r < 16; ++r) { float sv = ssv[r];
            sv += dpp_f<0xB1>(sv); sv += dpp_f<0x4E>(sv); sv += dpp_f<0x141>(sv); sv += dpp_f<0x140>(sv);
            sv = add_xor16(sv);
            ssv[r] = 0.8f * __builtin_amdgcn_rsqf(sv * (1.0f / 128.0f) + EPS); }
        float sg[4];
#pragma unroll
        for (int db = 0; db < 4; ++db) sg[db] = subg[32 * db + r32];
        bf16_t* stg = (bf16_t*)ox;
#pragma unroll
        for (int db = 0; db < 4; ++db) { const f32x16 t = o[db] * (ssv * sg[db]);
#pragma unroll
            for (int r = 0; r < 16; r += 2) { const unsigned w = cvt_pk_bf16(t[r], t[r + 1]);
                stg[crow(r, hi) * 128 + 32 * db + r32] = (bf16_t)(w & 0xffffu); stg[crow(r + 1, hi) * 128 + 32 * db + r32] = (bf16_t)(w >> 16); } }
        asm volatile("s_waitcnt lgkmcnt(0)" ::: "memory");
        bf16_t* yb = Y + (rowbase + q0 + wq * 32) * DM + 512 + h * 128;
#pragma unroll
        for (int i = 0; i < 8; ++i) { const int q = lane + 64 * i, row = q >> 4, pc = q & 15;
            const u32x4 v = *(const u32x4*)(stg + row * 128 + pc * 8);
            *(u32x4*)(yb + (size_t)row * DM + pc * 8) = v; }
    }
}
constexpr int NQUEUE = 128 + 1024 + NCONV;
__device__ __forceinline__ void mixer_phase(Frame& F) {
    const float* lq1 = F.in(12); const float* lk1 = F.in(13); const float* lq2 = F.in(14); const float* lk2 = F.in(15);
    float a1 = lq1[F.lane] * lk1[F.lane], a2 = lq2[F.lane] * lk2[F.lane];
    a1 = wave_sum(a1); a2 = wave_sum(a2);
    const float lam = expf(a1) - expf(a2) + 0.2f;
    unsigned* qhead = (unsigned*)(F.ws + WS_CTL) + CW_QUEUE;
    volatile LAS unsigned* slot = (volatile LAS unsigned*)(F.lds + LDS_MISC) + 16;
    for (;;) {
        if (F.tid == 0) slot[0] = __hip_atomic_fetch_add(qhead, 1u, __ATOMIC_RELAXED, __HIP_MEMORY_SCOPE_AGENT);
        __syncthreads();
        const int u = (int)__builtin_amdgcn_readfirstlane(slot[0]);
        if (u >= NQUEUE) break;
        if (u < 128) { rglru_item(F, u); continue; }
        const int v = u - 128;
        if (v < 2 * NCONV && (v & 1)) { conv_unit<8>(F, v >> 1, 0); __syncthreads(); continue; }
        const int idx = (v < 2 * NCONV) ? (v >> 1) : v - NCONV, qb = 15 - (idx >> 6), bh = idx & 63;
        attn_unit(F, bh >> 2, bh & 3, qb, lam); __syncthreads();
    }
    __syncthreads();
}
}

struct ProbOutProj {
    static constexpr bool FP8 = false;
    pg8::StaticOrder S; const char* A; const char* Bt; const bf16_t* xb; bf16_t* x1h; unsigned char* x1q; LAS unsigned char* lds;
    __device__ __forceinline__ bool next(int i, pg8::Unit& u) const { u.e = 0; u.tt = 0; return S.next(i, u.pm, u.pn); }
    __device__ __forceinline__ const char* abase(const pg8::Unit& u) const { return A + (size_t)u.pm * 256 * DM * 2; }
    __device__ __forceinline__ void aoff(const pg8::Unit& u, const int (&R)[2], const int (&C)[2], unsigned (&vo)[2][2]) const {
#pragma unroll
        for (int h = 0; h < 2; ++h)
#pragma unroll
            for (int i = 0; i < 2; ++i) vo[h][i] = (unsigned)((h * 128 + R[i]) * DM + C[i]) * 2u;
    }
    __device__ __forceinline__ const char* bptr(const pg8::Unit& u) const { return Bt + (size_t)u.pn * 256 * DM * 2; }
    __device__ __forceinline__ float pre(const pg8::Unit&, int) const { return 0.f; }
    __device__ __forceinline__ void epi(f32x4 (&acc)[2][2][4][2], const pg8::Unit& u, int wr, int wc, int fr, int fq, float) const {
        const int tid = (wr * 4 + wc) * 64 + fq * 16 + fr;
        const size_t tile0 = (size_t)u.pm * 256 * DM + (size_t)u.pn * 256;
        u32x4 xres[8][2];
#pragma unroll
        for (int c = 0; c < 8; ++c)
#pragma unroll
            for (int j = 0; j < 2; ++j) { const int p = tid + 512 * j, r2 = p >> 5, pi = p & 31;
                xres[c][j] = *(const u32x4*)(xb + tile0 + (size_t)((c >> 2) * 128 + (r2 >> 4) * 64 + (c & 3) * 16 + (r2 & 15)) * DM + pi * 8); }
#pragma unroll
        for (int ai = 0; ai < 2; ++ai)
#pragma unroll
            for (int m = 0; m < 4; ++m) { const int c = ai * 4 + m;
                LAS unsigned char* buf = lds + ((c & 1) ? STG_BUF1 : STG_BUF0);
                const int rl = wr * 16 + fr, p0 = wc * 4 + fq;
#pragma unroll
                for (int bj = 0; bj < 2; ++bj) { const f32x4 v0 = acc[ai][bj][m][0], v1 = acc[ai][bj][m][1];
                    u32x4 w; w.x = cvt_pk_bf16(v0[0], v0[1]); w.y = cvt_pk_bf16(v0[2], v0[3]); w.z = cvt_pk_bf16(v1[0], v1[1]); w.w = cvt_pk_bf16(v1[2], v1[3]);
                    *(LAS u32x4*)(buf + rl * 512 + (((bj * 16 + p0) ^ (rl & 7)) << 4)) = w; }
                asm volatile("s_waitcnt lgkmcnt(0)" ::: "memory"); __builtin_amdgcn_s_barrier(); asm volatile("" ::: "memory");
#pragma unroll
                for (int j = 0; j < 2; ++j) { const int p = tid + 512 * j, r2 = p >> 5, pi = p & 31;
                    const u32x4 a = *(const LAS u32x4*)(buf + r2 * 512 + ((pi ^ (r2 & 7)) << 4));
                    const size_t off = tile0 + (size_t)(ai * 128 + (r2 >> 4) * 64 + m * 16 + (r2 & 15)) * DM + pi * 8;
                    const u32x4 xv = xres[c][j];
                    const unsigned aw[4] = {a.x, a.y, a.z, a.w}, xw[4] = {xv.x, xv.y, xv.z, xv.w};
                    float v[8];
#pragma unroll
                    for (int q = 0; q < 4; ++q) { v[2 * q] = bf2f(aw[q] & 0xffffu) + bf2f(xw[q] & 0xffffu); v[2 * q + 1] = bf2f(aw[q] >> 16) + bf2f(xw[q] >> 16); }
                    u32x4 hb; hb.x = cvt_pk_bf16(v[0], v[1]); hb.y = cvt_pk_bf16(v[2], v[3]); hb.z = cvt_pk_bf16(v[4], v[5]); hb.w = cvt_pk_bf16(v[6], v[7]);
                    *(u32x4*)(x1h + off) = hb;
                    u32x2 w8; w8.x = pack_fp8x4(v[0], v[1], v[2], v[3]); w8.y = pack_fp8x4(v[4], v[5], v[6], v[7]);
                    *(u32x2*)(x1q + off) = w8; } }
    }
};

__device__ __forceinline__ void p5_router(Frame& F) {
    const int lane = F.lane, r32 = lane & 31, hi = lane >> 5, wid = F.wave, tl = wid & 3, kh = wid >> 2, tid = F.tid;
    const bf16_t* x1 = (const bf16_t*)(F.ws + WS_X1H); const bf16_t* WRH = (const bf16_t*)(F.ws + WS_WRH); const bf16_t* WRL = (const bf16_t*)(F.ws + WS_WRL);
    const float* rb = F.in(20);
    unsigned* ctl = (unsigned*)(F.ws + WS_CTL);
    int* LIST = (int*)(F.ws + WS_LIST); float* GATES = (float*)(F.ws + WS_GATES); float* RS2 = (float*)(F.ws + WS_RSTD2); int* POSI = (int*)(F.ws + WS_POSI);
    LAS float* T = (LAS float*)(F.lds);
    LAS float* SS = (LAS float*)(F.lds + 2 * 4 * 32 * 33 * 4);
    LAS unsigned* CNTL = (LAS unsigned*)(F.lds + 2 * 4 * 32 * 33 * 4 + 1024);
    float rbv[8];
#pragma unroll
    for (int j = 0; j < 8; ++j) rbv[j] = rb[8 * (tid & 3) + j];
    for (int blk = F.vcu; blk < MTOK / 128; blk += F.G) {
        const int R0 = blk * 128;
        if (tid < 32) CNTL[tid] = 0u;
        f32x16 acc = f32x16{}; float ssq = 0.f;
        const bf16_t* xrow = x1 + (size_t)(R0 + tl * 32 + r32) * DM + kh * 512 + hi * 8;
        const bf16_t* wh = WRH + r32 * DM + kh * 512 + hi * 8; const bf16_t* wl = WRL + r32 * DM + kh * 512 + hi * 8;
#pragma unroll 8
        for (int s = 0; s < 32; ++s) {
            const u32x4 xa = *(const u32x4*)(xrow + 16 * s);
            const unsigned xw[4] = {xa.x, xa.y, xa.z, xa.w};
#pragma unroll
            for (int j = 0; j < 4; ++j) { const float a = bf2f(xw[j] & 0xffffu), b = bf2f(xw[j] >> 16); ssq += a * a + b * b; }
            const bf16x8 bh = *(const bf16x8*)(wh + 16 * s), bl = *(const bf16x8*)(wl + 16 * s);
            acc = __builtin_amdgcn_mfma_f32_32x32x16_bf16(__builtin_bit_cast(bf16x8, xa), bh, acc, 0, 0, 0);
            acc = __builtin_amdgcn_mfma_f32_32x32x16_bf16(__builtin_bit_cast(bf16x8, xa), bl, acc, 0, 0, 0);
        }
        ssq = add_xor32(ssq);
#pragma unroll
        for (int r = 0; r < 16; ++r) T[((kh * 4 + tl) * 32 + att::crow(r, hi)) * 33 + r32] = acc[r];
        if (hi == 0) SS[(kh * 4 + tl) * 32 + r32] = ssq;
        __syncthreads();
        int ek[4]; float gk[4]; unsigned rk[4] = {0u, 0u, 0u, 0u}; float rstd2;
        const int srow = tid >> 2, sq = tid & 3;
        {
            const int tile = srow >> 5, rr = srow & 31;
            rstd2 = __builtin_amdgcn_rsqf((SS[tile * 32 + rr] + SS[(4 + tile) * 32 + rr]) * (1.0f / DM) + EPS);
            const LAS float* ta = T + (tile * 32 + rr) * 33 + 8 * sq; const LAS float* tb = T + ((4 + tile) * 32 + rr) * 33 + 8 * sq;
            float v[8];
#pragma unroll
            for (int j = 0; j < 8; ++j) v[j] = (ta[j] + tb[j]) * rstd2 + rbv[j];
            float vk[4];
#pragma unroll
            for (int k = 0; k < 4; ++k) { float best = -INFINITY; int be = 8 * sq;
#pragma unroll
                for (int j = 0; j < 8; ++j) if (v[j] > best) { best = v[j]; be = 8 * sq + j; }
                { const float ob = att::dpp_f<0xB1>(best); const int oe = __builtin_amdgcn_update_dpp(0, be, 0xB1, 0xf, 0xf, true); if (ob > best || (ob == best && oe < be)) { best = ob; be = oe; } }
                { const float ob = att::dpp_f<0x4E>(best); const int oe = __builtin_amdgcn_update_dpp(0, be, 0x4E, 0xf, 0xf, true); if (ob > best || (ob == best && oe < be)) { best = ob; be = oe; } }
                ek[k] = be; vk[k] = best;
#pragma unroll
                for (int j = 0; j < 8; ++j) if (be == 8 * sq + j) v[j] = -INFINITY; }
            float den = 0.f;
#pragma unroll
            for (int k = 0; k < 4; ++k) { gk[k] = __expf(vk[k] - vk[0]); den += gk[k]; }
            const float rden = 1.0f / den;
#pragma unroll
            for (int k = 0; k < 4; ++k) { gk[k] *= rden; if (sq == 0) rk[k] = __hip_atomic_fetch_add(CNTL + ek[k], 1u, __ATOMIC_RELAXED, __HIP_MEMORY_SCOPE_WORKGROUP); }
        }
        __syncthreads();
        if (tid < 32) { const unsigned n = CNTL[tid]; CNTL[32 + tid] = n ? atomicAdd(ctl + CW_CNT + 64 * tid, n) : 0u; }
        __syncthreads();
        if (sq == 0) {
            const int tok = R0 + srow;
            RS2[tok] = rstd2;
#pragma unroll
            for (int k = 0; k < 4; ++k) { const int li = (int)(CNTL[32 + ek[k]] + rk[k]); LIST[(size_t)ek[k] * MTOK + li] = tok * 4 + k; GATES[tok * 4 + k] = gk[k]; POSI[tok * 4 + k] = (ek[k] << 15) | li; }
        }
        __syncthreads();
    }
}

constexpr int MOE_MAXS = 24;
struct MoeSched { LAS int* TB; LAS int* TE; LAS int* TAB; int tlo, thi, mt, pn, mpb; };
constexpr int MOE_CNTS = 25600 / 4;
__device__ __forceinline__ void moe_prefix(Frame& F, LAS int* TB) {
    const unsigned* ctl = (const unsigned*)(F.ws + WS_CTL);
    if (F.tid < 64) {
        const int e = F.tid; const int c = (e < NEXP) ? (int)__hip_atomic_load(ctl + CW_CNT + 64 * (e & 31), __ATOMIC_RELAXED, __HIP_MEMORY_SCOPE_AGENT) : 0;
        const int tiles = (c + 255) >> 8; int incl = tiles;
#pragma unroll
        for (int o = 1; o < 32; o <<= 1) { const int y = __shfl_up(incl, o); if (e >= o) incl += y; }
        if (e < NEXP) { TB[e] = incl - tiles; TB[MOE_CNTS + e] = c; }
        if (e == NEXP - 1) TB[NEXP] = incl;
    }
    __syncthreads();
}
template <int NPN, bool TABLE>
__device__ __forceinline__ MoeSched moe_setup(Frame& F) {
    MoeSched M;
    M.TB = (LAS int*)(F.lds + LDS_AUX); M.TE = M.TB + 40; M.TAB = M.TB + 64;
    moe_prefix(F, M.TB);
    const int T = __builtin_amdgcn_readfirstlane(M.TB[NEXP]), x = F.vcu >> 5, i = F.vcu & 31;
    M.mpb = 32 / NPN; M.mt = __builtin_amdgcn_readfirstlane(i / NPN); M.pn = __builtin_amdgcn_readfirstlane(i % NPN);
    M.tlo = __builtin_amdgcn_readfirstlane((x * T) >> 3); M.thi = __builtin_amdgcn_readfirstlane(((x + 1) * T) >> 3);
    const int* LIST = (const int*)(F.ws + WS_LIST); const float* RS2 = (const float*)(F.ws + WS_RSTD2);
    if (F.tid < MOE_MAXS) { const int t = M.tlo + F.tid * M.mpb + M.mt; int e = 0; if (t < M.thi) { for (int q = 0; q < NEXP; ++q) if (M.TB[q + 1] <= t) e = q + 1; } M.TE[F.tid] = e; }
    __syncthreads();
    if (TABLE) {
        constexpr int NIT = MOE_MAXS * 256 / NTHR;
        int lst[NIT];
#pragma unroll
        for (int it = 0; it < NIT; ++it) { const int idx = F.tid + NTHR * it, s = idx >> 8, r = idx & 255, t = M.tlo + s * M.mpb + M.mt;
            const int e = M.TE[s]; const int li = (t - M.TB[e]) * 256 + r;
            lst[it] = (t < M.thi && li < M.TB[MOE_CNTS + e]) ? LIST[(size_t)e * MTOK + li] : -1; }
        float rsv[NIT];
#pragma unroll
        for (int it = 0; it < NIT; ++it) rsv[it] = (lst[it] >= 0) ? RS2[lst[it] >> 2] : 0.f;
#pragma unroll
        for (int it = 0; it < NIT; ++it) M.TAB[F.tid + NTHR * it] = (lst[it] >= 0) ? ((lst[it] >> 2) | (int)((f2bf(rsv[it]) & 0x7fffu) << 15)) : 0;
    }
    __syncthreads();
    return M;
}
struct ProbMoe1 {
    static constexpr bool FP8 = true;
    MoeSched M; const char* A; const char* W; const float* b1; unsigned char* act; LAS unsigned char* lds;
    __device__ __forceinline__ bool next(int s, pg8::Unit& u) const { const int t = __builtin_amdgcn_readfirstlane(M.tlo + s * M.mpb + M.mt); if (s >= MOE_MAXS || t >= __builtin_amdgcn_readfirstlane(M.thi)) return false; u.pn = M.pn; u.pm = t; u.tt = s;
        u.e = __builtin_amdgcn_readfirstlane(M.TE[s]); return true; }
    __device__ __forceinline__ const char* abase(const pg8::Unit&) const { return A; }
    __device__ __forceinline__ void aoff(const pg8::Unit& u, const int (&R)[2], const int (&C)[2], unsigned (&vo)[2][2]) const {
#pragma unroll
        for (int h = 0; h < 2; ++h)
#pragma unroll
            for (int i = 0; i < 2; ++i) vo[h][i] = (unsigned)((M.TAB[u.tt * 256 + h * 128 + R[i]] & 0x7fff) * DM + C[i] * 2);
    }
    __device__ __forceinline__ const char* bptr(const pg8::Unit& u) const { return W + ((size_t)u.e * 2 * DFF + (size_t)u.pn * 256) * DM; }
    __device__ __forceinline__ float pre(const pg8::Unit& u, int tid) const { const int t = tid & 255; return ld_untracked(b1 + (size_t)u.e * 2 * DFF + u.pn * 128 + (t & 127) + ((t >> 7) ? DFF : 0)); }
    __device__ __forceinline__ void epi(f32x4 (&acc)[2][2][4][2], const pg8::Unit& u, int wr, int wc, int fr, int fq, float pf) const {
        asm volatile("s_nop 15\n\ts_nop 7" ::: "memory");
        const int rl0 = wr * 64 + fr, cj = u.pn * 128 + wc * 32 + 8 * fq;
        LAS float* pfx = (LAS float*)(lds + LDS_PFX);
        if (wr == 0) pfx[wc * 64 + fq * 16 + fr] = pf;
        asm volatile("s_waitcnt lgkmcnt(0)" ::: "memory"); __builtin_amdgcn_s_barrier(); asm volatile("" ::: "memory");
        const LAS float* bg = pfx + wc * 32 + 8 * fq; const LAS float* bu = bg + 128;
        constexpr float CS = -1.702f * LOG2E, KA = ASCALE / CS;
        f32x4 bg0 = *(const LAS f32x4*)bg, bg1 = *(const LAS f32x4*)(bg + 4); const f32x4 bu0 = *(const LAS f32x4*)bu, bu1 = *(const LAS f32x4*)(bu + 4);
        bg0 = bg0 * CS; bg1 = bg1 * CS;
#pragma unroll
        for (int ai = 0; ai < 2; ++ai)
#pragma unroll
            for (int m = 0; m < 4; ++m) { const int rl = rl0 + ai * 128 + m * 16; const float rs = bf2f((unsigned)M.TAB[u.tt * 256 + rl] >> 15) * (1.0f / WSCALE), rsc = rs * CS;
                float a[8];
#pragma unroll
                for (int n = 0; n < 2; ++n)
#pragma unroll
                    for (int jp = 0; jp < 2; ++jp) {
                        const f32x2 ag = {acc[ai][0][m][n][2 * jp], acc[ai][0][m][n][2 * jp + 1]}, au = {acc[ai][1][m][n][2 * jp], acc[ai][1][m][n][2 * jp + 1]};
                        const f32x2 bgp = n ? (f32x2){bg1[2 * jp], bg1[2 * jp + 1]} : (f32x2){bg0[2 * jp], bg0[2 * jp + 1]};
                        const f32x2 bup = n ? (f32x2){bu1[2 * jp], bu1[2 * jp + 1]} : (f32x2){bu0[2 * jp], bu0[2 * jp + 1]};
                        const f32x2 z = ag * (f32x2){rsc, rsc} + bgp, hu = au * (f32x2){rs, rs} + bup;
                        const f32x2 zc = {fmaxf(z.x, 7.0f * CS), fmaxf(z.y, 7.0f * CS)};
                        const f32x2 up = {__builtin_amdgcn_fmed3f(hu.x, -7.0f, 7.0f), __builtin_amdgcn_fmed3f(hu.y, -7.0f, 7.0f)};
                        const f32x2 den = (f32x2){__builtin_amdgcn_exp2f(zc.x), __builtin_amdgcn_exp2f(zc.y)} + (f32x2){1.0f, 1.0f};
                        const f32x2 sg = {__builtin_amdgcn_rcpf(den.x), __builtin_amdgcn_rcpf(den.y)};
                        const f32x2 r = (zc * sg) * (up * (f32x2){KA, KA} + (f32x2){KA, KA});
                        a[4 * n + 2 * jp] = r.x; a[4 * n + 2 * jp + 1] = r.y; }
                u32x2 w; w.x = pack_fp8x4(a[0], a[1], a[2], a[3]); w.y = pack_fp8x4(a[4], a[5], a[6], a[7]);
                *(u32x2*)(act + ((size_t)u.pm * 256 + rl) * DFF + cj) = w; }
    }
};
struct ProbMoe2 {
    static constexpr bool FP8 = true;
    MoeSched M; const char* A; const char* W; const float* b2; unsigned char* ys; LAS unsigned char* lds;
    __device__ __forceinline__ bool next(int s, pg8::Unit& u) const { const int t = __builtin_amdgcn_readfirstlane(M.tlo + s * M.mpb + M.mt); if (s >= MOE_MAXS || t >= __builtin_amdgcn_readfirstlane(M.thi)) return false; u.pn = M.pn; u.pm = t; u.tt = s;
        u.e = __builtin_amdgcn_readfirstlane(M.TE[s]); return true; }
    __device__ __forceinline__ const char* abase(const pg8::Unit& u) const { return A + (size_t)u.pm * 256 * DFF; }
    __device__ __forceinline__ void aoff(const pg8::Unit& u, const int (&R)[2], const int (&C)[2], unsigned (&vo)[2][2]) const {
#pragma unroll
        for (int h = 0; h < 2; ++h)
#pragma unroll
            for (int i = 0; i < 2; ++i) vo[h][i] = (unsigned)((h * 128 + R[i]) * DFF + C[i] * 2);
    }
    __device__ __forceinline__ const char* bptr(const pg8::Unit& u) const { return W + ((size_t)u.e * DM + (size_t)u.pn * 256) * DFF; }
    __device__ __forceinline__ float pre(const pg8::Unit& u, int tid) const { return ld_untracked(b2 + (size_t)u.e * DM + u.pn * 256 + (tid & 255)); }
    __device__ __forceinline__ void epi(f32x4 (&acc)[2][2][4][2], const pg8::Unit& u, int wr, int wc, int fr, int fq, float pf) const {
        asm volatile("s_nop 15\n\ts_nop 7" ::: "memory");
        const int rl0 = wr * 64 + fr, col0 = u.pn * 256 + wc * 32 + 8 * fq;
        LAS float* pfx = (LAS float*)(lds + LDS_PFX);
        if (wr == 0) pfx[wc * 64 + fq * 16 + fr] = pf;
        asm volatile("s_waitcnt lgkmcnt(0)" ::: "memory"); __builtin_amdgcn_s_barrier(); asm volatile("" ::: "memory");
        const LAS float* bp = pfx + wc * 32 + 8 * fq;
        f32x4 bv[2][2];
#pragma unroll
        for (int bj = 0; bj < 2; ++bj) { bv[bj][0] = *(const LAS f32x4*)(bp + bj * 128) * YSCALE; bv[bj][1] = *(const LAS f32x4*)(bp + bj * 128 + 4) * YSCALE; }
        constexpr float sc = YSCALE / (WSCALE * ASCALE);
        char* tbase = (char*)ys + ((size_t)u.pm * 256) * DM + u.pn * 256;
        const int tid = (wr * 4 + wc) * 64 + fq * 16 + fr;
#pragma unroll
        for (int ai = 0; ai < 2; ++ai)
#pragma unroll
            for (int mh = 0; mh < 2; ++mh) { const int c = ai * 2 + mh; LAS unsigned char* buf = lds + ((c & 1) ? STG_BUF1 : STG_BUF0);
#pragma unroll
                for (int ml = 0; ml < 2; ++ml) { const int m = mh * 2 + ml, rl = ml * 32 + wr * 16 + fr;
#pragma unroll
                    for (int bj = 0; bj < 2; ++bj) { const f32x4 v0 = acc[ai][bj][m][0] * sc + bv[bj][0], v1 = acc[ai][bj][m][1] * sc + bv[bj][1];
                        u32x2 w; w.x = pack_fp8x4(v0[0], v0[1], v0[2], v0[3]); w.y = pack_fp8x4(v1[0], v1[1], v1[2], v1[3]);
                        const int slot = bj * 16 + wc * 4 + fq;
                        *(LAS u32x2*)(buf + rl * 256 + ((slot ^ ((rl & 7) << 1)) << 3)) = w; } }
                asm volatile("s_waitcnt lgkmcnt(0)" ::: "memory"); __builtin_amdgcn_s_barrier(); asm volatile("" ::: "memory");
#pragma unroll
                for (int j = 0; j < 2; ++j) { const int p = tid + 512 * j, r2 = p >> 4, pi = p & 15;
                    const u32x4 v = *(const LAS u32x4*)(buf + r2 * 256 + (((2 * pi) ^ ((r2 & 7) << 1)) << 3));
                    const int trow = ai * 128 + ((r2 >> 4) & 1) * 64 + (mh * 2 + (r2 >> 5)) * 16 + (r2 & 15);
                    *(u32x4*)(tbase + (size_t)trow * DM + pi * 16) = v; } }
    }
};
static_assert(256 + MOE_MAXS * 256 * 4 <= 32768 - 512, "MoE tables fit the AUX region");

__device__ __forceinline__ void p8_combine(Frame& F) {
    const int gw = F.vcu * NWAVES + F.wave, NGW = F.G * NWAVES;
    LAS int* TB = (LAS int*)(F.lds + LDS_AUX);
    moe_prefix(F, TB);
    const unsigned char* YS = F.ws + WS_YB; const int* POSI = (const int*)(F.ws + WS_POSI); const float* GATES = (const float*)(F.ws + WS_GATES);
    const bf16_t* X1H = (const bf16_t*)(F.ws + WS_X1H);
    for (int m = gw; m < MTOK; m += NGW) {
        f32x4* op = (f32x4*)(F.out + (size_t)m * DM) + F.lane;
        const u32x2* xp = (const u32x2*)(X1H + (size_t)m * DM) + F.lane;
        const int pv = POSI[m * 4 + (F.lane & 3)]; const float gv = GATES[m * 4 + (F.lane & 3)] * (1.0f / YSCALE);
        f32x4 v[4];
#pragma unroll
        for (int j = 0; j < 4; ++j) { const u32x2 w = xp[64 * j]; v[j].x = bf2f(w.x & 0xffffu); v[j].y = bf2f(w.x >> 16); v[j].z = bf2f(w.y & 0xffffu); v[j].w = bf2f(w.y >> 16); }
#pragma unroll
        for (int k = 0; k < 4; ++k) { const int p = __builtin_amdgcn_readlane(pv, k); const float g = __builtin_bit_cast(float, __builtin_amdgcn_readlane(__builtin_bit_cast(int, gv), k));
            const int pos = TB[p >> 15] * 256 + (p & 32767);
            const unsigned* yp = (const unsigned*)(YS + (size_t)pos * DM) + F.lane;
#pragma unroll
            for (int j = 0; j < 4; ++j) { const unsigned w = yp[64 * j]; const f32x2 lo = __builtin_amdgcn_cvt_pk_f32_fp8(w, false), hi2 = __builtin_amdgcn_cvt_pk_f32_fp8(w, true);
                v[j].x += g * lo.x; v[j].y += g * lo.y; v[j].z += g * hi2.x; v[j].w += g * hi2.y; } }
#pragma unroll
        for (int j = 0; j < 4; ++j) op[64 * j] = v[j];
    }
}

typedef GAS unsigned gu32;
#define XB_TMO      128
#define XB_XCNT(j)  (256  + 64 * (j))
#define XB_XSUB(j)  (1280 + 64 * (j))
#define XB_XGEN(j)  (2304 + 64 * (j))
#define XB_TOP      3328
#define XB_TOPGEN   3392
#define XCD_BAR_WORDS 3456
#define XB_SPIN_CAP (1u << 20)
__device__ __forceinline__ unsigned xb_ld(unsigned* p)              { return __hip_atomic_load(p, __ATOMIC_RELAXED, __HIP_MEMORY_SCOPE_AGENT); }
__device__ __forceinline__ unsigned xb_add(unsigned* p, unsigned v) { return __hip_atomic_fetch_add(p, v, __ATOMIC_RELAXED, __HIP_MEMORY_SCOPE_AGENT); }
__device__ __forceinline__ unsigned xb_xcc_id() { return (unsigned)__builtin_amdgcn_s_getreg((3 << 11) | 20) & 0xFu; }
#define XB_SPIN(cond, bar) do { unsigned _sp = 0; while (cond) { __builtin_amdgcn_s_sleep(1); \
    if ((++_sp & 255u) == 0u) { if (xb_ld(&(bar)[XB_TMO])) break; if (_sp > XB_SPIN_CAP) { atomicAdd(&(bar)[XB_TMO], 1u); break; } } } } while (0)
struct XcdBarrier { unsigned* bar; unsigned x; volatile LAS unsigned* st; };
__device__ __forceinline__ XcdBarrier xcd_barrier_post(unsigned* bar, volatile LAS unsigned* st) {
    XcdBarrier b; b.bar = bar; b.x = xb_xcc_id(); b.st = st;
    if (threadIdx.x == 0) (void)xb_add(&bar[XB_XCNT(b.x)], 1u);
    return b;
}
__device__ __forceinline__ void xcd_barrier_complete(unsigned* bar, unsigned x, unsigned& nloc, unsigned& nx) {
    const unsigned G = gridDim.x * gridDim.y * gridDim.z;
    unsigned sum, cnt, mine, sp = 0u;
    for (;;) {
        sum = 0u; cnt = 0u; mine = 0u;
#pragma unroll
        for (unsigned j = 0; j < 16; ++j) { const unsigned c = xb_ld(&bar[XB_XCNT(j)]); sum += c; cnt += (c > 0u) ? 1u : 0u; mine = (j == x) ? c : mine; }
        if (sum == G) break;
        __builtin_amdgcn_s_sleep(1);
        if ((++sp & 255u) == 0u) { if (xb_ld(&bar[XB_TMO])) break; if (sp > XB_SPIN_CAP) { atomicAdd(&bar[XB_TMO], 1u); break; } }
    }
    nloc = mine > 0u ? mine : 1u; nx = cnt > 0u ? cnt : 1u;
}
template <bool FILL>
__device__ __forceinline__ void xcd_barrier(const XcdBarrier& b, Frame& F) {
    asm volatile("s_waitcnt vmcnt(0)" ::: "memory");
    __syncthreads();
    if (threadIdx.x == 0) {
        unsigned* bar = b.bar;
        __builtin_amdgcn_s_waitcnt(0);
        unsigned nloc = b.st[0], nx = b.st[1];
        if (nloc == 0u) { xcd_barrier_complete(bar, b.x, nloc, nx); b.st[0] = nloc; b.st[1] = nx; }
        const unsigned old = xb_add(&bar[XB_XSUB(b.x)], 1u);
        const unsigned gen = old / nloc;
        if (old + 1u == (gen + 1u) * nloc) {
            __builtin_amdgcn_fence(__ATOMIC_RELEASE, "agent");
            asm volatile("s_waitcnt vmcnt(0)" ::: "memory");
            const unsigned og = xb_add(&bar[XB_TOP], 1u);
            const unsigned tg = og / nx;
            if (og + 1u == (tg + 1u) * nx) xb_add(&bar[XB_TOPGEN], 1u);
            else XB_SPIN(xb_ld(&bar[XB_TOPGEN]) == tg, bar);
            __builtin_amdgcn_fence(__ATOMIC_ACQUIRE, "agent");
            xb_add(&bar[XB_XGEN(b.x)], 1u);
            asm volatile("s_waitcnt vmcnt(0)" ::: "memory");
            if (FILL) b.st[4] = 1u;
        } else if (!FILL) {
            XB_SPIN(xb_ld(&bar[XB_XGEN(b.x)]) == gen, bar);
            __builtin_amdgcn_fence(__ATOMIC_ACQUIRE, "agent");
            asm volatile("s_waitcnt vmcnt(0)" ::: "memory");
        } else { b.st[4] = 0u; b.st[5] = gen; }
    }
    __syncthreads();
    if (FILL) {
        if (__builtin_amdgcn_readfirstlane((int)b.st[4]) == 0) {
            const unsigned gen = (unsigned)__builtin_amdgcn_readfirstlane((int)b.st[5]);
            unsigned* fq = (unsigned*)(F.ws + WS_CTL) + CW_FILLQ;
            for (;;) {
                if (threadIdx.x == 0) { const unsigned done = (xb_ld(&b.bar[XB_XGEN(b.x)]) != gen) ? 1u : 0u; unsigned t = (unsigned)NFILL; if (!done) t = xb_add(fq, 1u); b.st[6] = done; b.st[7] = t; }
                LDS_BARRIER();
                const unsigned done = (unsigned)__builtin_amdgcn_readfirstlane((int)b.st[6]), t = (unsigned)__builtin_amdgcn_readfirstlane((int)b.st[7]);
                if (done) break;
                if (t < (unsigned)NFILL) filler_unit(F, t);
                else { if (threadIdx.x == 0) XB_SPIN(xb_ld(&b.bar[XB_XGEN(b.x)]) == gen, b.bar); __syncthreads(); break; }
                LDS_BARRIER();
            }
            if (threadIdx.x == 0) { __builtin_amdgcn_fence(__ATOMIC_ACQUIRE, "agent"); asm volatile("s_waitcnt vmcnt(0)" ::: "memory"); }
            __syncthreads();
        }
    }
}

struct Args { const float* in[25]; float* out; unsigned char* ws; int ph_lo, ph_hi; };
__global__ void __launch_bounds__(NTHR, 2) mk_fwd(Args args) {
    extern __shared__ __attribute__((aligned(16))) unsigned char lds_raw[];
    Frame F;
    F.lds = (LAS unsigned char*)lds_raw; F.ws = args.ws; F.out = args.out;
    F.kin = (karg_ptr_t)__builtin_amdgcn_kernarg_segment_ptr();
    F.tid = threadIdx.x; F.lane = F.tid & 63; F.wave = __builtin_amdgcn_readfirstlane(F.tid >> 6);
    F.G = gridDim.x; { const int bx = blockIdx.x; F.vcu = (F.G % 8 == 0) ? (bx % 8) * (F.G / 8) + bx / 8 : bx; }
    const int lo = args.ph_lo, hi = args.ph_hi;
    { volatile LAS unsigned* MISC = (volatile LAS unsigned*)(F.lds + LDS_MISC); if (F.tid < 64) MISC[F.tid] = 0u; }
    __syncthreads();
    XcdBarrier bar; bar.bar = (unsigned*)(F.ws + WS_CTL) + CW_BAR; bar.x = 0; bar.st = nullptr;
    if (hi - lo > 1) bar = xcd_barrier_post((unsigned*)(F.ws + WS_CTL) + CW_BAR, (volatile LAS unsigned*)(F.lds + LDS_MISC) + 8);
#define IN(k) (lo <= (k) && (k) < hi)
#define SEAM(k) do { if (IN(k) && ((k) == 2 ? IN(4) : IN((k) + 1))) xcd_barrier<((k) <= 2 || (k) == 4)>(bar, F); } while (0)

    if (IN(0)) { p0_prologue(F); }
    SEAM(0);
    if (IN(1)) {
        ProbInProj P; P.S.init(MTOK, DIN, F.G, (int)blockIdx.x); P.A = (const char*)(F.ws + WS_XB); P.Bt = (const char*)(F.ws + WS_WIN); P.rstd1 = (const float*)(F.ws + WS_RSTD1);
        P.dst0 = (bf16_t*)(F.ws + WS_XR); P.qg = F.in(10); P.kg = F.in(11); P.xs = (LAS float*)(F.lds + LDS_AUX); P.lds = F.lds;
        pg8::gemm_phase<decltype(P), true>(F.lds, P);
    }
    SEAM(1);
    if (IN(2)) { att::mixer_phase(F); }
    SEAM(2);
    if (IN(4)) {
        ProbOutProj P; P.S.init(MTOK, DM, F.G, (int)blockIdx.x); P.A = (const char*)(F.ws + WS_Y); P.Bt = (const char*)(F.ws + WS_WOUT); P.xb = (const bf16_t*)(F.ws + WS_XB); P.x1h = (bf16_t*)(F.ws + WS_X1H); P.x1q = F.ws + WS_X1B; P.lds = F.lds;
        pg8::gemm_phase<decltype(P), true>(F.lds, P);
    }
    SEAM(4);
    if (IN(5)) { p5_router(F); filler_drain(F); }
    SEAM(5);
    if (IN(6)) {
        ProbMoe1 P; P.M = moe_setup<8, true>(F); P.A = (const char*)(F.ws + WS_X1B); P.W = (const char*)(F.ws + WS_W1); P.b1 = F.in(22); P.act = F.ws + WS_ACT; P.lds = F.lds;
        pg8::gemm_phase<decltype(P), true>(F.lds, P);
    }
    SEAM(6);
    if (IN(7)) {
        ProbMoe2 P; P.M = moe_setup<4, false>(F); P.A = (const char*)(F.ws + WS_ACT); P.W = (const char*)(F.ws + WS_W2); P.b2 = F.in(24); P.ys = F.ws + WS_YB; P.lds = F.lds;
        pg8::gemm_phase<decltype(P), true>(F.lds, P);
    }
    SEAM(7);
    if (IN(8)) { p8_combine(F); }
#undef IN
#undef SEAM
}

extern "C" void kernel_launch(void* const* d_in, const int* in_sizes, int n_in, void* d_out, int out_size, void* d_ws, size_t ws_size, hipStream_t stream) {
    static int grid = 0;
    if (grid == 0) {
        if (n_in != 25 || in_sizes[0] != MTOK * DM || out_size != MTOK * DM || ws_size < WS_END) {
            fprintf(stderr, "kernel_launch: unexpected problem (n_in %d, in0 %d, out %d, ws %zu); nothing launched\n", n_in, n_in > 0 ? in_sizes[0] : -1, out_size, ws_size); grid = -1; return; }
        int dev = 0, cus = 0, per_cu = 0;
        if (hipGetDevice(&dev) != hipSuccess || hipDeviceGetAttribute(&cus, hipDeviceAttributeMultiprocessorCount, dev) != hipSuccess) { grid = -1; return; }
        if (hipFuncSetAttribute((const void*)mk_fwd, hipFuncAttributeMaxDynamicSharedMemorySize, LDS_BYTES) != hipSuccess) { fprintf(stderr, "kernel_launch: hipFuncSetAttribute failed\n"); grid = -1; return; }
        if (hipOccupancyMaxActiveBlocksPerMultiprocessor(&per_cu, (const void*)mk_fwd, NTHR, LDS_BYTES) != hipSuccess || per_cu < 1) { fprintf(stderr, "kernel_launch: occupancy query says %d blocks/CU for %d B of LDS: the grid barrier needs every workgroup resident; nothing launched\n", per_cu, LDS_BYTES); (void)hipGetLastError(); grid = -1; return; }
        (void)hipGetLastError();
        grid = cus;
        if (grid != 256) { fprintf(stderr, "kernel_launch: built for a 256-CU device (got %d)\n", cus); grid = -1; return; }
    }
    if (grid < 0) return;
    (void)hipMemsetAsync((char*)d_ws + WS_CTL, 0, CTL_BYTES, stream);
    Args a{};
    for (int i = 0; i < 25; ++i) a.in[i] = (const float*)d_in[i];
    a.out = (float*)d_out; a.ws = (unsigned char*)d_ws;
#if MK_N_LAUNCHES == 1
    a.ph_lo = 0; a.ph_hi = NPHASE;
    hipLaunchKernelGGL(mk_fwd, dim3(grid), dim3(NTHR), LDS_BYTES, stream, a);
#else
    for (int p = 0; p < NPHASE; ++p) { a.ph_lo = p; a.ph_hi = p + 1; hipLaunchKernelGGL(mk_fwd, dim3(grid), dim3(NTHR), LDS_BYTES, stream, a); }
#endif
}
```
